# Optimizing an MI355X kernel written in HIP

```python
import jax, jax.numpy as jnp
from jax import lax
import numpy as np

D_MODEL = 1024
BATCH = 2
SEQ = 8192
DEPTH = 2

HEAD_DIM = 64
RET_HEADS = 8
DIL_HEADS = 8
SB_HEADS = D_MODEL // HEAD_DIM
RET_WIDTH = RET_HEADS * HEAD_DIM
DIL_WIDTH = DIL_HEADS * HEAD_DIM
SB_WIDTH = SB_HEADS * HEAD_DIM
HYB_IN = 4 * RET_WIDTH + 3 * DIL_WIDTH
D_FF = 2816
BLOCK = 128
RET_CHUNK = 128
RET_ROPE_THETA = 10000.0
ROPE_THETA = 500000.0
ROPE_DIM = HEAD_DIM // 4
DILATED_PATTERNS = ((128, 1), (512, 4), (2048, 16))
NORM_EPS = 1e-6
GN_EPS = 1e-5
N_EVEN = (DEPTH + 1) // 2
N_ODD = DEPTH // 2

kernel_name = "hybrid_retention_dilated_stickbreaking_macaron"


def rms_norm(x, g):
    xf = x.astype(jnp.float32)
    y = xf * lax.rsqrt(jnp.mean(xf * xf, axis=-1, keepdims=True) + NORM_EPS)
    return (y * g.astype(jnp.float32)).astype(x.dtype)


def swiglu_ffn(x, g, w_in, w_out):
    h = rms_norm(x, g)
    gate, up = jnp.split(h @ w_in, 2, axis=-1)
    return (jax.nn.silu(gate) * up) @ w_out


def split_heads(t, n_heads):
    b, s, _ = t.shape
    return t.reshape(b, s, n_heads, HEAD_DIM).transpose(0, 2, 1, 3)


def merge_heads(t):
    b, h, s, dh = t.shape
    return t.transpose(0, 2, 1, 3).reshape(b, s, h * dh)


def rotary(x, rot_dim, theta):
    s = x.shape[-2]
    half = rot_dim // 2
    inv_freq = 1.0 / (theta ** (jnp.arange(half, dtype=jnp.float32) / half))
    ang = jnp.arange(s, dtype=jnp.float32)[:, None] * inv_freq[None, :]
    cos, sin = jnp.cos(ang), jnp.sin(ang)
    xr = x[..., :rot_dim].astype(jnp.float32)
    x1, x2 = xr[..., :half], xr[..., half:]
    rot = jnp.concatenate([x1 * cos - x2 * sin, x2 * cos + x1 * sin], axis=-1).astype(x.dtype)
    return jnp.concatenate([rot, x[..., rot_dim:]], axis=-1)


def retention_chunkwise(q, k, v):
    b, h, s, dk = q.shape
    c = RET_CHUNK
    nc = s // c
    out_dtype = v.dtype
    q, k, v = (t.astype(jnp.float32) for t in (q, k, v))
    k = k * (dk ** -0.5)
    log_g = jnp.log(1.0 - 2.0 ** (-5.0 - jnp.arange(h, dtype=jnp.float32)))
    i = jnp.arange(c, dtype=jnp.float32)
    diff = i[:, None] - i[None, :]
    decay_in = jnp.where(diff >= 0, jnp.exp(jnp.maximum(diff, 0.0)[None] * log_g[:, None, None]), 0.0)
    qc = q.reshape(b, h, nc, c, dk)
    kc = k.reshape(b, h, nc, c, dk)
    vc = v.reshape(b, h, nc, c, -1)
    scores = jnp.einsum('bhnid,bhnjd->bhnij', qc, kc) * decay_in[None, :, None]
    inner = jnp.einsum('bhnij,bhnje->bhnie', scores, vc)
    k_decay = jnp.exp((c - 1 - i)[None, :] * log_g[:, None])
    kv = jnp.einsum('bhnjd,bhnje->nbhde', kc * k_decay[None, :, None, :, None], vc)
    chunk_decay = jnp.exp(c * log_g)[None, :, None, None]

    def step(state, kv_n):
        return state * chunk_decay + kv_n, state

    _, state_prev = lax.scan(step, jnp.zeros_like(kv[0]), kv)
    q_decay = jnp.exp((i + 1)[None, :] * log_g[:, None])
    cross = jnp.einsum('bhnid,nbhde->bhnie', qc * q_decay[None, :, None, :, None], state_prev)
    return (inner + cross).reshape(b, h, s, -1).astype(out_dtype)


def head_group_norm(o, g):
    of = o.astype(jnp.float32)
    mu = jnp.mean(of, axis=-1, keepdims=True)
    var = jnp.mean(jnp.square(of - mu), axis=-1, keepdims=True)
    y = (of - mu) * lax.rsqrt(var + GN_EPS)
    y = y * g.astype(jnp.float32).reshape(o.shape[1], 1, o.shape[3])
    return y.astype(o.dtype)


def band_attention(q, k, v, n_back):
    *lead, l_len, dh = q.shape
    nb = l_len // BLOCK
    qb = q.reshape(*lead, nb, BLOCK, dh)

    def with_prev(t):
        tb = t.reshape(*lead, nb, BLOCK, dh)
        prev = jnp.concatenate([jnp.zeros_like(tb[..., :1, :, :]), tb[..., :-1, :, :]], axis=-3)
        return jnp.concatenate([prev, tb], axis=-2)

    kb, vb = with_prev(k), with_prev(v)
    s = jnp.einsum('...nqd,...nkd->...nqk', qb, kb).astype(jnp.float32) * (dh ** -0.5)
    dist = (jnp.arange(BLOCK)[:, None] + BLOCK) - jnp.arange(2 * BLOCK)[None, :]
    in_band = (dist >= 0) & (dist <= n_back)
    key_pos = jnp.arange(nb)[:, None] * BLOCK - BLOCK + jnp.arange(2 * BLOCK)[None, :]
    mask = in_band[None] & (key_pos >= 0)[:, None, :]
    s = jnp.where(mask, s, -jnp.inf)
    m = jnp.max(s, axis=-1, keepdims=True)
    p = jnp.exp(s - m)
    den = jnp.sum(p, axis=-1, keepdims=True)
    o = jnp.einsum('...nqk,...nkd->...nqd', p, vb.astype(jnp.float32)) / den
    lse = (m + jnp.log(den))[..., 0]
    return o.reshape(*lead, l_len, dh), lse.reshape(*lead, l_len)


def dilated_attention(q, k, v):
    b, h, s, dh = q.shape
    outs, lses = [], []
    for window, dil in DILATED_PATTERNS:
        mult = dil * BLOCK
        s_pad = -(-s // mult) * mult
        pad = ((0, 0), (0, 0), (0, s_pad - s), (0, 0))

        def by_residue(t):
            return jnp.pad(t, pad).reshape(b, h, s_pad // dil, dil, dh).transpose(0, 1, 3, 2, 4)

        o, lse = band_attention(by_residue(q), by_residue(k), by_residue(v), window // dil)
        outs.append(o.transpose(0, 1, 3, 2, 4).reshape(b, h, s_pad, dh)[:, :, :s])
        lses.append(lse.transpose(0, 1, 3, 2).reshape(b, h, s_pad)[:, :, :s])
    w = jax.nn.softmax(jnp.stack(lses, axis=0), axis=0)
    o = jnp.sum(w[..., None] * jnp.stack(outs, axis=0), axis=0)
    return o.astype(q.dtype)


def stick_breaking_attention(q, k, v):
    b, h, s, dh = q.shape
    nb = s // BLOCK
    kf, vf = k.astype(jnp.float32), v.astype(jnp.float32)
    key_pos = jnp.arange(s)

    def one_block(args):
        q_blk, blk = args
        z = jnp.einsum('bhqd,bhkd->bhqk', q_blk.astype(jnp.float32), kf) * (dh ** -0.5)
        q_pos = blk * BLOCK + jnp.arange(BLOCK)
        causal = key_pos[None, :] < q_pos[:, None]
        log_stay = jnp.where(causal, jax.nn.log_sigmoid(-z), 0.0)
        later = lax.cumsum(log_stay, axis=3, reverse=True) - log_stay
        a = jnp.where(causal, jnp.exp(jax.nn.log_sigmoid(z) + later), 0.0)
        return jnp.einsum('bhqk,bhkd->bhqd', a, vf)

    q_blocks = q.reshape(b, h, nb, BLOCK, dh).transpose(2, 0, 1, 3, 4)
    o = lax.map(one_block, (q_blocks, jnp.arange(nb)))
    return o.transpose(1, 2, 0, 3, 4).reshape(b, h, s, dh).astype(q.dtype)


def retention_dilated_mixer(x, norm_g, w_in, ret_gn, w_out):
    h = rms_norm(x, norm_g)
    proj = h @ w_in
    cuts = [RET_WIDTH, 2 * RET_WIDTH, 3 * RET_WIDTH, 4 * RET_WIDTH,
            4 * RET_WIDTH + DIL_WIDTH, 4 * RET_WIDTH + 2 * DIL_WIDTH]
    rq, rk, rv, rg, dq, dk, dv = jnp.split(proj, cuts, axis=-1)
    rq = rotary(split_heads(rq, RET_HEADS), HEAD_DIM, RET_ROPE_THETA)
    rk = rotary(split_heads(rk, RET_HEADS), HEAD_DIM, RET_ROPE_THETA)
    ret = retention_chunkwise(rq, rk, split_heads(rv, RET_HEADS))
    ret = merge_heads(head_group_norm(ret, ret_gn)) * jax.nn.silu(rg)
    dq = rotary(split_heads(dq, DIL_HEADS), ROPE_DIM, ROPE_THETA)
    dk = rotary(split_heads(dk, DIL_HEADS), ROPE_DIM, ROPE_THETA)
    dil = merge_heads(dilated_attention(dq, dk, split_heads(dv, DIL_HEADS)))
    return jnp.concatenate([ret, dil], axis=-1) @ w_out


def stick_breaking_mixer(x, norm_g, w_in, w_out):
    h = rms_norm(x, norm_g)
    q, k, v = jnp.split(h @ w_in, 3, axis=-1)
    o = stick_breaking_attention(split_heads(q, SB_HEADS), split_heads(k, SB_HEADS), split_heads(v, SB_HEADS))
    return merge_heads(o) @ w_out


def setup_inputs(seed: int = 0) -> dict:
    key = jax.random.key(seed)
    ks = jax.random.split(key, 16)
    f32 = jnp.float32

    def gain(k, shape):
        return 1.0 + 0.02 * jax.random.normal(k, shape, f32)

    def dense(k, shape, fan_in):
        return jax.random.normal(k, shape, f32) * (fan_in ** -0.5)

    return {
        'x': jax.random.normal(ks[0], (BATCH, SEQ, D_MODEL), f32),
        'ffn1_norm': gain(ks[1], (DEPTH, D_MODEL)),
        'ffn1_w_in': dense(ks[2], (DEPTH, D_MODEL, 2 * D_FF), D_MODEL),
        'ffn1_w_out': dense(ks[3], (DEPTH, D_FF, D_MODEL), D_FF),
        'mix_norm': gain(ks[4], (DEPTH, D_MODEL)),
        'ffn2_norm': gain(ks[5], (DEPTH, D_MODEL)),
        'ffn2_w_in': dense(ks[6], (DEPTH, D_MODEL, 2 * D_FF), D_MODEL),
        'ffn2_w_out': dense(ks[7], (DEPTH, D_FF, D_MODEL), D_FF),
        'hyb_w_in': dense(ks[8], (N_EVEN, D_MODEL, HYB_IN), D_MODEL),
        'ret_gn': gain(ks[9], (N_EVEN, RET_WIDTH)),
        'hyb_w_out': dense(ks[10], (N_EVEN, RET_WIDTH + DIL_WIDTH, D_MODEL), RET_WIDTH + DIL_WIDTH),
        'sb_w_in': dense(ks[11], (N_ODD, D_MODEL, 3 * SB_WIDTH), D_MODEL),
        'sb_w_out': dense(ks[12], (N_ODD, SB_WIDTH, D_MODEL), SB_WIDTH),
        'final_norm': gain(ks[13], (D_MODEL,)),
    }


def reference(x, ffn1_norm, ffn1_w_in, ffn1_w_out, mix_norm, ffn2_norm, ffn2_w_in, ffn2_w_out,
              hyb_w_in, ret_gn, hyb_w_out, sb_w_in, sb_w_out, final_norm):
    for layer in range(DEPTH):
        x = x + 0.5 * swiglu_ffn(x, ffn1_norm[layer], ffn1_w_in[layer], ffn1_w_out[layer])
        if layer % 2 == 0:
            e = layer // 2
            x = x + retention_dilated_mixer(x, mix_norm[layer], hyb_w_in[e], ret_gn[e], hyb_w_out[e])
        else:
            o = layer // 2
            x = x + stick_breaking_mixer(x, mix_norm[layer], sb_w_in[o], sb_w_out[o])
        x = x + 0.5 * swiglu_ffn(x, ffn2_norm[layer], ffn2_w_in[layer], ffn2_w_out[layer])
    return rms_norm(x, final_norm)
```

```cpp
#include <hip/hip_runtime.h>
#include <cstdint>
#include <cstdio>

constexpr int BATCH = 2, SEQ = 8192, D = 1024, M = BATCH * SEQ, FF = 2816, HD = 64;
constexpr int HYB = 3584, SBW = 3072;
typedef unsigned short bf16;
constexpr size_t MiB = 1u << 20;
constexpr size_t WS_H32 = 0, WS_BIG = 64 * MiB, WS_CAT = 176 * MiB, WS_TAB = 208 * MiB;

__device__ __forceinline__ float bf2f(bf16 v) { return __uint_as_float(((unsigned)v) << 16); }
__device__ __forceinline__ bf16 f2bf(float f) { unsigned u = __float_as_uint(f); return (bf16)((u + 0x7fffu + ((u >> 16) & 1u)) >> 16); }
__device__ __forceinline__ float ldA(const float* p) { return *p; }
__device__ __forceinline__ float ldA(const bf16* p) { return bf2f(*p); }
__device__ __forceinline__ float wave_sum(float v) {
#pragma unroll
    for (int o = 1; o < 64; o <<= 1) v += __shfl_xor(v, o);
    return v;
}

__global__ void nv_tables(float* rc, float* rs, float* dc, float* ds) {
    int idx = blockIdx.x * blockDim.x + threadIdx.x;
    if (idx < SEQ * 32) { int pos = idx / 32, i = idx % 32; float inv = 1.0f / powf(10000.0f, (float)i / 32.0f); float ang = (float)pos * inv; rc[idx] = cosf(ang); rs[idx] = sinf(ang); }
    if (idx < SEQ * 8) { int pos = idx / 8, i = idx % 8; float inv = 1.0f / powf(500000.0f, (float)i / 8.0f); float ang = (float)pos * inv; dc[idx] = cosf(ang); ds[idx] = sinf(ang); }
}

__global__ void nv_rmsnorm(const float* x, const float* g, float* h) {
    const int row = blockIdx.x; const float* xr = x + (size_t)row * D; __shared__ float red[4];
    float s = 0.f; for (int c = threadIdx.x; c < D; c += 256) { float v = xr[c]; s += v * v; }
    s = wave_sum(s); if ((threadIdx.x & 63) == 0) red[threadIdx.x >> 6] = s; __syncthreads();
    const float tot = red[0] + red[1] + red[2] + red[3]; const float rs = 1.0f / sqrtf(tot / D + 1e-6f);
    for (int c = threadIdx.x; c < D; c += 256) h[(size_t)row * D + c] = xr[c] * rs * g[c];
}
__global__ void nv_final(float* x, const float* g) {
    const int row = blockIdx.x; float* xr = x + (size_t)row * D; __shared__ float red[4];
    float v[4]; float s = 0.f;
#pragma unroll
    for (int i = 0; i < 4; ++i) { v[i] = xr[threadIdx.x + 256 * i]; s += v[i] * v[i]; }
    s = wave_sum(s); if ((threadIdx.x & 63) == 0) red[threadIdx.x >> 6] = s; __syncthreads();
    const float tot = red[0] + red[1] + red[2] + red[3]; const float rs = 1.0f / sqrtf(tot / D + 1e-6f);
#pragma unroll
    for (int i = 0; i < 4; ++i) xr[threadIdx.x + 256 * i] = v[i] * rs * g[threadIdx.x + 256 * i];
}

template <typename AT, int MODE>
__global__ void __launch_bounds__(256) nv_gemm(const AT* A, int lda, const float* W, int ldw, int K, float* xres, float scale, bf16* outb, int ldo) {
    __shared__ float As[16][65]; __shared__ float Ws[16][64]; __shared__ float Ws2[16][64];
    const int tid = threadIdx.x, tx = tid & 15, ty = tid >> 4; const int row0 = blockIdx.y * 64, col0 = blockIdx.x * 64;
    float acc[4][4], acc2[4][4];
#pragma unroll
    for (int i = 0; i < 4; ++i)
#pragma unroll
        for (int j = 0; j < 4; ++j) { acc[i][j] = 0.f; acc2[i][j] = 0.f; }
    for (int k0 = 0; k0 < K; k0 += 16) {
#pragma unroll
        for (int i = 0; i < 4; ++i) { int idx = tid + 256 * i; int r = idx >> 4, kk = idx & 15; As[kk][r] = ldA(A + (size_t)(row0 + r) * lda + k0 + kk); }
#pragma unroll
        for (int i = 0; i < 4; ++i) { int idx = tid + 256 * i; int kk = idx >> 6, c = idx & 63; Ws[kk][c] = W[(size_t)(k0 + kk) * ldw + col0 + c]; if (MODE == 0) Ws2[kk][c] = W[(size_t)(k0 + kk) * ldw + col0 + c + FF]; }
        __syncthreads();
#pragma unroll
        for (int kk = 0; kk < 16; ++kk) {
            float a[4], b[4], b2[4];
#pragma unroll
            for (int i = 0; i < 4; ++i) { a[i] = As[kk][ty * 4 + i]; b[i] = Ws[kk][tx * 4 + i]; b2[i] = (MODE == 0) ? Ws2[kk][tx * 4 + i] : 0.f; }
#pragma unroll
            for (int i = 0; i < 4; ++i)
#pragma unroll
                for (int j = 0; j < 4; ++j) { acc[i][j] += a[i] * b[j]; if (MODE == 0) acc2[i][j] += a[i] * b2[j]; }
        }
        __syncthreads();
    }
#pragma unroll
    for (int i = 0; i < 4; ++i)
#pragma unroll
        for (int j = 0; j < 4; ++j) {
            const int r = row0 + ty * 4 + i, c = col0 + tx * 4 + j;
            if (MODE == 0) { float g = acc[i][j], u = acc2[i][j]; float v = g / (1.0f + expf(-g)) * u; outb[(size_t)r * ldo + c] = f2bf(v); }
            else if (MODE == 1) outb[(size_t)r * ldo + c] = f2bf(acc[i][j]);
            else xres[(size_t)r * D + c] += scale * acc[i][j];
        }
}

__global__ void nv_retention(const bf16* proj, const float* rc, const float* rs, const float* gn, bf16* cat) {
    const int b = blockIdx.x / 8, h = blockIdx.x % 8; const int tid = threadIdx.x, e = tid & 63, dg = tid >> 6;
    __shared__ float qs[64], ks[64], vs[64], red[4][64], os[64];
    const float gamma = 1.0f - exp2f(-5.0f - (float)h);
    float st[16];
#pragma unroll
    for (int i = 0; i < 16; ++i) st[i] = 0.f;
    for (int t = 0; t < SEQ; ++t) {
        const bf16* pr = proj + (size_t)(b * SEQ + t) * HYB + h * 64;
        if (tid < 32) { float x1 = bf2f(pr[tid]), x2 = bf2f(pr[tid + 32]); float c = rc[t * 32 + tid], s = rs[t * 32 + tid]; qs[tid] = x1 * c - x2 * s; qs[tid + 32] = x2 * c + x1 * s; }
        else if (tid < 64) { int i = tid - 32; float x1 = bf2f(pr[512 + i]), x2 = bf2f(pr[512 + i + 32]); float c = rc[t * 32 + i], s = rs[t * 32 + i]; ks[i] = (x1 * c - x2 * s) * 0.125f; ks[i + 32] = (x2 * c + x1 * s) * 0.125f; }
        else if (tid < 128) { int i = tid - 64; vs[i] = bf2f(pr[1024 + i]); }
        __syncthreads();
        float po = 0.f; const float ve = vs[e];
#pragma unroll
        for (int dd = 0; dd < 16; ++dd) { const int d = dg * 16 + dd; st[dd] = gamma * st[dd] + ks[d] * ve; po += qs[d] * st[dd]; }
        red[dg][e] = po; __syncthreads();
        if (tid < 64) os[tid] = red[0][tid] + red[1][tid] + red[2][tid] + red[3][tid];
        __syncthreads();
        if (tid < 64) {
            float mu = 0.f; for (int i = 0; i < 64; ++i) mu += os[i]; mu *= (1.0f / 64.0f);
            float var = 0.f; for (int i = 0; i < 64; ++i) { float d = os[i] - mu; var += d * d; } var *= (1.0f / 64.0f);
            float y = (os[tid] - mu) / sqrtf(var + 1e-5f) * gn[h * 64 + tid];
            float g = bf2f(pr[1536 + tid]); y *= g / (1.0f + expf(-g));
            cat[(size_t)(b * SEQ + t) * D + h * 64 + tid] = f2bf(y);
        }
        __syncthreads();
    }
}

__global__ void nv_dilated(const bf16* proj, const float* dc, const float* ds, bf16* cat) {
    const int wv = (blockIdx.x * blockDim.x + threadIdx.x) >> 6, lane = threadIdx.x & 63;
    const int t = wv % SEQ, h = (wv / SEQ) % 8, b = wv / (SEQ * 8);
    const bf16* base = proj + (size_t)b * SEQ * HYB + h * 64;
    float q = bf2f(base[(size_t)t * HYB + 2048 + lane]);
    { float other = __shfl_xor(q, 8); if (lane < 16) { int i = lane & 7; float c = dc[t * 8 + i], s = ds[t * 8 + i]; q = (lane < 8) ? (q * c - other * s) : (q * c + other * s); } }
    float outs[3], lses[3];
    const int dils[3] = {1, 4, 16};
#pragma unroll
    for (int p = 0; p < 3; ++p) {
        const int dil = dils[p]; float m = -INFINITY, l = 0.f, o = 0.f;
        for (int j = 0; j <= 128; ++j) {
            const int kp = t - j * dil; if (kp < 0) break;
            float k = bf2f(base[(size_t)kp * HYB + 2560 + lane]);
            { float other = __shfl_xor(k, 8); if (lane < 16) { int i = lane & 7; float c = dc[kp * 8 + i], s = ds[kp * 8 + i]; k = (lane < 8) ? (k * c - other * s) : (k * c + other * s); } }
            const float sc = wave_sum(q * k) * 0.125f; const float v = bf2f(base[(size_t)kp * HYB + 3072 + lane]);
            const float mn = fmaxf(m, sc); const float corr = expf(m - mn), pp = expf(sc - mn);
            l = l * corr + pp; o = o * corr + pp * v; m = mn;
        }
        outs[p] = o / l; lses[p] = m + logf(l);
    }
    const float mm = fmaxf(lses[0], fmaxf(lses[1], lses[2]));
    const float w0 = expf(lses[0] - mm), w1 = expf(lses[1] - mm), w2 = expf(lses[2] - mm);
    const float r = (w0 * outs[0] + w1 * outs[1] + w2 * outs[2]) / (w0 + w1 + w2);
    cat[(size_t)(b * SEQ + t) * D + 512 + h * 64 + lane] = f2bf(r);
}

__device__ __forceinline__ float softplusf(float x) { return fmaxf(x, 0.f) + log1pf(expf(-fabsf(x))); }
__global__ void nv_stickbreak(const bf16* qkv, bf16* cat) {
    const int wv = (blockIdx.x * blockDim.x + threadIdx.x) >> 6, lane = threadIdx.x & 63;
    const int t = wv % SEQ, h = (wv / SEQ) % 16, b = wv / (SEQ * 16);
    const bf16* base = qkv + (size_t)b * SEQ * SBW + h * 64;
    const float q = bf2f(base[(size_t)t * SBW + lane]);
    float later = 0.f, o = 0.f;
    for (int s = t - 1; s >= 0; --s) {
        const float k = bf2f(base[(size_t)s * SBW + 1024 + lane]);
        const float z = wave_sum(q * k) * 0.125f; const float v = bf2f(base[(size_t)s * SBW + 2048 + lane]);
        const float a = expf(-softplusf(-z) + later); o += a * v; later += -softplusf(z);
        if (later < -104.0f) break;
    }
    cat[(size_t)(b * SEQ + t) * D + h * 64 + lane] = f2bf(o);
}

extern "C" void kernel_launch(void* const* d_in, const int* in_sizes, int n_in, void* d_out, int out_size, void* d_ws, size_t ws_size, hipStream_t stream) {
    const float* x = (const float*)d_in[0];
    const float* ffn1_norm = (const float*)d_in[1]; const float* ffn1_w_in = (const float*)d_in[2]; const float* ffn1_w_out = (const float*)d_in[3];
    const float* mix_norm = (const float*)d_in[4]; const float* ffn2_norm = (const float*)d_in[5]; const float* ffn2_w_in = (const float*)d_in[6]; const float* ffn2_w_out = (const float*)d_in[7];
    const float* hyb_w_in = (const float*)d_in[8]; const float* ret_gn = (const float*)d_in[9]; const float* hyb_w_out = (const float*)d_in[10];
    const float* sb_w_in = (const float*)d_in[11]; const float* sb_w_out = (const float*)d_in[12]; const float* final_norm = (const float*)d_in[13];
    unsigned char* ws = (unsigned char*)d_ws; float* xr = (float*)d_out;
    float* h32 = (float*)(ws + WS_H32); bf16* big = (bf16*)(ws + WS_BIG); bf16* cat = (bf16*)(ws + WS_CAT);
    float* rc = (float*)(ws + WS_TAB); float* rs = rc + SEQ * 32; float* dc = rs + SEQ * 32; float* ds = dc + SEQ * 8;
    nv_tables<<<SEQ * 32 / 256, 256, 0, stream>>>(rc, rs, dc, ds);
    hipMemcpyAsync(xr, x, (size_t)M * D * 4, hipMemcpyDeviceToDevice, stream);
    for (int layer = 0; layer < 2; ++layer) {
        for (int f = 0; f < 2; ++f) {
            if (f == 1) {
            }
            const float* ng = (f == 0 ? ffn1_norm : ffn2_norm) + layer * D;
            const float* wi = (f == 0 ? ffn1_w_in : ffn2_w_in) + (size_t)layer * D * 2 * FF;
            const float* wo = (f == 0 ? ffn1_w_out : ffn2_w_out) + (size_t)layer * FF * D;
            nv_rmsnorm<<<M, 256, 0, stream>>>(xr, ng, h32);
            nv_gemm<float, 0><<<dim3(FF / 64, M / 64), 256, 0, stream>>>(h32, D, wi, 2 * FF, D, nullptr, 0.f, big, FF);
            nv_gemm<bf16, 2><<<dim3(D / 64, M / 64), 256, 0, stream>>>(big, FF, wo, D, FF, xr, 0.5f, nullptr, 0);
            if (f == 0) {
                nv_rmsnorm<<<M, 256, 0, stream>>>(xr, mix_norm + layer * D, h32);
                if (layer == 0) {
                    nv_gemm<float, 1><<<dim3(HYB / 64, M / 64), 256, 0, stream>>>(h32, D, hyb_w_in, HYB, D, nullptr, 0.f, big, HYB);
                    nv_retention<<<16, 256, 0, stream>>>(big, rc, rs, ret_gn, cat);
                    nv_dilated<<<M * 8 / 4, 256, 0, stream>>>(big, dc, ds, cat);
                    nv_gemm<bf16, 2><<<dim3(D / 64, M / 64), 256, 0, stream>>>(cat, D, hyb_w_out, D, D, xr, 1.0f, nullptr, 0);
                } else {
                    nv_gemm<float, 1><<<dim3(SBW / 64, M / 64), 256, 0, stream>>>(h32, D, sb_w_in, SBW, D, nullptr, 0.f, big, SBW);
                    nv_stickbreak<<<M * 16 / 4, 256, 0, stream>>>(big, cat);
                    nv_gemm<bf16, 2><<<dim3(D / 64, M / 64), 256, 0, stream>>>(cat, D, sb_w_out, D, D, xr, 1.0f, nullptr, 0);
                }
            }
        }
    }
    nv_final<<<M, 256, 0, stream>>>(xr, final_norm);
}
```

```cpp
#include <hip/hip_runtime.h>
#include <hip/hip_cooperative_groups.h>
#include <cstdio>
#include <cstdint>
namespace pg8 {
#define PG8_LAS __attribute__((address_space(3)))
typedef unsigned short bf16_t;
typedef short bf16x8 __attribute__((ext_vector_type(8)));
typedef float f32x4 __attribute__((ext_vector_type(4)));
typedef unsigned u32x4 __attribute__((ext_vector_type(4)));
constexpr int BM = 256, BK = 64, HALF = 128, HTB = HALF * BK * 2  , STAGE_BYTES = 8 * HTB, NXCD = 8, WGM = 8;

__host__ __device__ __forceinline__ int lds_byte(int r, int c) { const int st = (r >> 4) * 2 + (c >> 5), rr = r & 15, cc = c & 31, ob = rr * 64 + cc * 2; return st * 1024 + (ob ^ (((ob >> 9) & 1) << 5)); }
__host__ __device__ __forceinline__ void stage_rc(int b, int& R, int& C) { const int st = b / 1024, sb = b % 1024, swz = sb ^ (((sb >> 9) & 1) << 5); R = (st >> 1) * 16 + swz / 64; C = (st & 1) * 32 + (swz % 64) / 2; }
__host__ __device__ __forceinline__ int perm32(int rho) { const int n = rho >> 4, i = rho & 15; return 8 * (i >> 2) + 4 * n + (i & 3); }

struct Unit { int pm, pn; };
struct Gemm { const bf16_t* A; const bf16_t* Bt; int M, N, K; };

struct StaticOrder {
    int nM, nN, nwg, G, c;
    __host__ __device__ void init(int M, int N, int G_, int c_) { nM = M / BM; nN = N / BM; nwg = nM * nN; G = G_; c = c_; }
    __host__ __device__ bool next(int i, Unit& u) const {
        const long L = (long)i * G + c; if (L >= nwg) return false;
        int wgid = (int)L; { const int q = nwg / NXCD, r = nwg % NXCD, xcd = wgid % NXCD, off = wgid / NXCD; wgid = (xcd < r ? xcd * (q + 1) : r * (q + 1) + (xcd - r) * q) + off; }
        const int nig = WGM * nN, gid = wgid / nig, fm = gid * WGM, gsz = (nM - fm) < WGM ? (nM - fm) : WGM;
        u.pm = fm + ((wgid % nig) % gsz); u.pn = (wgid % nig) / gsz; return true;
    }
    __device__ __forceinline__ void a_ready(const Unit&) const {}
    __device__ __forceinline__ void done(const Unit&) const {}
};

__device__ __forceinline__ unsigned cvt_pk_bf16(float lo, float hi) { unsigned r; asm volatile("v_cvt_pk_bf16_f32 %0, %1, %2" : "=v"(r) : "v"(lo), "v"(hi)); return r; }
typedef float f32x2 __attribute__((ext_vector_type(2)));
__device__ __forceinline__ f32x2 gelu_pk(f32x2 v) {
    const f32x2 av = __builtin_elementwise_abs(v), d = av * 0.2316418882f + 1.0f;
    f32x2 t; t.x = __builtin_amdgcn_rcpf(d.x); t.y = __builtin_amdgcn_rcpf(d.y);
    f32x2 q = t * 0.5307027145f + (-0.7265760135f); q = q * t + 0.7107068705f; q = q * t + (-0.142248368f); q = q * t + 0.127414796f; q = q * t;
    const f32x2 s = (v * v) * (-0.72134752044f);
    f32x2 e; e.x = __builtin_amdgcn_exp2f(s.x); e.y = __builtin_amdgcn_exp2f(s.y);
    const f32x2 m = v * (q * e), r = v - m;
    f32x2 o; o.x = v.x < 0.f ? m.x : r.x; o.y = v.y < 0.f ? m.y : r.y; return o;
}

template <int ACT  > struct EpiBf16 {
    static constexpr bool PERM = true, AFTER_DRAIN = false; static_assert(ACT == 0 || ACT == 1, "EpiBf16: ACT is 0 (none) or 1 (gelu_pk)");
    bf16_t* O; int ldc; const float* bias; int split_cols; size_t split_stride; float scale0;
    __device__ __forceinline__ void operator()(const f32x4 (&acc)[2][2][4][2], const Unit& u, int wr, int wc, int fr, int fq) const {
        const int row0 = u.pm * BM + wr * 64 + fr; int colt = u.pn * BM; bf16_t* base = O;
        float sc = 1.f; if (split_cols) { const int t = colt / split_cols; base += (size_t)t * split_stride; colt -= t * split_cols; if (t == 0) sc = scale0; }
        const int col0 = colt + wc * 32 + 8 * fq, bcol0 = u.pn * BM + wc * 32 + 8 * fq;
        f32x4 bv[2][2];
#pragma unroll
        for (int bj = 0; bj < 2; ++bj)
#pragma unroll
            for (int n = 0; n < 2; ++n) bv[bj][n] = bias ? *(const f32x4*)(bias + bcol0 + bj * HALF + 4 * n) : (f32x4){0.f, 0.f, 0.f, 0.f};
#pragma unroll
        for (int ai = 0; ai < 2; ++ai)
#pragma unroll
            for (int m = 0; m < 4; ++m) { bf16_t* rowp = base + (size_t)(row0 + ai * HALF + m * 16) * ldc + col0;
#pragma unroll
                for (int bj = 0; bj < 2; ++bj) { f32x4 v0 = acc[ai][bj][m][0] + bv[bj][0], v1 = acc[ai][bj][m][1] + bv[bj][1];
                    if (ACT == 1) { f32x2 a = gelu_pk((f32x2){v0[0], v0[1]}), b = gelu_pk((f32x2){v0[2], v0[3]}), c = gelu_pk((f32x2){v1[0], v1[1]}), d = gelu_pk((f32x2){v1[2], v1[3]});
                        v0 = (f32x4){a.x, a.y, b.x, b.y}; v1 = (f32x4){c.x, c.y, d.x, d.y}; }
                    v0 = v0 * sc; v1 = v1 * sc; u32x4 w; w.x = cvt_pk_bf16(v0[0], v0[1]); w.y = cvt_pk_bf16(v0[2], v0[3]); w.z = cvt_pk_bf16(v1[0], v1[1]); w.w = cvt_pk_bf16(v1[2], v1[3]);
                    *(u32x4*)(rowp + bj * HALF) = w; } }
    }
};

struct PanelStats {
    unsigned* xbuf;
    unsigned* cnt;
    unsigned* tmo;
    int ntn; float eps;
    unsigned code;
    __device__ __forceinline__ bool run(const f32x4 (&v)[2][2][4][2], const Unit& u, int wr, int wc, int fr, int fq, PG8_LAS unsigned char* lds, int wid, int lane) const {
        typedef float f32x2v __attribute__((ext_vector_type(2)));
        PG8_LAS f32x2v* P = (PG8_LAS f32x2v*)lds;
        PG8_LAS f32x2v* S = (PG8_LAS f32x2v*)(lds + 8192);
        PG8_LAS unsigned* flag = (PG8_LAS unsigned*)(lds + 8192 + 2048);
#pragma unroll
        for (int ai = 0; ai < 2; ++ai)
#pragma unroll
            for (int m = 0; m < 4; ++m) {
                float s = 0.f;
#pragma unroll
                for (int bj = 0; bj < 2; ++bj)
#pragma unroll
                    for (int n = 0; n < 2; ++n) { const f32x4 x = v[ai][bj][m][n]; s += (x[0] + x[1]) + (x[2] + x[3]); }
                s += __shfl_xor(s, 16); s += __shfl_xor(s, 32);
                const float mw = s * (1.0f / 64.0f); float q = 0.f;
#pragma unroll
                for (int bj = 0; bj < 2; ++bj)
#pragma unroll
                    for (int n = 0; n < 2; ++n) { const f32x4 d = v[ai][bj][m][n] - mw; q += (d[0] * d[0] + d[1] * d[1]) + (d[2] * d[2] + d[3] * d[3]); }
                q += __shfl_xor(q, 16); q += __shfl_xor(q, 32);
                if (fq == 0) P[(ai * HALF + wr * 64 + m * 16 + fr) * 4 + wc] = (f32x2v){mw, q};
            }
        asm volatile("s_waitcnt lgkmcnt(0)" ::: "memory"); __builtin_amdgcn_s_barrier(); asm volatile("" ::: "memory");
#if defined(BROKEN_EXCHANGE_NO_WAIT)
#warning BROKEN CONTROL BUILD: the row-statistics exchange does not wait; results are wrong by design
        if (blockIdx.x >= 64) { const long long t0_ = clock64(); while (clock64() - t0_ < 60000) __builtin_amdgcn_s_sleep(8); }
#endif
        const int row = wid * 32 + (lane & 31);
        if (lane < 32) {
            const f32x2v a = P[row * 4 + 0], b = P[row * 4 + 1], c = P[row * 4 + 2], d = P[row * 4 + 3];
            const float mt = (a.x + b.x + c.x + d.x) * 0.25f;
            const float da = a.x - mt, db = b.x - mt, dc = c.x - mt, dd = d.x - mt;
            const float m2 = (a.y + b.y) + (c.y + d.y) + 64.0f * ((da * da + db * db) + (dc * dc + dd * dd));
            unsigned long long* slot = (unsigned long long*)xbuf + ((size_t)(u.pm * BM + row) * 4 + u.pn);
            __hip_atomic_store(slot, ((unsigned long long)__float_as_uint(m2) << 32) | __float_as_uint(mt), __ATOMIC_RELAXED, __HIP_MEMORY_SCOPE_AGENT);
        }
        asm volatile("s_waitcnt vmcnt(0)" ::: "memory");
        if (lane == 0) __hip_atomic_fetch_add(cnt + 64 * u.pm, 1u, __ATOMIC_RELAXED, __HIP_MEMORY_SCOPE_AGENT);
        if (wid == 0) {
            bool dead = false; const unsigned long long t0 = __builtin_amdgcn_s_memrealtime(); const unsigned want = 8u * (unsigned)ntn;
            for (;;) {
#if defined(BROKEN_EXCHANGE_NO_WAIT)
                break;
#endif
                if ((unsigned)__builtin_amdgcn_readfirstlane(__hip_atomic_load(cnt + 64 * u.pm, __ATOMIC_RELAXED, __HIP_MEMORY_SCOPE_AGENT)) >= want) break;
                if (__builtin_amdgcn_s_memrealtime() - t0 > 2000000ull) {
                    if (lane == 0) { unsigned expect = 0u; __hip_atomic_compare_exchange_strong(tmo + 1, &expect, code | (unsigned)(u.pm & 0xff), __ATOMIC_RELAXED, __ATOMIC_RELAXED, __HIP_MEMORY_SCOPE_AGENT);
                                     __hip_atomic_store(tmo, 1u, __ATOMIC_RELAXED, __HIP_MEMORY_SCOPE_AGENT); }
                    dead = true; break; }
                __builtin_amdgcn_s_sleep(2);
            }
            __builtin_amdgcn_fence(__ATOMIC_ACQUIRE, "agent");
            if (lane == 0) flag[0] = dead ? 1u : 0u;
        }
        asm volatile("s_waitcnt vmcnt(0) lgkmcnt(0)" ::: "memory"); __builtin_amdgcn_s_barrier(); asm volatile("" ::: "memory");
        const bool bad = flag[0] != 0u;
        if (lane < 32) {
            const unsigned long long* slot = (const unsigned long long*)xbuf + (size_t)(u.pm * BM + row) * 4; float mt[4], m2[4]; float ms = 0.f;
#pragma unroll
            for (int t = 0; t < 4; ++t) { if (t < ntn) { const unsigned long long w = __hip_atomic_load(slot + t, __ATOMIC_RELAXED, __HIP_MEMORY_SCOPE_AGENT); mt[t] = __uint_as_float((unsigned)w); m2[t] = __uint_as_float((unsigned)(w >> 32)); } else { mt[t] = 0.f; m2[t] = 0.f; } ms += mt[t]; }
            const float mean = ms / (float)ntn; float q = 0.f;
#pragma unroll
            for (int t = 0; t < 4; ++t) if (t < ntn) { const float dm = mt[t] - mean; q += m2[t] + 256.0f * dm * dm; }
            S[row] = (f32x2v){mean, 1.0f / sqrtf(q / (256.0f * (float)ntn) + eps)};
        }
        asm volatile("s_waitcnt lgkmcnt(0)" ::: "memory"); __builtin_amdgcn_s_barrier(); asm volatile("" ::: "memory");
        return bad;
    }
};
struct EpiLnRes {
    static constexpr bool PERM = false, AFTER_DRAIN = true;
    const float* base; float* out; int ldc; const float* bias; PanelStats st; unsigned poison;
    __device__ __forceinline__ void fused(f32x4 (&acc)[2][2][4][2], const Unit& u, int wr, int wc, int fr, int fq, PG8_LAS unsigned char* lds, int wid, int lane) const {
        typedef float f32x2v __attribute__((ext_vector_type(2)));
        const PG8_LAS f32x2v* S = (const PG8_LAS f32x2v*)(lds + 8192);
        const int col0 = u.pn * BM + wc * 32 + 4 * fq;
#pragma unroll
        for (int bj = 0; bj < 2; ++bj)
#pragma unroll
            for (int n = 0; n < 2; ++n) { const f32x4 bv = bias ? *(const f32x4*)(bias + col0 + bj * HALF + n * 16) : (f32x4){0.f, 0.f, 0.f, 0.f};
#pragma unroll
                for (int ai = 0; ai < 2; ++ai)
#pragma unroll
                    for (int m = 0; m < 4; ++m) acc[ai][bj][m][n] += bv; }
        f32x4 pre[4][2][2];
#pragma unroll
        for (int m = 0; m < 4; ++m) { const size_t off = (size_t)(u.pm * BM + wr * 64 + m * 16 + fr) * ldc + col0;
#pragma unroll
            for (int bj = 0; bj < 2; ++bj)
#pragma unroll
                for (int n = 0; n < 2; ++n) pre[m][bj][n] = *(const f32x4*)(base + off + bj * HALF + n * 16); }
        const bool bad = st.run(acc, u, wr, wc, fr, fq, lds, wid, lane) || poison != 0u;
        const float qnan = __builtin_nanf("");
#pragma unroll
        for (int ai = 0; ai < 2; ++ai)
#pragma unroll
            for (int m = 0; m < 4; ++m) { const int r = ai * HALF + wr * 64 + m * 16 + fr; const f32x2v sr = S[r]; const size_t off = (size_t)(u.pm * BM + r) * ldc + col0;
#pragma unroll
                for (int bj = 0; bj < 2; ++bj)
#pragma unroll
                    for (int n = 0; n < 2; ++n) { const f32x4 bs = ai == 0 ? pre[m][bj][n] : *(const f32x4*)(base + off + bj * HALF + n * 16); f32x4 o = bs + (acc[ai][bj][m][n] - sr.x) * sr.y;
                        if (bad) o = (f32x4){qnan, qnan, qnan, qnan}; *(f32x4*)(out + off + bj * HALF + n * 16) = o; }
                if (m & 1) asm volatile("" ::: "memory"); }
    }
};
struct EpiLnResLn {
    static constexpr bool PERM = false, AFTER_DRAIN = true;
    const float* base; float* out; bf16_t* xn; int ldc; const float* bias; PanelStats st1, st2; unsigned poison;
    __device__ __forceinline__ void fused(f32x4 (&acc)[2][2][4][2], const Unit& u, int wr, int wc, int fr, int fq, PG8_LAS unsigned char* lds, int wid, int lane) const {
        typedef float f32x2v __attribute__((ext_vector_type(2))); typedef unsigned u32x2v __attribute__((ext_vector_type(2)));
        const PG8_LAS f32x2v* S = (const PG8_LAS f32x2v*)(lds + 8192);
        const int col0 = u.pn * BM + wc * 32 + 4 * fq;
#pragma unroll
        for (int bj = 0; bj < 2; ++bj)
#pragma unroll
            for (int n = 0; n < 2; ++n) { const f32x4 bv = bias ? *(const f32x4*)(bias + col0 + bj * HALF + n * 16) : (f32x4){0.f, 0.f, 0.f, 0.f};
#pragma unroll
                for (int ai = 0; ai < 2; ++ai)
#pragma unroll
                    for (int m = 0; m < 4; ++m) acc[ai][bj][m][n] += bv; }
        bool bad = st1.run(acc, u, wr, wc, fr, fq, lds, wid, lane) || poison != 0u;
        const float qnan = __builtin_nanf("");
#pragma unroll
        for (int ai = 0; ai < 2; ++ai)
#pragma unroll
            for (int m = 0; m < 4; ++m) { const int r = ai * HALF + wr * 64 + m * 16 + fr; const f32x2v sr = S[r]; const size_t off = (size_t)(u.pm * BM + r) * ldc + col0;
#pragma unroll
                for (int bj = 0; bj < 2; ++bj)
#pragma unroll
                    for (int n = 0; n < 2; ++n) { const f32x4 bs = *(const f32x4*)(base + off + bj * HALF + n * 16); acc[ai][bj][m][n] = bs + (acc[ai][bj][m][n] - sr.x) * sr.y; }
                asm volatile("" : "+v"(acc[ai][0][m][0]), "+v"(acc[ai][0][m][1]), "+v"(acc[ai][1][m][0]), "+v"(acc[ai][1][m][1]));
                if (m & 1) asm volatile("" ::: "memory"); }
        const bool bad1 = bad;
        bad = st2.run(acc, u, wr, wc, fr, fq, lds, wid, lane) || bad;
#pragma unroll
        for (int ai = 0; ai < 2; ++ai)
#pragma unroll
            for (int m = 0; m < 4; ++m) { const int r = ai * HALF + wr * 64 + m * 16 + fr; const f32x2v sr = S[r]; const size_t off = (size_t)(u.pm * BM + r) * ldc + col0;
#pragma unroll
                for (int bj = 0; bj < 2; ++bj)
#pragma unroll
                    for (int n = 0; n < 2; ++n) { const f32x4 x1 = acc[ai][bj][m][n]; *(f32x4*)(out + off + bj * HALF + n * 16) = bad1 ? (f32x4){qnan, qnan, qnan, qnan} : x1;
                        const f32x4 o = (x1 - sr.x) * sr.y; u32x2v w; w.x = cvt_pk_bf16(o[0], o[1]); w.y = cvt_pk_bf16(o[2], o[3]);
                        if (bad) { w.x = 0x7fc07fc0u; w.y = 0x7fc07fc0u; } *(u32x2v*)(xn + off + bj * HALF + n * 16) = w; }
                asm volatile("" ::: "memory"); }
    }
};

template <class Epi, class Sched, bool ALIGN_EPI = false, bool SP2 = false>
__device__ __forceinline__ void gemm_phase(PG8_LAS unsigned char* lds, const Gemm g, const Sched& S, const Epi& E) {
    int tid_ = threadIdx.x; asm volatile("" : "+v"(tid_));
    const int tid = tid_, wid = __builtin_amdgcn_readfirstlane(tid >> 6), lane = tid & 63, wr = wid >> 2, wc = wid & 3, fr = lane & 15, fq = lane >> 4;
    const int K = g.K, nt = K / BK;
    unsigned voffA[2], voffB[2];
#pragma unroll
    for (int i = 0; i < 2; ++i) { int R, C; stage_rc(tid * 16 + i * 8192, R, C); const int Rb = Epi::PERM ? ((R & ~31) + perm32(R & 31)) : R;
        voffA[i] = (unsigned)(R * K + C) * 2u; voffB[i] = (unsigned)(Rb * K + C) * 2u; }
    const size_t kstep = (size_t)(BK * 2);
    const size_t hstep = (size_t)HALF * K * 2;
    const size_t tstep = 2 * hstep;
    const unsigned ldsw = (unsigned)wid * 1024u;
    const int aoff = lds_byte(wr * 64 + fr, fq * 8), boff = lds_byte(wc * 32 + fr, fq * 8);
#define PG8_SA(b, h) (((b) * 2 + (h)) * HTB)
#define PG8_SB(b, h) ((4 + (b) * 2 + (h)) * HTB)
#define PG8_STAGE(bufoff, gbase, voff) do { _Pragma("unroll") for (int _i = 0; _i < 2; ++_i) \
        __builtin_amdgcn_global_load_lds((const unsigned*)((const char*)(gbase) + (voff)[_i]), (PG8_LAS unsigned*)(lds + (bufoff) + ldsw + _i * 8192), 16, 0, 0); } while (0)
#define PG8_LDA(dst, b, h) do { _Pragma("unroll") for (int m = 0; m < 4; ++m) _Pragma("unroll") for (int k = 0; k < 2; ++k) dst[m][k] = *(const PG8_LAS bf16x8*)(lds + PG8_SA(b, h) + aoff + m * 2048 + k * 1024); } while (0)
#define PG8_LDB(dst, b, h) do { _Pragma("unroll") for (int n = 0; n < 2; ++n) _Pragma("unroll") for (int k = 0; k < 2; ++k) dst[n][k] = *(const PG8_LAS bf16x8*)(lds + PG8_SB(b, h) + boff + n * 2048 + k * 1024); } while (0)
#define PG8_MMA(ai, bj, At, Bt) do { __builtin_amdgcn_s_setprio(1); _Pragma("unroll") for (int m = 0; m < 4; ++m) _Pragma("unroll") for (int n = 0; n < 2; ++n) _Pragma("unroll") for (int k = 0; k < 2; ++k) \
        acc[ai][bj][m][n] = __builtin_amdgcn_mfma_f32_16x16x32_bf16(Bt[n][k], At[m][k], acc[ai][bj][m][n], 0, 0, 0); __builtin_amdgcn_s_setprio(0); } while (0)
#define PG8_WAIT_V(n) asm volatile("s_waitcnt vmcnt(" #n ")" ::: "memory")
#define PG8_WAIT_L(n) asm volatile("s_waitcnt lgkmcnt(" #n ")" ::: "memory")
#define PG8_BAR __builtin_amdgcn_s_barrier()
#define PG8_SCHED __builtin_amdgcn_sched_barrier(0)
    Unit cur, nxt; int ui = 0;
    if (!S.next(0, cur)) return;
    f32x4 acc[2][2][4][2];
#pragma unroll
    for (int a = 0; a < 2; ++a)
#pragma unroll
        for (int b = 0; b < 2; ++b)
#pragma unroll
            for (int m = 0; m < 4; ++m)
#pragma unroll
                for (int n = 0; n < 2; ++n) acc[a][b][m][n] = (f32x4){0.f, 0.f, 0.f, 0.f};
    bf16x8 At[4][2], B0[2][2], B1[2][2];
    const char* cA = (const char*)g.A + (size_t)cur.pm * tstep; const char* cB = (const char*)g.Bt + (size_t)cur.pn * tstep;
    S.a_ready(cur);
    if constexpr (SP2) {
        PG8_STAGE(PG8_SB(0, 0), cB, voffB); PG8_STAGE(PG8_SB(0, 1), cB + hstep, voffB); PG8_STAGE(PG8_SA(0, 0), cA, voffA); PG8_STAGE(PG8_SA(0, 1), cA + hstep, voffA);
        if (wr == 1) PG8_BAR;
        PG8_WAIT_V(2); PG8_BAR;
        PG8_STAGE(PG8_SB(1, 0), cB + kstep, voffB); PG8_STAGE(PG8_SA(1, 0), cA + kstep, voffA); PG8_STAGE(PG8_SB(1, 1), cB + hstep + kstep, voffB);
        PG8_WAIT_V(6); PG8_BAR;
    } else {
        PG8_STAGE(PG8_SB(0, 0), cB, voffB); PG8_STAGE(PG8_SA(0, 0), cA, voffA); PG8_STAGE(PG8_SB(0, 1), cB + hstep, voffB); PG8_STAGE(PG8_SA(0, 1), cA + hstep, voffA);
        if (wr == 1) PG8_BAR;
        PG8_WAIT_V(4); PG8_BAR;
        PG8_STAGE(PG8_SB(1, 0), cB + kstep, voffB); PG8_STAGE(PG8_SA(1, 0), cA + kstep, voffA); PG8_STAGE(PG8_SB(1, 1), cB + hstep + kstep, voffB);
        PG8_WAIT_V(6); PG8_BAR;
    }
    for (;;) {
        const bool has_next = S.next(ui + 1, nxt);
        const char* nA = has_next ? (const char*)g.A + (size_t)nxt.pm * tstep : cA; const char* nB = has_next ? (const char*)g.Bt + (size_t)nxt.pn * tstep : cB;
        for (int t = 0; t < nt; t += 2) {
            const bool last = (t == nt - 2);
            const char* a1 = cA + (size_t)(t + 1) * kstep;
            const char* a2 = last ? nA : cA + (size_t)(t + 2) * kstep; const char* b2 = last ? nB : cB + (size_t)(t + 2) * kstep;
            const char* a3 = a2 + kstep; const char* b3 = b2 + kstep;
            if (last && has_next) S.a_ready(nxt);
            if constexpr (SP2) {
            PG8_LDB(B0, 0, 0); PG8_LDB(B1, 0, 1); PG8_SCHED; PG8_LDA(At, 0, 0); PG8_STAGE(PG8_SA(1, 1), a1 + hstep, voffA);
            PG8_WAIT_V(8); PG8_WAIT_L(0); PG8_BAR; PG8_MMA(0, 0, At, B0); PG8_MMA(0, 1, At, B1); PG8_BAR; PG8_SCHED;
            PG8_LDA(At, 0, 1); PG8_STAGE(PG8_SB(0, 0), b2, voffB); PG8_STAGE(PG8_SB(0, 1), b2 + hstep, voffB); PG8_STAGE(PG8_SA(0, 0), a2, voffA);
            PG8_WAIT_V(8); PG8_WAIT_L(0); PG8_BAR; PG8_MMA(1, 0, At, B0); PG8_MMA(1, 1, At, B1); PG8_BAR; PG8_SCHED;
            PG8_LDB(B0, 1, 0); PG8_LDB(B1, 1, 1); PG8_SCHED; PG8_LDA(At, 1, 0); PG8_STAGE(PG8_SA(0, 1), a2 + hstep, voffA);
            PG8_WAIT_V(8); PG8_WAIT_L(0); PG8_BAR; PG8_MMA(0, 0, At, B0); PG8_MMA(0, 1, At, B1); PG8_BAR; PG8_SCHED;
            PG8_LDA(At, 1, 1); PG8_STAGE(PG8_SB(1, 0), b3, voffB); PG8_STAGE(PG8_SB(1, 1), b3 + hstep, voffB); PG8_STAGE(PG8_SA(1, 0), a3, voffA);
            PG8_WAIT_V(8); PG8_WAIT_L(0); PG8_BAR; PG8_MMA(1, 0, At, B0); PG8_MMA(1, 1, At, B1); PG8_BAR; PG8_SCHED;
            } else {
            PG8_LDB(B0, 0, 0); PG8_SCHED; PG8_LDA(At, 0, 0); PG8_STAGE(PG8_SA(1, 1), a1 + hstep, voffA);
            PG8_WAIT_L(8); PG8_BAR; PG8_WAIT_L(0); PG8_MMA(0, 0, At, B0); PG8_BAR; PG8_SCHED;
            PG8_LDB(B1, 0, 1); PG8_STAGE(PG8_SB(0, 0), b2, voffB);
            PG8_BAR; PG8_WAIT_L(0); PG8_MMA(0, 1, At, B1); PG8_BAR;
            PG8_LDA(At, 0, 1); PG8_STAGE(PG8_SA(0, 0), a2, voffA);
            PG8_BAR; PG8_WAIT_L(0); PG8_MMA(1, 0, At, B0); PG8_BAR; PG8_SCHED;
            PG8_STAGE(PG8_SB(0, 1), b2 + hstep, voffB);
            PG8_WAIT_V(6); PG8_BAR; PG8_MMA(1, 1, At, B1); PG8_BAR;
            PG8_LDB(B0, 1, 0); PG8_SCHED; PG8_LDA(At, 1, 0); PG8_STAGE(PG8_SA(0, 1), a2 + hstep, voffA);
            PG8_WAIT_L(8); PG8_BAR; PG8_WAIT_L(0); PG8_MMA(0, 0, At, B0); PG8_BAR; PG8_SCHED;
            PG8_LDB(B1, 1, 1); PG8_STAGE(PG8_SB(1, 0), b3, voffB);
            PG8_BAR; PG8_WAIT_L(0); PG8_MMA(0, 1, At, B1); PG8_BAR;
            PG8_LDA(At, 1, 1); PG8_STAGE(PG8_SA(1, 0), a3, voffA);
            PG8_BAR; PG8_WAIT_L(0); PG8_MMA(1, 0, At, B0); PG8_BAR; PG8_SCHED;
            PG8_STAGE(PG8_SB(1, 1), b3 + hstep, voffB);
            PG8_WAIT_V(6); PG8_BAR; PG8_MMA(1, 1, At, B1); PG8_BAR;
            }
        }
        if constexpr (ALIGN_EPI) { if (wr == 0) PG8_BAR; }
        if constexpr (!Epi::AFTER_DRAIN) { E(acc, cur, wr, wc, fr, fq); S.done(cur); }
        if (!has_next) break;
#pragma unroll
        for (int a = 0; a < 2; ++a)
#pragma unroll
            for (int b = 0; b < 2; ++b)
#pragma unroll
                for (int m = 0; m < 4; ++m)
#pragma unroll
                    for (int n = 0; n < 2; ++n) acc[a][b][m][n] = (f32x4){0.f, 0.f, 0.f, 0.f};
        cur = nxt; cA = nA; cB = nB; ++ui;
        if constexpr (ALIGN_EPI) { if (wr == 1) PG8_BAR; }
    }
    PG8_WAIT_V(0);
    if constexpr (!ALIGN_EPI) { if (wr == 0) PG8_BAR; }
    PG8_BAR;
    if constexpr (Epi::AFTER_DRAIN) { E.fused(acc, cur, wr, wc, fr, fq, lds, wid, lane); S.done(cur); }
#undef PG8_SA
#undef PG8_SB
#undef PG8_STAGE
#undef PG8_LDA
#undef PG8_LDB
#undef PG8_MMA
#undef PG8_WAIT_V
#undef PG8_WAIT_L
#undef PG8_BAR
#undef PG8_SCHED
}
}

#ifndef PG8_SP2
#define PG8_SP2 true
#endif
#ifndef PG8_ALIGN
#define PG8_ALIGN true
#endif
namespace pg8 {
typedef unsigned u32x2 __attribute__((ext_vector_type(2)));
#define PG8_GAS __attribute__((address_space(1)))
constexpr float RMS_EPS = 1e-6f;
constexpr int SS_ROWS = 16384;
__device__ __forceinline__ void row_rs8(float (&rs)[8], const float* ssp, int npart, int row0, int fq) {
    const PG8_GAS float* sp = (const PG8_GAS float*)ssp; float pr[8][4];
#pragma unroll
    for (int r = 0; r < 8; ++r)
#pragma unroll
        for (int i = 0; i < 4; ++i) { const int j = fq * 4 + i; pr[r][i] = sp[(size_t)(j < npart ? j : 0) * SS_ROWS + row0 + (r >> 2) * HALF + (r & 3) * 16]; }
#pragma unroll
    for (int r = 0; r < 8; ++r) { float s = 0.f;
#pragma unroll
        for (int i = 0; i < 4; ++i) s += (fq * 4 + i < npart) ? pr[r][i] : 0.f;
        s += __shfl_xor(s, 16); s += __shfl_xor(s, 32);
        rs[r] = rsqrtf(s * (1.0f / 1024.0f) + RMS_EPS); }
}
struct EpiSwiGLU {
    static constexpr bool PERM = true, AFTER_DRAIN = false;
    bf16_t* O; int ldc; const float* ss; int npart;
    __device__ __forceinline__ void operator()(const f32x4 (&acc)[2][2][4][2], const Unit& u, int wr, int wc, int fr, int fq) const {
        const int row0 = u.pm * BM + wr * 64 + fr, col0 = u.pn * HALF + wc * 32 + 8 * fq;
        float rsv[8]; row_rs8(rsv, ss, npart, row0, fq);
#pragma unroll
        for (int ai = 0; ai < 2; ++ai)
#pragma unroll
            for (int m = 0; m < 4; ++m) {
                const int row = row0 + ai * HALF + m * 16; const float rs = rsv[ai * 4 + m];
                float h[8];
#pragma unroll
                for (int n = 0; n < 2; ++n)
#pragma unroll
                    for (int i = 0; i < 4; ++i) { const float g = acc[ai][0][m][n][i] * rs, up = acc[ai][1][m][n][i] * rs; h[n * 4 + i] = g * __builtin_amdgcn_rcpf(1.0f + __expf(-g)) * up; }
                u32x4 w; w.x = cvt_pk_bf16(h[0], h[1]); w.y = cvt_pk_bf16(h[2], h[3]); w.z = cvt_pk_bf16(h[4], h[5]); w.w = cvt_pk_bf16(h[6], h[7]);
                *(PG8_GAS u32x4*)(O + (size_t)row * ldc + col0) = w;
            }
    }
};
struct EpiScaleBf16 {
    static constexpr bool PERM = true, AFTER_DRAIN = false;
    bf16_t* O; int ldc; const float* ss; int npart;
    __device__ __forceinline__ void operator()(const f32x4 (&acc)[2][2][4][2], const Unit& u, int wr, int wc, int fr, int fq) const {
        const int row0 = u.pm * BM + wr * 64 + fr, col0 = u.pn * BM + wc * 32 + 8 * fq;
        float rsv[8]; row_rs8(rsv, ss, npart, row0, fq);
#pragma unroll
        for (int ai = 0; ai < 2; ++ai)
#pragma unroll
            for (int m = 0; m < 4; ++m) {
                const int row = row0 + ai * HALF + m * 16; const float rs = rsv[ai * 4 + m];
#pragma unroll
                for (int bj = 0; bj < 2; ++bj) { const f32x4 v0 = acc[ai][bj][m][0] * rs, v1 = acc[ai][bj][m][1] * rs;
                    u32x4 w; w.x = cvt_pk_bf16(v0[0], v0[1]); w.y = cvt_pk_bf16(v0[2], v0[3]); w.z = cvt_pk_bf16(v1[0], v1[1]); w.w = cvt_pk_bf16(v1[2], v1[3]);
                    *(PG8_GAS u32x4*)(O + (size_t)row * ldc + col0 + bj * HALF) = w; }
            }
    }
};
struct EpiResid {
    static constexpr bool PERM = false, AFTER_DRAIN = false;
    const float* base32; const bf16_t* baseb; bf16_t* xb; float* ssn; float scale;
    __device__ __forceinline__ void operator()(const f32x4 (&acc)[2][2][4][2], const Unit& u, int wr, int wc, int fr, int fq) const {
        const int col0 = u.pn * BM + wc * 32 + 4 * fq;
#pragma unroll
        for (int ai = 0; ai < 2; ++ai) {
            f32x4 b[4][2][2];
            if (base32) {
#pragma unroll
                for (int m = 0; m < 4; ++m) { const size_t off = (size_t)(u.pm * BM + ai * HALF + wr * 64 + m * 16 + fr) * 1024 + col0;
#pragma unroll
                    for (int bj = 0; bj < 2; ++bj)
#pragma unroll
                        for (int n = 0; n < 2; ++n) b[m][bj][n] = *(const PG8_GAS f32x4*)(base32 + off + bj * HALF + n * 16); }
            } else {
                u32x2 w[4][2][2];
#pragma unroll
                for (int m = 0; m < 4; ++m) { const size_t off = (size_t)(u.pm * BM + ai * HALF + wr * 64 + m * 16 + fr) * 1024 + col0;
#pragma unroll
                    for (int bj = 0; bj < 2; ++bj)
#pragma unroll
                        for (int n = 0; n < 2; ++n) w[m][bj][n] = *(const PG8_GAS u32x2*)(baseb + off + bj * HALF + n * 16); }
#pragma unroll
                for (int m = 0; m < 4; ++m)
#pragma unroll
                    for (int bj = 0; bj < 2; ++bj)
#pragma unroll
                        for (int n = 0; n < 2; ++n) { const u32x2 x = w[m][bj][n]; b[m][bj][n] = (f32x4){__uint_as_float(x.x << 16), __uint_as_float(x.x & 0xffff0000u), __uint_as_float(x.y << 16), __uint_as_float(x.y & 0xffff0000u)}; }
            }
#pragma unroll
            for (int m = 0; m < 4; ++m) {
                const int row = u.pm * BM + ai * HALF + wr * 64 + m * 16 + fr; const size_t off = (size_t)row * 1024 + col0; float s = 0.f;
#pragma unroll
                for (int bj = 0; bj < 2; ++bj)
#pragma unroll
                    for (int n = 0; n < 2; ++n) { const f32x4 v = b[m][bj][n] + acc[ai][bj][m][n] * scale; s += (v[0] * v[0] + v[1] * v[1]) + (v[2] * v[2] + v[3] * v[3]);
                        u32x2 w2; w2.x = cvt_pk_bf16(v[0], v[1]); w2.y = cvt_pk_bf16(v[2], v[3]); *(PG8_GAS u32x2*)(xb + off + bj * HALF + n * 16) = w2; }
                s += __shfl_xor(s, 16); s += __shfl_xor(s, 32);
                if (fq == 0) ((PG8_GAS float*)ssn)[(size_t)(u.pn * 4 + wc) * SS_ROWS + row] = s;
            }
        }
    }
};
}
#define GAS __attribute__((address_space(1)))
#define LAS __attribute__((address_space(3)))
typedef unsigned short bf16;
typedef unsigned v4u __attribute__((ext_vector_type(4)));
typedef float f32x4 __attribute__((ext_vector_type(4)));
typedef short bf16x8 __attribute__((ext_vector_type(8)));
typedef GAS unsigned gu32;
typedef GAS unsigned long long gu64;
#define RLX_AGENT __ATOMIC_RELAXED, __HIP_MEMORY_SCOPE_AGENT
#define LDS_WAIT() asm volatile("s_waitcnt lgkmcnt(0)" ::: "memory")
#define VM_WAIT() asm volatile("s_waitcnt vmcnt(0)" ::: "memory")
__device__ __forceinline__ unsigned long long rt() { return __builtin_amdgcn_s_memrealtime(); }
__device__ __forceinline__ unsigned f2bf(float f) { unsigned u = __builtin_bit_cast(unsigned, f); return (u + 0x7fffu + ((u >> 16) & 1u)) >> 16; }
__device__ __forceinline__ unsigned pk2(float lo, float hi) { return f2bf(lo) | (f2bf(hi) << 16); }

#define XB_TMO      128
#define XB_XCNT(j)  (256  + 64 * (j))
#define XB_XSUB(j)  (1280 + 64 * (j))
#define XB_XGEN(j)  (2304 + 64 * (j))
#define XB_TOP      3328
#define XB_TOPGEN   3392
#define XCD_BAR_WORDS 3456
#define XB_SPIN_CAP (1u << 18)

__device__ __forceinline__ unsigned xb_ld(unsigned* p)              { return __hip_atomic_load(p, __ATOMIC_RELAXED, __HIP_MEMORY_SCOPE_AGENT); }
__device__ __forceinline__ unsigned xb_add(unsigned* p, unsigned v) { return __hip_atomic_fetch_add(p, v, __ATOMIC_RELAXED, __HIP_MEMORY_SCOPE_AGENT); }
__device__ __forceinline__ unsigned xb_xcc_id() { return (unsigned)__builtin_amdgcn_s_getreg((3 << 11) | 20) & 0xFu; }
#define XB_SPIN(cond, bar) do { unsigned _sp = 0; while (cond) { __builtin_amdgcn_s_sleep(1); \
    if ((++_sp & 255u) == 0u) { if (xb_ld(&(bar)[XB_TMO])) break; if (_sp > XB_SPIN_CAP) { atomicAdd(&(bar)[XB_TMO], 1u); break; } } } } while (0)

struct XcdBarrier {
    unsigned* bar; unsigned x;
    volatile LAS unsigned* st;
};

__device__ __forceinline__ XcdBarrier xcd_barrier_post(unsigned* bar, volatile LAS unsigned* st) {
    XcdBarrier b; b.bar = bar; b.x = xb_xcc_id(); b.st = st;
    if (threadIdx.x == 0) (void)xb_add(&bar[XB_XCNT(b.x)], 1u);
    return b;
}
__device__ __forceinline__ void xcd_barrier_complete(unsigned* bar, unsigned x, unsigned& nloc, unsigned& nx) {
    const unsigned G = gridDim.x * gridDim.y * gridDim.z;
    unsigned sum, cnt, mine, sp = 0u;
    for (;;) {
        sum = 0u; cnt = 0u; mine = 0u;
#pragma unroll
        for (unsigned j = 0; j < 16; ++j) { const unsigned c = xb_ld(&bar[XB_XCNT(j)]); sum += c; cnt += (c > 0u) ? 1u : 0u; mine = (j == x) ? c : mine; }
        if (sum == G) break;
        __builtin_amdgcn_s_sleep(1);
        if ((++sp & 255u) == 0u) { if (xb_ld(&bar[XB_TMO])) break; if (sp > XB_SPIN_CAP) { atomicAdd(&bar[XB_TMO], 1u); break; } }
    }
    nloc = mine > 0u ? mine : 1u; nx = cnt > 0u ? cnt : 1u;
}

__device__ __forceinline__ void xcd_barrier(const XcdBarrier& b) {
    asm volatile("s_waitcnt vmcnt(0)" ::: "memory");
    __syncthreads();
    if (threadIdx.x == 0) {
        unsigned* bar = b.bar;
        __builtin_amdgcn_s_waitcnt(0);
        unsigned nloc = b.st[0], nx = b.st[1];
        if (nloc == 0u) { xcd_barrier_complete(bar, b.x, nloc, nx); b.st[0] = nloc; b.st[1] = nx; }
        const unsigned old = xb_add(&bar[XB_XSUB(b.x)], 1u);
        const unsigned gen = old / nloc;
        if (old + 1u == (gen + 1u) * nloc) {
            __builtin_amdgcn_fence(__ATOMIC_RELEASE, "agent");
            asm volatile("s_waitcnt vmcnt(0)" ::: "memory");
            const unsigned og = xb_add(&bar[XB_TOP], 1u);
            const unsigned tg = og / nx;
            if (og + 1u == (tg + 1u) * nx) xb_add(&bar[XB_TOPGEN], 1u);
            else XB_SPIN(xb_ld(&bar[XB_TOPGEN]) == tg, bar);
            __builtin_amdgcn_fence(__ATOMIC_ACQUIRE, "agent");
            xb_add(&bar[XB_XGEN(b.x)], 1u);
            asm volatile("s_waitcnt vmcnt(0)" ::: "memory");
        } else {
            XB_SPIN(xb_ld(&bar[XB_XGEN(b.x)]) == gen, bar);
            __builtin_amdgcn_fence(__ATOMIC_ACQUIRE, "agent");
            asm volatile("s_waitcnt vmcnt(0)" ::: "memory");
        }
    }
    __syncthreads();
}
constexpr int NWAVES = 8;
constexpr int BATCH = 2, SEQ = 8192, D = 1024, M = BATCH * SEQ, FF = 2816, HD = 64, HYB = 3584, SBW = 3072;
constexpr size_t MiB = 1u << 20;
constexpr size_t WS_CTL = 0, CTL_ZERO_BYTES = 1 * MiB;
constexpr size_t WS_W = 1 * MiB;
constexpr size_t WS_XBA = 43 * MiB, WS_XBB = 75 * MiB;
constexpr size_t WS_BIG = 107 * MiB;
constexpr size_t WS_KV = 219 * MiB;
constexpr size_t WS_ST = 235 * MiB;
constexpr size_t WS_TAB = 243 * MiB;
constexpr size_t WS_SS = 246 * MiB;
constexpr size_t WS_LSE = 247 * MiB;
constexpr size_t WS_SSP = 248 * MiB;
constexpr size_t WO_F1IN = 0, WO_F1OUT = 5767168, WO_MIXIN = 8650752, WO_MIXOUT = 12320768, WO_F2IN = 13369344, WO_F2OUT = 19136512;
constexpr int CW_BAR = 4096;
constexpr int RING_OFF = 0, RING_BYTES = 131072, LDSCTL_OFF = RING_BYTES, MISC_OFF = LDSCTL_OFF + 320, LDS_BYTES = 147456;

__device__ __forceinline__ float wave_sum(float v) {
#pragma unroll
    for (int o = 1; o < 64; o <<= 1) v += __shfl_xor(v, o);
    return v;
}
__device__ __forceinline__ float bf2f(bf16 v) { return __uint_as_float(((unsigned)v) << 16); }

__device__ __forceinline__ void transpose_item(const float* W, const float* gain, int K, int N, bf16* WT, int dest_row0, int k0, int n0, LAS float* scr, int lane) {
    float wv[32];
#pragma unroll
    for (int i = 0; i < 32; ++i) wv[i] = ((const GAS float*)W)[(size_t)(k0 + 2 * i + (lane >> 5)) * N + n0 + (lane & 31)];
#pragma unroll
    for (int i = 0; i < 32; ++i) { const int kk = 2 * i + (lane >> 5); const float gk = gain ? gain[k0 + kk] : 1.0f; scr[kk * 33 + (lane & 31)] = wv[i] * gk; }
    LDS_WAIT(); asm volatile("" ::: "memory");
    const int c = lane & 7;
#pragma unroll
    for (int j = 0; j < 4; ++j) { const int n = (lane >> 3) + 8 * j; const LAS float* s = scr + (8 * c) * 33 + n;
        v4u o; o.x = pk2(s[0 * 33], s[1 * 33]); o.y = pk2(s[2 * 33], s[3 * 33]); o.z = pk2(s[4 * 33], s[5 * 33]); o.w = pk2(s[6 * 33], s[7 * 33]);
        *(GAS v4u*)(WT + (size_t)(dest_row0 + n) * K + k0 + 8 * c) = o; }
    LDS_WAIT(); asm volatile("" ::: "memory");
}
struct Args { const float* in[14]; float* out; unsigned char* ws; int ph_lo, ph_hi, li, mask; };

__device__ __forceinline__ void convert_layer(const Args& a, int l, LAS float* scr, int gw, int NGW, int lane) {
    bf16* Wb = (bf16*)(a.ws + WS_W);
    const int mixN = l == 0 ? HYB : SBW;
    const int I_IN = (D / 64) * (2 * FF / 32), I_OUT = (FF / 64) * (D / 32), I_MI = (D / 64) * (mixN / 32), I_MO = (D / 64) * (D / 32);
    const int NITEMS = 2 * I_IN + 2 * I_OUT + I_MI + I_MO;
    for (int it = gw; it < NITEMS; it += NGW) {
        int r = it; const float* W; const float* gain = nullptr; int K, N; bf16* WT; bool swi = false;
        if (r < I_IN) { W = a.in[2] + (size_t)l * D * 2 * FF; gain = a.in[1] + l * D; K = D; N = 2 * FF; WT = Wb + WO_F1IN; swi = true; }
        else if ((r -= I_IN) < I_IN) { W = a.in[6] + (size_t)l * D * 2 * FF; gain = a.in[5] + l * D; K = D; N = 2 * FF; WT = Wb + WO_F2IN; swi = true; }
        else if ((r -= I_IN) < I_OUT) { W = a.in[3] + (size_t)l * FF * D; K = FF; N = D; WT = Wb + WO_F1OUT; }
        else if ((r -= I_OUT) < I_OUT) { W = a.in[7] + (size_t)l * FF * D; K = FF; N = D; WT = Wb + WO_F2OUT; }
        else if ((r -= I_OUT) < I_MI) { W = l == 0 ? a.in[8] : a.in[11]; gain = a.in[4] + l * D; K = D; N = mixN; WT = Wb + WO_MIXIN; }
        else { r -= I_MI; W = l == 0 ? a.in[10] : a.in[12]; K = D; N = D; WT = Wb + WO_MIXOUT; }
        const int nblk = N / 32, kb = r / nblk, nb = r % nblk, n0 = 32 * nb; int dest = n0;
        if (swi) { const int up = n0 >= FF ? 1 : 0, j0 = n0 - up * FF; dest = (j0 / 128) * 256 + up * 128 + (j0 % 128); }
        transpose_item(W, gain, K, N, WT, dest, 64 * kb, n0, scr, lane);
    }
}
namespace mix {
typedef short bfx8 __attribute__((ext_vector_type(8)));
typedef unsigned u32x2v __attribute__((ext_vector_type(2)));
typedef unsigned short u16;
#define MFMA16(a, b, c) __builtin_amdgcn_mfma_f32_16x16x32_bf16(a, b, c, 0, 0, 0)
constexpr int QP = 72;
constexpr int OFF_Q = 0, OFF_K = 18432, OFF_V = 55296, OFF_FLAG = 89088;
constexpr float LOG2E = 1.4426950408889634f, LN2 = 0.6931471805599453f;

__device__ __forceinline__ float bfe(const v4u& a, int e) { return __uint_as_float((e & 1) ? (a[e >> 1] & 0xffff0000u) : (a[e >> 1] << 16)); }
typedef float f32x2_t __attribute__((ext_vector_type(2))); typedef __bf16 bf16x2_t __attribute__((ext_vector_type(2)));
__device__ __forceinline__ unsigned pkbf(float lo, float hi) { const f32x2_t v = {lo, hi}; const bf16x2_t b = __builtin_convertvector(v, bf16x2_t); return __builtin_bit_cast(unsigned, b); }
__device__ __forceinline__ bfx8 pack8(const f32x4& p0, const f32x4& p1) { v4u w; w.x = pkbf(p0[0], p0[1]); w.y = pkbf(p0[2], p0[3]); w.z = pkbf(p1[0], p1[1]); w.w = pkbf(p1[2], p1[3]); return __builtin_bit_cast(bfx8, w); }

template <int MODE>
__device__ __forceinline__ void stage_rows(LAS bf16* dst, const bf16* src, size_t rowStride, int nrows, int pos0, int posStride, const float* ctab, const float* stab, int tid) {
    for (int it = tid; it < nrows * 4; it += 512) {
        const int row = it >> 2, c = it & 3; const bf16* p = src + (size_t)row * rowStride;
        v4u a = *(const GAS v4u*)(p + 8 * c), b = *(const GAS v4u*)(p + 32 + 8 * c);
        if (MODE == 1) {
            const int pos = pos0 + row * posStride; const GAS f32x4* ct = (const GAS f32x4*)(ctab + pos * 32 + 8 * c); const GAS f32x4* sn = (const GAS f32x4*)(stab + pos * 32 + 8 * c);
            const f32x4 c0 = ct[0], c1 = ct[1], s0 = sn[0], s1 = sn[1]; float y1[8], y2[8];
#pragma unroll
            for (int e = 0; e < 8; ++e) { const float cs = e < 4 ? c0[e & 3] : c1[e & 3], si = e < 4 ? s0[e & 3] : s1[e & 3]; const float x1 = bfe(a, e), x2 = bfe(b, e); y1[e] = x1 * cs - x2 * si; y2[e] = x2 * cs + x1 * si; }
            a.x = pkbf(y1[0], y1[1]); a.y = pkbf(y1[2], y1[3]); a.z = pkbf(y1[4], y1[5]); a.w = pkbf(y1[6], y1[7]);
            b.x = pkbf(y2[0], y2[1]); b.y = pkbf(y2[2], y2[3]); b.z = pkbf(y2[4], y2[5]); b.w = pkbf(y2[6], y2[7]);
        }
        if (MODE == 2) {
            v4u o; o.x = __shfl_xor(a.x, 1); o.y = __shfl_xor(a.y, 1); o.z = __shfl_xor(a.z, 1); o.w = __shfl_xor(a.w, 1);
            if (c < 2) {
                const int pos = pos0 + row * posStride; const GAS f32x4* ct = (const GAS f32x4*)(ctab + pos * 8); const GAS f32x4* sn = (const GAS f32x4*)(stab + pos * 8);
                const f32x4 c0 = ct[0], c1 = ct[1], s0 = sn[0], s1 = sn[1]; float y[8];
#pragma unroll
                for (int e = 0; e < 8; ++e) { const float cs = e < 4 ? c0[e & 3] : c1[e & 3], si = e < 4 ? s0[e & 3] : s1[e & 3]; const float xo = bfe(a, e), xp = bfe(o, e); y[e] = c == 0 ? (xo * cs - xp * si) : (xo * cs + xp * si); }
                a.x = pkbf(y[0], y[1]); a.y = pkbf(y[2], y[3]); a.z = pkbf(y[4], y[5]); a.w = pkbf(y[6], y[7]);
            }
        }
        *(LAS v4u*)(dst + row * QP + 8 * c) = a; *(LAS v4u*)(dst + row * QP + 32 + 8 * c) = b;
    }
}
__device__ __forceinline__ void stage_vt(LAS bf16* dst, int pitch, int key_off, const bf16* src, size_t rowStride, int tid) {
    for (int it = tid; it < 128 * 8; it += 512) {
        const int key = it & 127, c = it >> 7; const v4u a = *(const GAS v4u*)(src + (size_t)key * rowStride + 8 * c);
#pragma unroll
        for (int e = 0; e < 8; ++e) dst[(8 * c + e) * pitch + key_off + key] = (bf16)((e & 1) ? (a[e >> 1] >> 16) : (a[e >> 1] & 0xffffu));
    }
}
struct RR { v4u a, b; };
struct TT { f32x4 c0, c1, s0, s1; };
struct VV { v4u v0, v1; };
__device__ __forceinline__ void ld_rows(RR& r, const bf16* src, size_t rowStride, int tid) { const bf16* p = src + (size_t)(tid >> 2) * rowStride + 8 * (tid & 3); r.a = *(const GAS v4u*)p; r.b = *(const GAS v4u*)(p + 32); }
__device__ __forceinline__ void st_rows(LAS bf16* dst, const RR& r, int tid) { LAS bf16* q = dst + (tid >> 2) * QP + 8 * (tid & 3); *(LAS v4u*)q = r.a; *(LAS v4u*)(q + 32) = r.b; }
__device__ __forceinline__ void ld_tab(TT& t, const float* ctab, const float* stab, int idx) { const GAS f32x4* ct = (const GAS f32x4*)(ctab + idx); const GAS f32x4* sn = (const GAS f32x4*)(stab + idx); t.c0 = ct[0]; t.c1 = ct[1]; t.s0 = sn[0]; t.s1 = sn[1]; }
__device__ __forceinline__ void rot1(RR& r, const TT& t) {
    float y1[8], y2[8];
#pragma unroll
    for (int e = 0; e < 8; ++e) { const float cs = e < 4 ? t.c0[e & 3] : t.c1[e & 3], si = e < 4 ? t.s0[e & 3] : t.s1[e & 3]; const float x1 = bfe(r.a, e), x2 = bfe(r.b, e); y1[e] = x1 * cs - x2 * si; y2[e] = x2 * cs + x1 * si; }
    r.a.x = pkbf(y1[0], y1[1]); r.a.y = pkbf(y1[2], y1[3]); r.a.z = pkbf(y1[4], y1[5]); r.a.w = pkbf(y1[6], y1[7]);
    r.b.x = pkbf(y2[0], y2[1]); r.b.y = pkbf(y2[2], y2[3]); r.b.z = pkbf(y2[4], y2[5]); r.b.w = pkbf(y2[6], y2[7]);
}
__device__ __forceinline__ void rot2(RR& r, const TT& t, int c) {
    v4u o; o.x = __shfl_xor(r.a.x, 1); o.y = __shfl_xor(r.a.y, 1); o.z = __shfl_xor(r.a.z, 1); o.w = __shfl_xor(r.a.w, 1);
    if (c < 2) { float y[8];
#pragma unroll
        for (int e = 0; e < 8; ++e) { const float cs = e < 4 ? t.c0[e & 3] : t.c1[e & 3], si = e < 4 ? t.s0[e & 3] : t.s1[e & 3]; const float xo = bfe(r.a, e), xp = bfe(o, e); y[e] = c == 0 ? (xo * cs - xp * si) : (xo * cs + xp * si); }
        r.a.x = pkbf(y[0], y[1]); r.a.y = pkbf(y[2], y[3]); r.a.z = pkbf(y[4], y[5]); r.a.w = pkbf(y[6], y[7]); }
}
__device__ __forceinline__ void ld_vt(VV& v, const bf16* src, size_t rowStride, int tid) { const bf16* p = src + (size_t)(tid & 127) * rowStride + 8 * (tid >> 7); v.v0 = *(const GAS v4u*)p; v.v1 = *(const GAS v4u*)(p + 32); }
__device__ __forceinline__ void st_vt(LAS bf16* dst, int pitch, int key_off, const VV& v, int tid) { const int key = tid & 127, c = tid >> 7;
#pragma unroll
    for (int e = 0; e < 8; ++e) { dst[(8 * c + e) * pitch + key_off + key] = (bf16)((e & 1) ? (v.v0[e >> 1] >> 16) : (v.v0[e >> 1] & 0xffffu)); dst[(8 * (c + 4) + e) * pitch + key_off + key] = (bf16)((e & 1) ? (v.v1[e >> 1] >> 16) : (v.v1[e >> 1] & 0xffffu)); }
}
__device__ __forceinline__ void stage_kt_ret(LAS bf16* dst, const bf16* src, size_t rowStride, int pos0, const float* ctab, const float* stab, float log2g, int tid) {
    { const int it = tid; const int key = it & 127, c = it >> 7; const bf16* p = src + (size_t)key * rowStride;
        const v4u a = *(const GAS v4u*)(p + 8 * c), b = *(const GAS v4u*)(p + 32 + 8 * c);
        const int pos = pos0 + key; const GAS f32x4* ct = (const GAS f32x4*)(ctab + pos * 32 + 8 * c); const GAS f32x4* sn = (const GAS f32x4*)(stab + pos * 32 + 8 * c);
        const f32x4 c0 = ct[0], c1 = ct[1], s0 = sn[0], s1 = sn[1]; const float kd = 0.125f * exp2f((float)(127 - key) * log2g);
#pragma unroll
        for (int e = 0; e < 8; ++e) { const float cs = e < 4 ? c0[e & 3] : c1[e & 3], si = e < 4 ? s0[e & 3] : s1[e & 3]; const float x1 = bfe(a, e), x2 = bfe(b, e);
            dst[(8 * c + e) * 136 + key] = (bf16)f2bf((x1 * cs - x2 * si) * kd); dst[(32 + 8 * c + e) * 136 + key] = (bf16)f2bf((x2 * cs + x1 * si) * kd); }
    }
}
__device__ __forceinline__ f32x4 st_tile(const LAS bf16* Ks, int T, const bfx8 (&qf)[2], int c16, int g) {
    f32x4 acc = (f32x4){0.f, 0.f, 0.f, 0.f};
#pragma unroll
    for (int ks = 0; ks < 2; ++ks) { const bfx8 a = *(const LAS bfx8*)(Ks + (16 * T + c16) * QP + 32 * ks + 8 * g); acc = MFMA16(a, qf[ks], acc); }
    return acc;
}
__device__ __forceinline__ void st_tiles8(const LAS bf16* Ks, int T0, const bfx8 (&qf)[2], int c16, int g, f32x4 (&out)[8]) {
    bfx8 a[8][2];
#pragma unroll
    for (int T = 0; T < 8; ++T)
#pragma unroll
        for (int ks = 0; ks < 2; ++ks) a[T][ks] = *(const LAS bfx8*)(Ks + (16 * (T0 + T) + c16) * QP + 32 * ks + 8 * g);
#pragma unroll
    for (int T = 0; T < 8; ++T) { f32x4 acc = (f32x4){0.f, 0.f, 0.f, 0.f};
#pragma unroll
        for (int ks = 0; ks < 2; ++ks) acc = MFMA16(a[T][ks], qf[ks], acc);
        out[T] = acc; }
}
__device__ __forceinline__ void pv_pair(f32x4 (&o)[4], const LAS bf16* Vs, int vp, int t0, int t1, const f32x4& p0, const f32x4& p1, int c16, int g) {
    const bfx8 pb = pack8(p0, p1); u32x2v lo[4], hi[4];
#pragma unroll
    for (int dt = 0; dt < 4; ++dt) { lo[dt] = *(const LAS u32x2v*)(Vs + (16 * dt + c16) * vp + 16 * t0 + 4 * g); hi[dt] = *(const LAS u32x2v*)(Vs + (16 * dt + c16) * vp + 16 * t1 + 4 * g); }
#pragma unroll
    for (int dt = 0; dt < 4; ++dt) { v4u av; av.x = lo[dt].x; av.y = lo[dt].y; av.z = hi[dt].x; av.w = hi[dt].y; o[dt] = MFMA16(__builtin_bit_cast(bfx8, av), pb, o[dt]); }
}

__device__ __forceinline__ void ret_kv_unit(int u, const bf16* proj, const float* rc, const float* rs, float* kv, LAS unsigned char* lds, int tid) {
    const int n = u & 63, bh = u >> 6, h = bh & 7, b = bh >> 3; const int lane = tid & 63, w = __builtin_amdgcn_readfirstlane(tid >> 6), c16 = lane & 15, g = lane >> 4;
    const float log2g = log2f(1.0f - exp2f(-5.0f - (float)h));
    const bf16* rowp = proj + (size_t)(b * SEQ + n * 128) * HYB + h * 64;
    LAS bf16* Kt = (LAS bf16*)(lds + OFF_Q); LAS bf16* Vt = (LAS bf16*)(lds + OFF_V);
    { const int key = tid & 127, c = tid >> 7; const bf16* p = rowp + 512 + (size_t)key * HYB;
        const v4u a = *(const GAS v4u*)(p + 8 * c), b2 = *(const GAS v4u*)(p + 32 + 8 * c); TT t; ld_tab(t, rc, rs, (n * 128 + key) * 32 + 8 * c); VV vv; ld_vt(vv, rowp + 1024, HYB, tid);
        const float kd = 0.125f * __builtin_amdgcn_exp2f((float)(127 - key) * log2g);
#pragma unroll
        for (int e = 0; e < 8; ++e) { const float cs = e < 4 ? t.c0[e & 3] : t.c1[e & 3], si = e < 4 ? t.s0[e & 3] : t.s1[e & 3]; const float x1 = bfe(a, e), x2 = bfe(b2, e);
            Kt[(8 * c + e) * 136 + key] = (bf16)f2bf((x1 * cs - x2 * si) * kd); Kt[(32 + 8 * c + e) * 136 + key] = (bf16)f2bf((x2 * cs + x1 * si) * kd); }
        st_vt(Vt, 136, 0, vv, tid); }
    __syncthreads();
    const int dvt = w >> 1;
#pragma unroll
    for (int i = 0; i < 2; ++i) { const int dkt = 2 * (w & 1) + i; f32x4 acc = (f32x4){0.f, 0.f, 0.f, 0.f};
#pragma unroll
        for (int ks = 0; ks < 4; ++ks) { const bfx8 a = *(const LAS bfx8*)(Vt + (16 * dvt + c16) * 136 + 32 * ks + 8 * g), bb = *(const LAS bfx8*)(Kt + (16 * dkt + c16) * 136 + 32 * ks + 8 * g); acc = MFMA16(a, bb, acc); }
        float* o = kv + ((size_t)n * 16 + bh) * 4096;
#pragma unroll
        for (int r = 0; r < 4; ++r) o[(16 * dvt + 4 * g + r) * 64 + 16 * dkt + c16] = acc[r]; }
    __syncthreads();
}
__device__ __forceinline__ void ret_scan(int chain, const float* kv, bf16* St) {
    const int h = (chain >> 12) & 7; const float cd = exp2f(128.0f * log2f(1.0f - exp2f(-5.0f - (float)h)));
    float state = 0.f; const GAS float* kvp = (const GAS float*)kv + chain; GAS bf16* stp = (GAS bf16*)St + chain;
#pragma unroll
    for (int n0 = 0; n0 < 64; n0 += 32) {
        float v[32];
#pragma unroll
        for (int i = 0; i < 32; ++i) v[i] = kvp[(size_t)(n0 + i) * 65536];
#pragma unroll
        for (int i = 0; i < 32; ++i) { stp[(size_t)(n0 + i) * 65536] = (bf16)f2bf(state); state = state * cd + v[i]; }
    }
}
__device__ __forceinline__ void ret_out_unit(int u, const bf16* proj, const float* rc, const float* rs, const bf16* St, const float* gn, bf16* cat, LAS unsigned char* lds, int tid) {
    const int n = u & 63, bh = u >> 6, h = bh & 7, b = bh >> 3; const int lane = tid & 63, w = __builtin_amdgcn_readfirstlane(tid >> 6), c16 = lane & 15, g = lane >> 4;
    const float log2g = log2f(1.0f - exp2f(-5.0f - (float)h));
    const size_t row0 = (size_t)(b * SEQ + n * 128); const bf16* rowp = proj + row0 * HYB + h * 64;
    LAS bf16* Qs = (LAS bf16*)(lds + OFF_Q); LAS bf16* Ks = (LAS bf16*)(lds + OFF_K); LAS bf16* Vs = (LAS bf16*)(lds + OFF_V);
    { RR rq, rk, rst; TT t; VV vv;
        ld_rows(rq, rowp, HYB, tid); ld_rows(rk, rowp + 512, HYB, tid); ld_tab(t, rc, rs, (n * 128 + (tid >> 2)) * 32 + 8 * (tid & 3)); ld_vt(vv, rowp + 1024, HYB, tid);
        if (tid < 256) ld_rows(rst, St + ((size_t)n * 16 + bh) * 4096, 64, tid);
        rot1(rq, t); rot1(rk, t); st_rows(Qs, rq, tid); st_rows(Ks, rk, tid); st_vt(Vs, 136, 0, vv, tid);
        if (tid < 256) st_rows(Ks + 128 * QP, rst, tid); }
    __syncthreads();
    bfx8 qf[2];
#pragma unroll
    for (int ks = 0; ks < 2; ++ks) qf[ks] = *(const LAS bfx8*)(Qs + (16 * w + c16) * QP + 32 * ks + 8 * g);
    const int qi = 16 * w + c16;
    f32x4 o[4], cr[4];
#pragma unroll
    for (int dt = 0; dt < 4; ++dt) { o[dt] = (f32x4){0.f, 0.f, 0.f, 0.f}; cr[dt] = (f32x4){0.f, 0.f, 0.f, 0.f}; }
#pragma unroll
    for (int tp = 0; tp < 4; ++tp) {
        f32x4 p[2];
#pragma unroll
        for (int i = 0; i < 2; ++i) { const int T = 2 * tp + i; const f32x4 s = st_tile(Ks, T, qf, c16, g);
#pragma unroll
            for (int r = 0; r < 4; ++r) { const int kj = 16 * T + 4 * g + r; const int dd = qi - kj; p[i][r] = dd >= 0 ? s[r] * 0.125f * __builtin_amdgcn_exp2f((float)dd * log2g) : 0.f; } }
        pv_pair(o, Vs, 136, 2 * tp, 2 * tp + 1, p[0], p[1], c16, g);
    }
#pragma unroll
    for (int dt = 0; dt < 4; ++dt) cr[dt] = st_tile(Ks, 8 + dt, qf, c16, g);
    const float qd = exp2f((float)(qi + 1) * log2g);
    float sum = 0.f;
#pragma unroll
    for (int dt = 0; dt < 4; ++dt) { o[dt] = o[dt] + cr[dt] * qd; sum += (o[dt][0] + o[dt][1]) + (o[dt][2] + o[dt][3]); }
    sum += __shfl_xor(sum, 16); sum += __shfl_xor(sum, 32);
    const float mu = sum * (1.0f / 64.0f); float var = 0.f;
#pragma unroll
    for (int dt = 0; dt < 4; ++dt) { o[dt] = o[dt] - mu; var += (o[dt][0] * o[dt][0] + o[dt][1] * o[dt][1]) + (o[dt][2] * o[dt][2] + o[dt][3] * o[dt][3]); }
    var += __shfl_xor(var, 16); var += __shfl_xor(var, 32);
    const float rstd = rsqrtf(var * (1.0f / 64.0f) + 1e-5f);
    const size_t tok = row0 + qi;
    f32x4 ggv[4]; u32x2v rgv[4];
#pragma unroll
    for (int dt = 0; dt < 4; ++dt) { const int d0 = 16 * dt + 4 * g; ggv[dt] = *(const GAS f32x4*)(gn + h * 64 + d0); rgv[dt] = *(const GAS u32x2v*)(proj + tok * HYB + 1536 + h * 64 + d0); }
#pragma unroll
    for (int dt = 0; dt < 4; ++dt) { const int d0 = 16 * dt + 4 * g; const f32x4 gg = ggv[dt]; const u32x2v rgw = rgv[dt];
        float y[4];
#pragma unroll
        for (int r = 0; r < 4; ++r) { const float gate = __uint_as_float((r & 1) ? (rgw[r >> 1] & 0xffff0000u) : (rgw[r >> 1] << 16)); y[r] = o[dt][r] * rstd * gg[r] * (gate * __builtin_amdgcn_rcpf(1.0f + __expf(-gate))); }
        u32x2v wv; wv.x = pkbf(y[0], y[1]); wv.y = pkbf(y[2], y[3]); *(GAS u32x2v*)(cat + tok * D + h * 64 + d0) = wv; }
    __syncthreads();
}

__device__ __forceinline__ void dil_unit(int u, const bf16* proj, const float* dc, const float* ds, bf16* part, float* lsep, bf16* cat, LAS unsigned char* lds, int tid) {
    const int idx = u & 63, h = (u >> 6) & 7, b = (u >> 9) & 1, p = u >> 10; const int dil = p == 0 ? 1 : (p == 1 ? 4 : 16), nper = 64 / dil, r = idx / nper, nbi = idx % nper;
    const int lane = tid & 63, w = __builtin_amdgcn_readfirstlane(tid >> 6), c16 = lane & 15, g = lane >> 4;
    const bf16* bp = proj + (size_t)b * SEQ * HYB + h * 64; const int t0 = (128 * nbi) * dil + r;
    LAS bf16* Qs = (LAS bf16*)(lds + OFF_Q); LAS bf16* Ks = (LAS bf16*)(lds + OFF_K); LAS bf16* Vs = (LAS bf16*)(lds + OFF_V);
    const size_t rstr = (size_t)dil * HYB;
    { RR rq, rk, rkp; TT t, tp_; VV vv, vvp; const int tp = t0 - 128 * dil, srow = tid >> 2, sc = tid & 3;
        ld_rows(rq, bp + (size_t)t0 * HYB + 2048, rstr, tid); ld_rows(rk, bp + (size_t)t0 * HYB + 2560, rstr, tid); ld_tab(t, dc, ds, (t0 + srow * dil) * 8); ld_vt(vv, bp + (size_t)t0 * HYB + 3072, rstr, tid);
        if (nbi > 0) { ld_rows(rkp, bp + (size_t)tp * HYB + 2560, rstr, tid); ld_tab(tp_, dc, ds, (tp + srow * dil) * 8); ld_vt(vvp, bp + (size_t)tp * HYB + 3072, rstr, tid); }
        rot2(rq, t, sc); rot2(rk, t, sc); st_rows(Qs, rq, tid); st_rows(Ks + 128 * QP, rk, tid); st_vt(Vs, 264, 128, vv, tid);
        if (nbi > 0) { rot2(rkp, tp_, sc); st_rows(Ks, rkp, tid); st_vt(Vs, 264, 0, vvp, tid); } }
    __syncthreads();
    bfx8 qf[2];
#pragma unroll
    for (int ks = 0; ks < 2; ++ks) qf[ks] = *(const LAS bfx8*)(Qs + (16 * w + c16) * QP + 32 * ks + 8 * g);
    const int qi = 16 * w + c16; const int Tlo = nbi > 0 ? w : 8, Thi = 8 + w;
    f32x4 s[16]; float m = -INFINITY;
#pragma unroll
    for (int T = 0; T < 16; ++T) { s[T] = (f32x4){-INFINITY, -INFINITY, -INFINITY, -INFINITY};
        if (T >= Tlo && T <= Thi) { const f32x4 a = st_tile(Ks, T, qf, c16, g);
#pragma unroll
            for (int rr = 0; rr < 4; ++rr) { const int kj = 16 * (T & 7) + 4 * g + rr; const bool ok = T < 8 ? (kj >= qi) : (kj <= qi); s[T][rr] = ok ? a[rr] * 0.125f : -INFINITY; m = fmaxf(m, s[T][rr]); } } }
    m = fmaxf(m, __shfl_xor(m, 16)); m = fmaxf(m, __shfl_xor(m, 32));
    float l = 0.f;
#pragma unroll
    for (int T = 0; T < 16; ++T) {
        if (T >= Tlo && T <= Thi) {
#pragma unroll
            for (int rr = 0; rr < 4; ++rr) { const float e = __builtin_amdgcn_exp2f((s[T][rr] - m) * LOG2E); s[T][rr] = e; l += e; }
        } else s[T] = (f32x4){0.f, 0.f, 0.f, 0.f};
    }
    l += __shfl_xor(l, 16); l += __shfl_xor(l, 32);
    f32x4 o[4];
#pragma unroll
    for (int dt = 0; dt < 4; ++dt) o[dt] = (f32x4){0.f, 0.f, 0.f, 0.f};
#pragma unroll
    for (int tp = 0; tp < 8; ++tp) if (2 * tp + 1 >= Tlo && 2 * tp <= Thi) {
        const int ta = 2 * tp, tb = 2 * tp + 1;
        const int ra = ta >= Tlo ? ta : tb, rb = tb <= Thi ? tb : ta;
        pv_pair(o, Vs, 264, ra, rb, s[ta], s[tb], c16, g);
    }
    const float rl = 1.0f / l, lse = m + __logf(l);
    const size_t tok = (size_t)b * SEQ + t0 + (size_t)qi * dil;
    if (p < 2) {
        if (g == 0) lsep[(size_t)p * M * 8 + tok * 8 + h] = lse;
#pragma unroll
        for (int dt = 0; dt < 4; ++dt) { u32x2v wv; wv.x = pkbf(o[dt][0] * rl, o[dt][1] * rl); wv.y = pkbf(o[dt][2] * rl, o[dt][3] * rl); *(GAS u32x2v*)(part + (size_t)p * M * 512 + tok * 512 + h * 64 + 16 * dt + 4 * g) = wv; }
    } else {
        const float l0 = ((const GAS float*)lsep)[tok * 8 + h], l1 = ((const GAS float*)lsep)[(size_t)M * 8 + tok * 8 + h];
        u32x2v x0v[4], x1v[4];
#pragma unroll
        for (int dt = 0; dt < 4; ++dt) { const int d0 = h * 64 + 16 * dt + 4 * g; x0v[dt] = *(const GAS u32x2v*)(part + tok * 512 + d0); x1v[dt] = *(const GAS u32x2v*)(part + (size_t)M * 512 + tok * 512 + d0); }
        const float mm = fmaxf(lse, fmaxf(l0, l1));
        const float w0 = __expf(l0 - mm), w1 = __expf(l1 - mm), w2 = __expf(lse - mm); const float inv = 1.0f / (w0 + w1 + w2); const float a0 = w0 * inv, a1 = w1 * inv, a2 = w2 * inv * rl;
#pragma unroll
        for (int dt = 0; dt < 4; ++dt) { const int d0 = h * 64 + 16 * dt + 4 * g; const u32x2v x0 = x0v[dt], x1 = x1v[dt]; float y[4];
#pragma unroll
            for (int rr = 0; rr < 4; ++rr) { const float v0 = __uint_as_float((rr & 1) ? (x0[rr >> 1] & 0xffff0000u) : (x0[rr >> 1] << 16)), v1 = __uint_as_float((rr & 1) ? (x1[rr >> 1] & 0xffff0000u) : (x1[rr >> 1] << 16)); y[rr] = a0 * v0 + a1 * v1 + a2 * o[dt][rr]; }
            u32x2v wv; wv.x = pkbf(y[0], y[1]); wv.y = pkbf(y[2], y[3]); *(GAS u32x2v*)(cat + tok * D + 512 + d0) = wv; }
    }
    __syncthreads();
}
}
namespace mix {
__device__ __forceinline__ void sb_unit(int u, const bf16* qkv, bf16* cat, LAS unsigned char* lds, int tid) {
    const int qb = 63 - (u & 63), h = (u >> 6) & 15, b = u >> 10; const int lane = tid & 63, w = __builtin_amdgcn_readfirstlane(tid >> 6), c16 = lane & 15, g = lane >> 4;
    const bf16* bp = qkv + (size_t)b * SEQ * SBW + h * 64;
    LAS bf16* Qs = (LAS bf16*)(lds + OFF_Q); LAS bf16* Ks = (LAS bf16*)(lds + OFF_K); LAS bf16* Vs = (LAS bf16*)(lds + OFF_V); volatile LAS int* flags = (volatile LAS int*)(lds + OFF_FLAG);
    const int qi = 16 * w + c16;
    v4u onesw, tri0w, tri1w;
    {
        unsigned t0e[8], t1e[8];
#pragma unroll
        for (int j = 0; j < 8; ++j) { t0e[j] = j < 4 ? ((4 * g + j > c16) ? 0x3F80u : 0u) : 0x3F80u; t1e[j] = j < 4 ? 0u : ((4 * g + (j - 4) > c16) ? 0x3F80u : 0u); }
        onesw = (v4u){0x3F803F80u, 0x3F803F80u, 0x3F803F80u, 0x3F803F80u};
        tri0w = (v4u){t0e[0] | (t0e[1] << 16), t0e[2] | (t0e[3] << 16), t0e[4] | (t0e[5] << 16), t0e[6] | (t0e[7] << 16)};
        tri1w = (v4u){t1e[0] | (t1e[1] << 16), t1e[2] | (t1e[3] << 16), t1e[4] | (t1e[5] << 16), t1e[6] | (t1e[7] << 16)};
    }
    const bfx8 ones = __builtin_bit_cast(bfx8, onesw), tri0 = __builtin_bit_cast(bfx8, tri0w), tri1 = __builtin_bit_cast(bfx8, tri1w);
    f32x4 o[4];
#pragma unroll
    for (int dt = 0; dt < 4; ++dt) o[dt] = (f32x4){0.f, 0.f, 0.f, 0.f};
    float carry = 0.f;
    bfx8 qf[2];
    const int krow = tid >> 2, kc = tid & 3, vkey = tid & 127, vc = tid >> 7;
    v4u ka, kb2, va0, va1;
#define SB_LOAD(blk) do { const bf16* kp_ = bp + (size_t)((blk) * 128 + krow) * SBW + 1024; ka = *(const GAS v4u*)(kp_ + 8 * kc); kb2 = *(const GAS v4u*)(kp_ + 32 + 8 * kc); \
        const bf16* vp_ = bp + (size_t)((blk) * 128 + vkey) * SBW + 2048; va0 = *(const GAS v4u*)(vp_ + 8 * vc); va1 = *(const GAS v4u*)(vp_ + 8 * (vc + 4)); } while (0)
    SB_LOAD(qb);
    { RR rq; ld_rows(rq, bp + (size_t)(qb * 128) * SBW, SBW, tid); st_rows(Qs, rq, tid); }
    for (int kb = qb; kb >= 0; --kb) {
        *(LAS v4u*)(Ks + krow * QP + 8 * kc) = ka; *(LAS v4u*)(Ks + krow * QP + 32 + 8 * kc) = kb2;
#pragma unroll
        for (int e = 0; e < 8; ++e) { Vs[(8 * vc + e) * 136 + vkey] = (bf16)((e & 1) ? (va0[e >> 1] >> 16) : (va0[e >> 1] & 0xffffu)); Vs[(8 * (vc + 4) + e) * 136 + vkey] = (bf16)((e & 1) ? (va1[e >> 1] >> 16) : (va1[e >> 1] & 0xffffu)); }
        __syncthreads();
        if (kb > 0) SB_LOAD(kb - 1);
        if (kb == qb) {
#pragma unroll
            for (int ks = 0; ks < 2; ++ks) qf[ks] = *(const LAS bfx8*)(Qs + (16 * w + c16) * QP + 32 * ks + 8 * g);
        }
        const bool diag = kb == qb;
        if (__any(carry >= -104.0f)) {
        f32x4 ls[8], lg[8];
        f32x4 zt[8]; st_tiles8(Ks, 0, qf, c16, g, zt);
#pragma unroll
        for (int T = 0; T < 8; ++T) { const f32x4 a = zt[T];
#pragma unroll
            for (int r = 0; r < 4; ++r) { const int kj = 16 * T + 4 * g + r; const bool ok = !diag || kj < qi; const float z = a[r] * 0.125f;
                const float sp = fmaxf(z, 0.f) + __log2f(1.0f + __builtin_amdgcn_exp2f(-fabsf(z) * LOG2E)) * LN2;
                ls[T][r] = ok ? -sp : 0.f; lg[T][r] = ok ? z - sp : -INFINITY; } }
        float tot[4]; f32x4 later[8];
#pragma unroll
        for (int s = 0; s < 4; ++s) {
            f32x4 hi0, hi1, lo0, lo1;
#pragma unroll
            for (int r = 0; r < 4; ++r) { hi0[r] = __uint_as_float(__float_as_uint(ls[2 * s][r]) & 0xffff0000u); lo0[r] = ls[2 * s][r] - hi0[r]; hi1[r] = __uint_as_float(__float_as_uint(ls[2 * s + 1][r]) & 0xffff0000u); lo1[r] = ls[2 * s + 1][r] - hi1[r]; }
            const bfx8 bh = pack8(hi0, hi1), bl = pack8(lo0, lo1);
            f32x4 t = (f32x4){0.f, 0.f, 0.f, 0.f}; t = MFMA16(ones, bh, t); t = MFMA16(ones, bl, t); tot[s] = t[0];
            f32x4 a0 = (f32x4){0.f, 0.f, 0.f, 0.f}, a1 = (f32x4){0.f, 0.f, 0.f, 0.f};
            a0 = MFMA16(tri0, bh, a0); a0 = MFMA16(tri0, bl, a0); a1 = MFMA16(tri1, bh, a1); a1 = MFMA16(tri1, bl, a1);
            later[2 * s] = a0; later[2 * s + 1] = a1;
        }
        float suf = carry;
#pragma unroll
        for (int s = 3; s >= 0; --s) {
            f32x4 p0, p1;
#pragma unroll
            for (int r = 0; r < 4; ++r) { p0[r] = __builtin_amdgcn_exp2f((lg[2 * s][r] + later[2 * s][r] + suf) * LOG2E); p1[r] = __builtin_amdgcn_exp2f((lg[2 * s + 1][r] + later[2 * s + 1][r] + suf) * LOG2E); }
            pv_pair(o, Vs, 136, 2 * s, 2 * s + 1, p0, p1, c16, g);
            suf += tot[s];
        }
        carry = suf;
        }
        const int alive = __any(carry >= -104.0f) ? 1 : 0;
        if (lane == 0) flags[w] = alive;
        __syncthreads();
        int any = 0;
#pragma unroll
        for (int i = 0; i < 8; ++i) any |= flags[i];
        if (!any) break;
    }
#undef SB_LOAD
    const size_t tok = (size_t)b * SEQ + qb * 128 + qi;
#pragma unroll
    for (int dt = 0; dt < 4; ++dt) { u32x2v wv; wv.x = pkbf(o[dt][0], o[dt][1]); wv.y = pkbf(o[dt][2], o[dt][3]); *(GAS u32x2v*)(cat + tok * D + h * 64 + 16 * dt + 4 * g) = wv; }
    __syncthreads();
}
}
__global__ void __launch_bounds__(NWAVES * 64, 2) mega(Args args) {
    extern __shared__ __attribute__((aligned(16))) unsigned char lds_raw[];
    LAS unsigned char* lds = (LAS unsigned char*)lds_raw;
    volatile LAS unsigned* MISC = (volatile LAS unsigned*)(lds + MISC_OFF);
    const int G = gridDim.x; const int bx = blockIdx.x;
    for (int u = threadIdx.x; u < (LDS_BYTES - LDSCTL_OFF) / 4; u += NWAVES * 64) ((LAS unsigned*)(lds + LDSCTL_OFF))[u] = 0u;
    __syncthreads();
    XcdBarrier bar = xcd_barrier_post((unsigned*)((gu32*)(args.ws + WS_CTL) + CW_BAR) + args.li * XCD_BAR_WORDS, MISC + 8);

    for (int ph = args.ph_lo; ph < args.ph_hi; ++ph) {
        int tid = threadIdx.x; asm volatile("" : "+v"(tid));
        unsigned char* ws = args.ws; asm volatile("" : "+s"(ws));
        const int lane = tid & 63, wave = __builtin_amdgcn_readfirstlane(tid >> 6);
        const int vcu = (G % 8 == 0) ? (bx % 8) * (G / 8) + bx / 8 : bx;
        const int gw = vcu * NWAVES + wave, NGW = G * NWAVES;
        bf16* Wb = (bf16*)(ws + WS_W); bf16* xbA = (bf16*)(ws + WS_XBA); bf16* xbB = (bf16*)(ws + WS_XBB); bf16* big = (bf16*)(ws + WS_BIG);
        float* SS = (float*)(ws + WS_SS); float* out = args.out;
        const int l = ph >= 11 ? 1 : 0, s = (ph >= 1 && ph <= 9) ? ph : (ph >= 11 && ph <= 19 ? ph - 10 : 0);
        if (l == 1 && (s == 5 || s == 6)) continue;
        if (ph == 0) {
            LAS float* scr = (LAS float*)(lds + RING_OFF + wave * 16384);
            float* rc = (float*)(ws + WS_TAB); float* rs = rc + SEQ * 32; float* dc = rs + SEQ * 32; float* ds = dc + SEQ * 8;
            for (int idx = gw * 64 + lane; idx < SEQ * 32; idx += NGW * 64) {
                { const int pos = idx / 32, i = idx % 32; const float inv = 1.0f / powf(10000.0f, (float)i / 32.0f); const float ang = (float)pos * inv; rc[idx] = cosf(ang); rs[idx] = sinf(ang); }
                if (idx < SEQ * 8) { const int pos = idx / 8, i = idx % 8; const float inv = 1.0f / powf(500000.0f, (float)i / 8.0f); const float ang = (float)pos * inv; dc[idx] = cosf(ang); ds[idx] = sinf(ang); }
            }
            for (int m0 = gw; m0 < M; m0 += 2 * NGW) {
                f32x4 v[2][4];
#pragma unroll
                for (int r = 0; r < 2; ++r) { const int m = m0 + r * NGW < M ? m0 + r * NGW : m0; const GAS f32x4* xr = (const GAS f32x4*)(args.in[0] + (size_t)m * D) + lane;
#pragma unroll
                    for (int j = 0; j < 4; ++j) v[r][j] = xr[64 * j]; }
#pragma unroll
                for (int r = 0; r < 2; ++r) { const int m = m0 + r * NGW; if (m < M) { float sq = 0.f;
#pragma unroll
                    for (int j = 0; j < 4; ++j) sq += (v[r][j].x * v[r][j].x + v[r][j].y * v[r][j].y) + (v[r][j].z * v[r][j].z + v[r][j].w * v[r][j].w);
                    sq = wave_sum(sq); if (lane == 0) SS[m] = sq;
                    GAS unsigned long long* o8 = (GAS unsigned long long*)(xbA + (size_t)m * D) + lane;
#pragma unroll
                    for (int j = 0; j < 4; ++j) o8[64 * j] = (unsigned long long)pk2(v[r][j].x, v[r][j].y) | ((unsigned long long)pk2(v[r][j].z, v[r][j].w) << 32); } }
            }
            convert_layer(args, 0, scr, gw, NGW, lane);
        } else if (ph == 10) {
            LAS float* scr = (LAS float*)(lds + RING_OFF + wave * 16384);
            convert_layer(args, 1, scr, gw, NGW, lane);
        } else if (ph == 20) {
            const float* ssf = (const float*)(ws + WS_SSP) + (size_t)5 * 16 * M; const float* g = args.in[13];
            for (int m0 = gw; m0 < M; m0 += 4 * NGW) {
                float part[4]; unsigned long long wv[4][4];
#pragma unroll
                for (int r = 0; r < 4; ++r) { const int m = m0 + r * NGW; part[r] = (lane < 16 && m < M) ? ((const GAS float*)ssf)[(size_t)lane * M + m] : 0.f;
                    const GAS unsigned long long* xi = (const GAS unsigned long long*)(xbA + (size_t)(m < M ? m : 0) * D) + lane;
#pragma unroll
                    for (int j = 0; j < 4; ++j) wv[r][j] = xi[64 * j]; }
#pragma unroll
                for (int r = 0; r < 4; ++r) { const int m = m0 + r * NGW; const float rs = rsqrtf(wave_sum(part[r]) * (1.0f / 1024.0f) + 1e-6f);
                    if (m < M) { GAS f32x4* xr = (GAS f32x4*)(out + (size_t)m * D) + lane; const GAS f32x4* gr = (const GAS f32x4*)g + lane;
#pragma unroll
                        for (int j = 0; j < 4; ++j) { const unsigned lo = (unsigned)wv[r][j], hi = (unsigned)(wv[r][j] >> 32);
                            f32x4 v = (f32x4){__uint_as_float(lo << 16), __uint_as_float(lo & 0xffff0000u), __uint_as_float(hi << 16), __uint_as_float(hi & 0xffff0000u)}; v = v * rs * gr[64 * j]; xr[64 * j] = v; } } }
            }
        } else if (s == 1 || s == 8) {
            pg8::Gemm g{s == 1 ? xbA : xbB, Wb + (s == 1 ? WO_F1IN : WO_F2IN), M, 2 * FF, D};
            pg8::StaticOrder S; S.init(M, 2 * FF, G, bx);
            const int kss = 3 * l + (s == 1 ? 0 : 2);
            pg8::EpiSwiGLU E{big, FF, kss == 0 ? (const float*)SS : (const float*)(ws + WS_SSP) + (size_t)(kss - 1) * 16 * M, kss == 0 ? 1 : 16};
            pg8::gemm_phase<pg8::EpiSwiGLU, pg8::StaticOrder, PG8_ALIGN, PG8_SP2>(lds + RING_OFF, g, S, E);
        } else if (s == 3) {
            const int N = l == 0 ? HYB : SBW;
            pg8::Gemm g{xbB, Wb + WO_MIXIN, M, N, D};
            pg8::StaticOrder S; S.init(M, N, G, bx);
            pg8::EpiScaleBf16 E{big, N, (const float*)(ws + WS_SSP) + (size_t)(3 * l) * 16 * M, 16};
            pg8::gemm_phase<pg8::EpiScaleBf16, pg8::StaticOrder, PG8_ALIGN, PG8_SP2>(lds + RING_OFF, g, S, E);
        } else if (s == 2 || s == 7 || s == 9) {
            const bf16* A = s == 7 ? xbA : big; const int K = s == 7 ? D : FF;
            const bf16* Bt = Wb + (s == 2 ? WO_F1OUT : s == 7 ? WO_MIXOUT : WO_F2OUT);
            const float* base32 = (l == 0 && s == 2) ? args.in[0] : nullptr; const bf16* baseb = s == 2 ? xbA : xbB;
            bf16* xbo = s == 9 ? xbA : xbB; float* ssn = (float*)(ws + WS_SSP) + (size_t)(3 * l + (s == 2 ? 0 : s == 7 ? 1 : 2)) * 16 * M;
            pg8::Gemm g{A, Bt, M, D, K};
            pg8::StaticOrder S; S.init(M, D, G, bx);
            pg8::EpiResid E{base32, baseb, xbo, ssn, s == 7 ? 1.0f : 0.5f};
            pg8::gemm_phase<pg8::EpiResid, pg8::StaticOrder, PG8_ALIGN, PG8_SP2>(lds + RING_OFF, g, S, E);
        } else if (l == 0) {
            const float* rc = (const float*)(ws + WS_TAB); const float* rs = rc + SEQ * 32; const float* dc = rs + SEQ * 32; const float* ds = dc + SEQ * 8;
            float* kv = (float*)(ws + WS_KV); bf16* St = (bf16*)(ws + WS_ST); bf16* part = (bf16*)out;     float* lsep = (float*)(ws + WS_LSE);
            if (s == 4) { for (int u = bx; u < 1024; u += G) mix::ret_kv_unit(u, big, rc, rs, kv, lds, tid); }
            else if (s == 5) {
                for (int chain = bx * 512 + tid; chain < 65536; chain += G * 512) mix::ret_scan(chain, kv, St);
                for (int u = bx; u < 2048; u += G) mix::dil_unit(u, big, dc, ds, part, lsep, xbA, lds, tid);
            } else {
                for (int v = bx; v < 2048; v += G) { if (v < 1024) mix::ret_out_unit(v, big, rc, rs, St, args.in[9], xbA, lds, tid); else mix::dil_unit(v + 1024, big, dc, ds, part, lsep, xbA, lds, tid); }
            }
        } else {
            for (int u = bx; u < 2048; u += G) mix::sb_unit(u, big, xbA, lds, tid);
        }
        if (ph + 1 < args.ph_hi) { if (args.li != 0) cooperative_groups::this_grid().sync(); else xcd_barrier(bar); }
    }
}
extern "C" void kernel_launch(void* const* d_in, const int* in_sizes, int n_in, void* d_out, int out_size, void* d_ws, size_t ws_size, hipStream_t stream) {
    static int grid = 0;
    if (grid == 0) {
        int dev = 0, cus = 0, per_cu = 0;
        hipGetDevice(&dev); hipDeviceGetAttribute(&cus, hipDeviceAttributeMultiprocessorCount, dev);
        if (hipFuncSetAttribute((const void*)mega, hipFuncAttributeMaxDynamicSharedMemorySize, LDS_BYTES) != hipSuccess) { fprintf(stderr, "kernel_launch: hipFuncSetAttribute failed\n"); grid = -1; return; }
        if (hipOccupancyMaxActiveBlocksPerMultiprocessor(&per_cu, (const void*)mega, NWAVES * 64, LDS_BYTES) != hipSuccess || per_cu < 1) per_cu = 1;
        (void)hipGetLastError();
        grid = (cus > 0 ? cus : 256) * 1;
    }
    if (grid < 0) return;
    hipMemsetAsync((char*)d_ws + WS_CTL, 0, CTL_ZERO_BYTES, stream);
    Args a{};
    for (int i = 0; i < 14; ++i) a.in[i] = (const float*)d_in[i];
    a.out = (float*)d_out; a.ws = (unsigned char*)d_ws; a.ph_lo = 0; a.ph_hi = 21; a.li = 0; a.mask = 0;
    void* kargs[] = {&a};
    hipError_t e = hipLaunchCooperativeKernel((const void*)mega, dim3(grid), dim3(NWAVES * 64), kargs, LDS_BYTES, stream);
    if (e != hipSuccess) fprintf(stderr, "kernel_launch: cooperative launch failed: %s (grid %d)\n", hipGetErrorString(e), grid);
}
```

```cpp
#include <hip/hip_runtime.h>
#include <hip/hip_cooperative_groups.h>
#include <cstdio>
#include <cstdint>
__device__ __forceinline__ int mk_lane() { int z = 0; asm volatile("" : "+s"(z)); return (int)__builtin_amdgcn_mbcnt_hi(~0u, __builtin_amdgcn_mbcnt_lo(~0u, (unsigned)z)); }
#define MK_LANE() mk_lane()
namespace pg8 {
#define PG8_LAS __attribute__((address_space(3)))
typedef unsigned short bf16_t;
typedef short bf16x8 __attribute__((ext_vector_type(8)));
typedef float f32x4 __attribute__((ext_vector_type(4)));
typedef unsigned u32x4 __attribute__((ext_vector_type(4)));
constexpr int BM = 256, BK = 64, HALF = 128, HTB = HALF * BK * 2  , STAGE_BYTES = 8 * HTB, NXCD = 8, WGM = 8;

__host__ __device__ __forceinline__ int lds_byte(int r, int c) { const int st = (r >> 4) * 2 + (c >> 5), rr = r & 15, cc = c & 31, ob = rr * 64 + cc * 2; return st * 1024 + (ob ^ (((ob >> 9) & 1) << 5)); }
__host__ __device__ __forceinline__ void stage_rc(int b, int& R, int& C) { const int st = b / 1024, sb = b % 1024, swz = sb ^ (((sb >> 9) & 1) << 5); R = (st >> 1) * 16 + swz / 64; C = (st & 1) * 32 + (swz % 64) / 2; }
__host__ __device__ __forceinline__ int perm32(int rho) { const int n = rho >> 4, i = rho & 15; return 8 * (i >> 2) + 4 * n + (i & 3); }

struct Unit { int pm, pn; };
struct Gemm { const bf16_t* A; const bf16_t* Bt; int M, N, K; };

struct StaticOrder {
    int nM, nN, nwg, G, c;
    __host__ __device__ void init(int M, int N, int G_, int c_) { nM = M / BM; nN = N / BM; nwg = nM * nN; G = G_; c = c_; }
    __host__ __device__ bool next(int i, Unit& u) const {
        const long L = (long)i * G + c; if (L >= nwg) return false;
        int wgid = (int)L; { const int q = nwg / NXCD, r = nwg % NXCD, xcd = wgid % NXCD, off = wgid / NXCD; wgid = (xcd < r ? xcd * (q + 1) : r * (q + 1) + (xcd - r) * q) + off; }
        const int nig = WGM * nN, gid = wgid / nig, fm = gid * WGM, gsz = (nM - fm) < WGM ? (nM - fm) : WGM;
        u.pm = fm + ((wgid % nig) % gsz); u.pn = (wgid % nig) / gsz; return true;
    }
    __device__ __forceinline__ void a_ready(const Unit&) const {}
    __device__ __forceinline__ void done(const Unit&) const {}
};

__device__ __forceinline__ unsigned cvt_pk_bf16(float lo, float hi) { unsigned r; asm volatile("v_cvt_pk_bf16_f32 %0, %1, %2" : "=v"(r) : "v"(lo), "v"(hi)); return r; }
typedef float f32x2 __attribute__((ext_vector_type(2)));
__device__ __forceinline__ f32x2 gelu_pk(f32x2 v) {
    const f32x2 av = __builtin_elementwise_abs(v), d = av * 0.2316418882f + 1.0f;
    f32x2 t; t.x = __builtin_amdgcn_rcpf(d.x); t.y = __builtin_amdgcn_rcpf(d.y);
    f32x2 q = t * 0.5307027145f + (-0.7265760135f); q = q * t + 0.7107068705f; q = q * t + (-0.142248368f); q = q * t + 0.127414796f; q = q * t;
    const f32x2 s = (v * v) * (-0.72134752044f);
    f32x2 e; e.x = __builtin_amdgcn_exp2f(s.x); e.y = __builtin_amdgcn_exp2f(s.y);
    const f32x2 m = v * (q * e), r = v - m;
    f32x2 o; o.x = v.x < 0.f ? m.x : r.x; o.y = v.y < 0.f ? m.y : r.y; return o;
}

template <int ACT  > struct EpiBf16 {
    static constexpr bool PERM = true, AFTER_DRAIN = false; static_assert(ACT == 0 || ACT == 1, "EpiBf16: ACT is 0 (none) or 1 (gelu_pk)");
    bf16_t* O; int ldc; const float* bias; int split_cols; size_t split_stride; float scale0;
    __device__ __forceinline__ void operator()(const f32x4 (&acc)[2][2][4][2], const Unit& u, int wr, int wc, int fr, int fq) const {
        const int row0 = u.pm * BM + wr * 64 + fr; int colt = u.pn * BM; bf16_t* base = O;
        float sc = 1.f; if (split_cols) { const int t = colt / split_cols; base += (size_t)t * split_stride; colt -= t * split_cols; if (t == 0) sc = scale0; }
        const int col0 = colt + wc * 32 + 8 * fq, bcol0 = u.pn * BM + wc * 32 + 8 * fq;
        f32x4 bv[2][2];
#pragma unroll
        for (int bj = 0; bj < 2; ++bj)
#pragma unroll
            for (int n = 0; n < 2; ++n) bv[bj][n] = bias ? *(const f32x4*)(bias + bcol0 + bj * HALF + 4 * n) : (f32x4){0.f, 0.f, 0.f, 0.f};
#pragma unroll
        for (int ai = 0; ai < 2; ++ai)
#pragma unroll
            for (int m = 0; m < 4; ++m) { bf16_t* rowp = base + (size_t)(row0 + ai * HALF + m * 16) * ldc + col0;
#pragma unroll
                for (int bj = 0; bj < 2; ++bj) { f32x4 v0 = acc[ai][bj][m][0] + bv[bj][0], v1 = acc[ai][bj][m][1] + bv[bj][1];
                    if (ACT == 1) { f32x2 a = gelu_pk((f32x2){v0[0], v0[1]}), b = gelu_pk((f32x2){v0[2], v0[3]}), c = gelu_pk((f32x2){v1[0], v1[1]}), d = gelu_pk((f32x2){v1[2], v1[3]});
                        v0 = (f32x4){a.x, a.y, b.x, b.y}; v1 = (f32x4){c.x, c.y, d.x, d.y}; }
                    v0 = v0 * sc; v1 = v1 * sc; u32x4 w; w.x = cvt_pk_bf16(v0[0], v0[1]); w.y = cvt_pk_bf16(v0[2], v0[3]); w.z = cvt_pk_bf16(v1[0], v1[1]); w.w = cvt_pk_bf16(v1[2], v1[3]);
                    *(u32x4*)(rowp + bj * HALF) = w; } }
    }
};

struct PanelStats {
    unsigned* xbuf;
    unsigned* cnt;
    unsigned* tmo;
    int ntn; float eps;
    unsigned code;
    __device__ __forceinline__ bool run(const f32x4 (&v)[2][2][4][2], const Unit& u, int wr, int wc, int fr, int fq, PG8_LAS unsigned char* lds, int wid, int lane) const {
        typedef float f32x2v __attribute__((ext_vector_type(2)));
        PG8_LAS f32x2v* P = (PG8_LAS f32x2v*)lds;
        PG8_LAS f32x2v* S = (PG8_LAS f32x2v*)(lds + 8192);
        PG8_LAS unsigned* flag = (PG8_LAS unsigned*)(lds + 8192 + 2048);
#pragma unroll
        for (int ai = 0; ai < 2; ++ai)
#pragma unroll
            for (int m = 0; m < 4; ++m) {
                float s = 0.f;
#pragma unroll
                for (int bj = 0; bj < 2; ++bj)
#pragma unroll
                    for (int n = 0; n < 2; ++n) { const f32x4 x = v[ai][bj][m][n]; s += (x[0] + x[1]) + (x[2] + x[3]); }
                s += __shfl_xor(s, 16); s += __shfl_xor(s, 32);
                const float mw = s * (1.0f / 64.0f); float q = 0.f;
#pragma unroll
                for (int bj = 0; bj < 2; ++bj)
#pragma unroll
                    for (int n = 0; n < 2; ++n) { const f32x4 d = v[ai][bj][m][n] - mw; q += (d[0] * d[0] + d[1] * d[1]) + (d[2] * d[2] + d[3] * d[3]); }
                q += __shfl_xor(q, 16); q += __shfl_xor(q, 32);
                if (fq == 0) P[(ai * HALF + wr * 64 + m * 16 + fr) * 4 + wc] = (f32x2v){mw, q};
            }
        asm volatile("s_waitcnt lgkmcnt(0)" ::: "memory"); __builtin_amdgcn_s_barrier(); asm volatile("" ::: "memory");
#if defined(BROKEN_EXCHANGE_NO_WAIT)
#warning BROKEN CONTROL BUILD: the row-statistics exchange does not wait; results are wrong by design
        if (blockIdx.x >= 64) { const long long t0_ = clock64(); while (clock64() - t0_ < 60000) __builtin_amdgcn_s_sleep(8); }
#endif
        const int row = wid * 32 + (lane & 31);
        if (lane < 32) {
            const f32x2v a = P[row * 4 + 0], b = P[row * 4 + 1], c = P[row * 4 + 2], d = P[row * 4 + 3];
            const float mt = (a.x + b.x + c.x + d.x) * 0.25f;
            const float da = a.x - mt, db = b.x - mt, dc = c.x - mt, dd = d.x - mt;
            const float m2 = (a.y + b.y) + (c.y + d.y) + 64.0f * ((da * da + db * db) + (dc * dc + dd * dd));
            unsigned long long* slot = (unsigned long long*)xbuf + ((size_t)(u.pm * BM + row) * 4 + u.pn);
            __hip_atomic_store(slot, ((unsigned long long)__float_as_uint(m2) << 32) | __float_as_uint(mt), __ATOMIC_RELAXED, __HIP_MEMORY_SCOPE_AGENT);
        }
        asm volatile("s_waitcnt vmcnt(0)" ::: "memory");
        if (lane == 0) __hip_atomic_fetch_add(cnt + 64 * u.pm, 1u, __ATOMIC_RELAXED, __HIP_MEMORY_SCOPE_AGENT);
        if (wid == 0) {
            bool dead = false; const unsigned long long t0 = __builtin_amdgcn_s_memrealtime(); const unsigned want = 8u * (unsigned)ntn;
            for (;;) {
#if defined(BROKEN_EXCHANGE_NO_WAIT)
                break;
#endif
                if ((unsigned)__builtin_amdgcn_readfirstlane(__hip_atomic_load(cnt + 64 * u.pm, __ATOMIC_RELAXED, __HIP_MEMORY_SCOPE_AGENT)) >= want) break;
                if (__builtin_amdgcn_s_memrealtime() - t0 > 2000000ull) {
                    if (lane == 0) { unsigned expect = 0u; __hip_atomic_compare_exchange_strong(tmo + 1, &expect, code | (unsigned)(u.pm & 0xff), __ATOMIC_RELAXED, __ATOMIC_RELAXED, __HIP_MEMORY_SCOPE_AGENT);
                                     __hip_atomic_store(tmo, 1u, __ATOMIC_RELAXED, __HIP_MEMORY_SCOPE_AGENT); }
                    dead = true; break; }
                __builtin_amdgcn_s_sleep(2);
            }
            __builtin_amdgcn_fence(__ATOMIC_ACQUIRE, "agent");
            if (lane == 0) flag[0] = dead ? 1u : 0u;
        }
        asm volatile("s_waitcnt vmcnt(0) lgkmcnt(0)" ::: "memory"); __builtin_amdgcn_s_barrier(); asm volatile("" ::: "memory");
        const bool bad = flag[0] != 0u;
        if (lane < 32) {
            const unsigned long long* slot = (const unsigned long long*)xbuf + (size_t)(u.pm * BM + row) * 4; float mt[4], m2[4]; float ms = 0.f;
#pragma unroll
            for (int t = 0; t < 4; ++t) { if (t < ntn) { const unsigned long long w = __hip_atomic_load(slot + t, __ATOMIC_RELAXED, __HIP_MEMORY_SCOPE_AGENT); mt[t] = __uint_as_float((unsigned)w); m2[t] = __uint_as_float((unsigned)(w >> 32)); } else { mt[t] = 0.f; m2[t] = 0.f; } ms += mt[t]; }
            const float mean = ms / (float)ntn; float q = 0.f;
#pragma unroll
            for (int t = 0; t < 4; ++t) if (t < ntn) { const float dm = mt[t] - mean; q += m2[t] + 256.0f * dm * dm; }
            S[row] = (f32x2v){mean, 1.0f / sqrtf(q / (256.0f * (float)ntn) + eps)};
        }
        asm volatile("s_waitcnt lgkmcnt(0)" ::: "memory"); __builtin_amdgcn_s_barrier(); asm volatile("" ::: "memory");
        return bad;
    }
};
struct EpiLnRes {
    static constexpr bool PERM = false, AFTER_DRAIN = true;
    const float* base; float* out; int ldc; const float* bias; PanelStats st; unsigned poison;
    __device__ __forceinline__ void fused(f32x4 (&acc)[2][2][4][2], const Unit& u, int wr, int wc, int fr, int fq, PG8_LAS unsigned char* lds, int wid, int lane) const {
        typedef float f32x2v __attribute__((ext_vector_type(2)));
        const PG8_LAS f32x2v* S = (const PG8_LAS f32x2v*)(lds + 8192);
        const int col0 = u.pn * BM + wc * 32 + 4 * fq;
#pragma unroll
        for (int bj = 0; bj < 2; ++bj)
#pragma unroll
            for (int n = 0; n < 2; ++n) { const f32x4 bv = bias ? *(const f32x4*)(bias + col0 + bj * HALF + n * 16) : (f32x4){0.f, 0.f, 0.f, 0.f};
#pragma unroll
                for (int ai = 0; ai < 2; ++ai)
#pragma unroll
                    for (int m = 0; m < 4; ++m) acc[ai][bj][m][n] += bv; }
        f32x4 pre[4][2][2];
#pragma unroll
        for (int m = 0; m < 4; ++m) { const size_t off = (size_t)(u.pm * BM + wr * 64 + m * 16 + fr) * ldc + col0;
#pragma unroll
            for (int bj = 0; bj < 2; ++bj)
#pragma unroll
                for (int n = 0; n < 2; ++n) pre[m][bj][n] = *(const f32x4*)(base + off + bj * HALF + n * 16); }
        const bool bad = st.run(acc, u, wr, wc, fr, fq, lds, wid, lane) || poison != 0u;
        const float qnan = __builtin_nanf("");
#pragma unroll
        for (int ai = 0; ai < 2; ++ai)
#pragma unroll
            for (int m = 0; m < 4; ++m) { const int r = ai * HALF + wr * 64 + m * 16 + fr; const f32x2v sr = S[r]; const size_t off = (size_t)(u.pm * BM + r) * ldc + col0;
#pragma unroll
                for (int bj = 0; bj < 2; ++bj)
#pragma unroll
                    for (int n = 0; n < 2; ++n) { const f32x4 bs = ai == 0 ? pre[m][bj][n] : *(const f32x4*)(base + off + bj * HALF + n * 16); f32x4 o = bs + (acc[ai][bj][m][n] - sr.x) * sr.y;
                        if (bad) o = (f32x4){qnan, qnan, qnan, qnan}; *(f32x4*)(out + off + bj * HALF + n * 16) = o; }
                if (m & 1) asm volatile("" ::: "memory"); }
    }
};
struct EpiLnResLn {
    static constexpr bool PERM = false, AFTER_DRAIN = true;
    const float* base; float* out; bf16_t* xn; int ldc; const float* bias; PanelStats st1, st2; unsigned poison;
    __device__ __forceinline__ void fused(f32x4 (&acc)[2][2][4][2], const Unit& u, int wr, int wc, int fr, int fq, PG8_LAS unsigned char* lds, int wid, int lane) const {
        typedef float f32x2v __attribute__((ext_vector_type(2))); typedef unsigned u32x2v __attribute__((ext_vector_type(2)));
        const PG8_LAS f32x2v* S = (const PG8_LAS f32x2v*)(lds + 8192);
        const int col0 = u.pn * BM + wc * 32 + 4 * fq;
#pragma unroll
        for (int bj = 0; bj < 2; ++bj)
#pragma unroll
            for (int n = 0; n < 2; ++n) { const f32x4 bv = bias ? *(const f32x4*)(bias + col0 + bj * HALF + n * 16) : (f32x4){0.f, 0.f, 0.f, 0.f};
#pragma unroll
                for (int ai = 0; ai < 2; ++ai)
#pragma unroll
                    for (int m = 0; m < 4; ++m) acc[ai][bj][m][n] += bv; }
        bool bad = st1.run(acc, u, wr, wc, fr, fq, lds, wid, lane) || poison != 0u;
        const float qnan = __builtin_nanf("");
#pragma unroll
        for (int ai = 0; ai < 2; ++ai)
#pragma unroll
            for (int m = 0; m < 4; ++m) { const int r = ai * HALF + wr * 64 + m * 16 + fr; const f32x2v sr = S[r]; const size_t off = (size_t)(u.pm * BM + r) * ldc + col0;
#pragma unroll
                for (int bj = 0; bj < 2; ++bj)
#pragma unroll
                    for (int n = 0; n < 2; ++n) { const f32x4 bs = *(const f32x4*)(base + off + bj * HALF + n * 16); acc[ai][bj][m][n] = bs + (acc[ai][bj][m][n] - sr.x) * sr.y; }
                asm volatile("" : "+v"(acc[ai][0][m][0]), "+v"(acc[ai][0][m][1]), "+v"(acc[ai][1][m][0]), "+v"(acc[ai][1][m][1]));
                if (m & 1) asm volatile("" ::: "memory"); }
        const bool bad1 = bad;
        bad = st2.run(acc, u, wr, wc, fr, fq, lds, wid, lane) || bad;
#pragma unroll
        for (int ai = 0; ai < 2; ++ai)
#pragma unroll
            for (int m = 0; m < 4; ++m) { const int r = ai * HALF + wr * 64 + m * 16 + fr; const f32x2v sr = S[r]; const size_t off = (size_t)(u.pm * BM + r) * ldc + col0;
#pragma unroll
                for (int bj = 0; bj < 2; ++bj)
#pragma unroll
                    for (int n = 0; n < 2; ++n) { const f32x4 x1 = acc[ai][bj][m][n]; *(f32x4*)(out + off + bj * HALF + n * 16) = bad1 ? (f32x4){qnan, qnan, qnan, qnan} : x1;
                        const f32x4 o = (x1 - sr.x) * sr.y; u32x2v w; w.x = cvt_pk_bf16(o[0], o[1]); w.y = cvt_pk_bf16(o[2], o[3]);
                        if (bad) { w.x = 0x7fc07fc0u; w.y = 0x7fc07fc0u; } *(u32x2v*)(xn + off + bj * HALF + n * 16) = w; }
                asm volatile("" ::: "memory"); }
    }
};

template <class Epi, class Sched, bool ALIGN_EPI = false, bool SP2 = false>
__device__ __forceinline__ void gemm_phase(PG8_LAS unsigned char* lds, const Gemm g, const Sched& S, const Epi& E, const int wave_s  ) {
    int tid_ = wave_s * 64 + MK_LANE(); asm volatile("" : "+v"(tid_));
    const int tid = tid_, wid = __builtin_amdgcn_readfirstlane(tid >> 6), lane = tid & 63, wr = wid >> 2, wc = wid & 3, fr = lane & 15, fq = lane >> 4;
    const int K = g.K, nt = K / BK;
    unsigned voffA[2], voffB[2];
#pragma unroll
    for (int i = 0; i < 2; ++i) { int R, C; stage_rc(tid * 16 + i * 8192, R, C); const int Rb = Epi::PERM ? ((R & ~31) + perm32(R & 31)) : R;
        voffA[i] = (unsigned)(R * K + C) * 2u; voffB[i] = (unsigned)(Rb * K + C) * 2u; }
    const size_t kstep = (size_t)(BK * 2);
    const size_t hstep = (size_t)HALF * K * 2;
    const size_t tstep = 2 * hstep;
    const unsigned ldsw = (unsigned)wid * 1024u;
    const int aoff = lds_byte(wr * 64 + fr, fq * 8), boff = lds_byte(wc * 32 + fr, fq * 8);
#define PG8_SA(b, h) (((b) * 2 + (h)) * HTB)
#define PG8_SB(b, h) ((4 + (b) * 2 + (h)) * HTB)
#define PG8_STAGE(bufoff, gbase, voff) do { _Pragma("unroll") for (int _i = 0; _i < 2; ++_i) \
        __builtin_amdgcn_global_load_lds((const unsigned*)((const char*)(gbase) + (voff)[_i]), (PG8_LAS unsigned*)(lds + (bufoff) + ldsw + _i * 8192), 16, 0, 0); } while (0)
#define PG8_LDA(dst, b, h) do { _Pragma("unroll") for (int m = 0; m < 4; ++m) _Pragma("unroll") for (int k = 0; k < 2; ++k) dst[m][k] = *(const PG8_LAS bf16x8*)(lds + PG8_SA(b, h) + aoff + m * 2048 + k * 1024); } while (0)
#define PG8_LDB(dst, b, h) do { _Pragma("unroll") for (int n = 0; n < 2; ++n) _Pragma("unroll") for (int k = 0; k < 2; ++k) dst[n][k] = *(const PG8_LAS bf16x8*)(lds + PG8_SB(b, h) + boff + n * 2048 + k * 1024); } while (0)
#define PG8_MMA(ai, bj, At, Bt) do { __builtin_amdgcn_s_setprio(1); _Pragma("unroll") for (int m = 0; m < 4; ++m) _Pragma("unroll") for (int n = 0; n < 2; ++n) _Pragma("unroll") for (int k = 0; k < 2; ++k) \
        acc[ai][bj][m][n] = __builtin_amdgcn_mfma_f32_16x16x32_bf16(Bt[n][k], At[m][k], acc[ai][bj][m][n], 0, 0, 0); __builtin_amdgcn_s_setprio(0); } while (0)
#define PG8_WAIT_V(n) asm volatile("s_waitcnt vmcnt(" #n ")" ::: "memory")
#define PG8_WAIT_L(n) asm volatile("s_waitcnt lgkmcnt(" #n ")" ::: "memory")
#define PG8_BAR __builtin_amdgcn_s_barrier()
#define PG8_SCHED __builtin_amdgcn_sched_barrier(0)
    Unit cur, nxt; int ui = 0;
    if (!S.next(0, cur)) return;
    f32x4 acc[2][2][4][2];
#pragma unroll
    for (int a = 0; a < 2; ++a)
#pragma unroll
        for (int b = 0; b < 2; ++b)
#pragma unroll
            for (int m = 0; m < 4; ++m)
#pragma unroll
                for (int n = 0; n < 2; ++n) acc[a][b][m][n] = (f32x4){0.f, 0.f, 0.f, 0.f};
    bf16x8 At[4][2], B0[2][2], B1[2][2];
    const char* cA = (const char*)g.A + (size_t)cur.pm * tstep; const char* cB = (const char*)g.Bt + (size_t)cur.pn * tstep;
    S.a_ready(cur);
    if constexpr (SP2) {
        PG8_STAGE(PG8_SB(0, 0), cB, voffB); PG8_STAGE(PG8_SB(0, 1), cB + hstep, voffB); PG8_STAGE(PG8_SA(0, 0), cA, voffA); PG8_STAGE(PG8_SA(0, 1), cA + hstep, voffA);
        if (wr == 1) PG8_BAR;
        PG8_WAIT_V(2); PG8_BAR;
        PG8_STAGE(PG8_SB(1, 0), cB + kstep, voffB); PG8_STAGE(PG8_SA(1, 0), cA + kstep, voffA); PG8_STAGE(PG8_SB(1, 1), cB + hstep + kstep, voffB);
        PG8_WAIT_V(6); PG8_BAR;
    } else {
        PG8_STAGE(PG8_SB(0, 0), cB, voffB); PG8_STAGE(PG8_SA(0, 0), cA, voffA); PG8_STAGE(PG8_SB(0, 1), cB + hstep, voffB); PG8_STAGE(PG8_SA(0, 1), cA + hstep, voffA);
        if (wr == 1) PG8_BAR;
        PG8_WAIT_V(4); PG8_BAR;
        PG8_STAGE(PG8_SB(1, 0), cB + kstep, voffB); PG8_STAGE(PG8_SA(1, 0), cA + kstep, voffA); PG8_STAGE(PG8_SB(1, 1), cB + hstep + kstep, voffB);
        PG8_WAIT_V(6); PG8_BAR;
    }
    for (;;) {
        const bool has_next = S.next(ui + 1, nxt);
        const char* nA = has_next ? (const char*)g.A + (size_t)nxt.pm * tstep : cA; const char* nB = has_next ? (const char*)g.Bt + (size_t)nxt.pn * tstep : cB;
        for (int t = 0; t < nt; t += 2) {
            const bool last = (t == nt - 2);
            const char* a1 = cA + (size_t)(t + 1) * kstep;
            const char* a2 = last ? nA : cA + (size_t)(t + 2) * kstep; const char* b2 = last ? nB : cB + (size_t)(t + 2) * kstep;
            const char* a3 = a2 + kstep; const char* b3 = b2 + kstep;
            if (last && has_next) S.a_ready(nxt);
            if constexpr (SP2) {
            PG8_LDB(B0, 0, 0); PG8_LDB(B1, 0, 1); PG8_SCHED; PG8_LDA(At, 0, 0); PG8_STAGE(PG8_SA(1, 1), a1 + hstep, voffA);
            PG8_WAIT_V(8); PG8_WAIT_L(0); PG8_BAR; PG8_MMA(0, 0, At, B0); PG8_MMA(0, 1, At, B1); PG8_BAR; PG8_SCHED;
            PG8_LDA(At, 0, 1); PG8_STAGE(PG8_SB(0, 0), b2, voffB); PG8_STAGE(PG8_SB(0, 1), b2 + hstep, voffB); PG8_STAGE(PG8_SA(0, 0), a2, voffA);
            PG8_WAIT_V(8); PG8_WAIT_L(0); PG8_BAR; PG8_MMA(1, 0, At, B0); PG8_MMA(1, 1, At, B1); PG8_BAR; PG8_SCHED;
            PG8_LDB(B0, 1, 0); PG8_LDB(B1, 1, 1); PG8_SCHED; PG8_LDA(At, 1, 0); PG8_STAGE(PG8_SA(0, 1), a2 + hstep, voffA);
            PG8_WAIT_V(8); PG8_WAIT_L(0); PG8_BAR; PG8_MMA(0, 0, At, B0); PG8_MMA(0, 1, At, B1); PG8_BAR; PG8_SCHED;
            PG8_LDA(At, 1, 1); PG8_STAGE(PG8_SB(1, 0), b3, voffB); PG8_STAGE(PG8_SB(1, 1), b3 + hstep, voffB); PG8_STAGE(PG8_SA(1, 0), a3, voffA);
            PG8_WAIT_V(8); PG8_WAIT_L(0); PG8_BAR; PG8_MMA(1, 0, At, B0); PG8_MMA(1, 1, At, B1); PG8_BAR; PG8_SCHED;
            } else {
            PG8_LDB(B0, 0, 0); PG8_SCHED; PG8_LDA(At, 0, 0); PG8_STAGE(PG8_SA(1, 1), a1 + hstep, voffA);
            PG8_WAIT_L(8); PG8_BAR; PG8_WAIT_L(0); PG8_MMA(0, 0, At, B0); PG8_BAR; PG8_SCHED;
            PG8_LDB(B1, 0, 1); PG8_STAGE(PG8_SB(0, 0), b2, voffB);
            PG8_BAR; PG8_WAIT_L(0); PG8_MMA(0, 1, At, B1); PG8_BAR;
            PG8_LDA(At, 0, 1); PG8_STAGE(PG8_SA(0, 0), a2, voffA);
            PG8_BAR; PG8_WAIT_L(0); PG8_MMA(1, 0, At, B0); PG8_BAR; PG8_SCHED;
            PG8_STAGE(PG8_SB(0, 1), b2 + hstep, voffB);
            PG8_WAIT_V(6); PG8_BAR; PG8_MMA(1, 1, At, B1); PG8_BAR;
            PG8_LDB(B0, 1, 0); PG8_SCHED; PG8_LDA(At, 1, 0); PG8_STAGE(PG8_SA(0, 1), a2 + hstep, voffA);
            PG8_WAIT_L(8); PG8_BAR; PG8_WAIT_L(0); PG8_MMA(0, 0, At, B0); PG8_BAR; PG8_SCHED;
            PG8_LDB(B1, 1, 1); PG8_STAGE(PG8_SB(1, 0), b3, voffB);
            PG8_BAR; PG8_WAIT_L(0); PG8_MMA(0, 1, At, B1); PG8_BAR;
            PG8_LDA(At, 1, 1); PG8_STAGE(PG8_SA(1, 0), a3, voffA);
            PG8_BAR; PG8_WAIT_L(0); PG8_MMA(1, 0, At, B0); PG8_BAR; PG8_SCHED;
            PG8_STAGE(PG8_SB(1, 1), b3 + hstep, voffB);
            PG8_WAIT_V(6); PG8_BAR; PG8_MMA(1, 1, At, B1); PG8_BAR;
            }
        }
        if constexpr (ALIGN_EPI) { if (wr == 0) PG8_BAR; }
        if constexpr (!Epi::AFTER_DRAIN) { E(acc, cur, wr, wc, fr, fq); S.done(cur); }
        if (!has_next) break;
#pragma unroll
        for (int a = 0; a < 2; ++a)
#pragma unroll
            for (int b = 0; b < 2; ++b)
#pragma unroll
                for (int m = 0; m < 4; ++m)
#pragma unroll
                    for (int n = 0; n < 2; ++n) acc[a][b][m][n] = (f32x4){0.f, 0.f, 0.f, 0.f};
        cur = nxt; cA = nA; cB = nB; ++ui;
        if constexpr (ALIGN_EPI) { if (wr == 1) PG8_BAR; }
    }
    PG8_WAIT_V(0);
    if constexpr (!ALIGN_EPI) { if (wr == 0) PG8_BAR; }
    PG8_BAR;
    if constexpr (Epi::AFTER_DRAIN) { E.fused(acc, cur, wr, wc, fr, fq, lds, wid, lane); S.done(cur); }
#undef PG8_SA
#undef PG8_SB
#undef PG8_STAGE
#undef PG8_LDA
#undef PG8_LDB
#undef PG8_MMA
#undef PG8_WAIT_V
#undef PG8_WAIT_L
#undef PG8_BAR
#undef PG8_SCHED
}
}

#ifndef PG8_SP2
#define PG8_SP2 true
#endif
#ifndef PG8_ALIGN
#define PG8_ALIGN true
#endif
namespace pg8 {
typedef unsigned u32x2 __attribute__((ext_vector_type(2)));
#define PG8_GAS __attribute__((address_space(1)))
constexpr float RMS_EPS = 1e-6f;
constexpr int SS_ROWS = 16384;
__device__ __forceinline__ void row_rs8(float (&rs)[8], const float* ssp, int npart, int row0, int fq) {
    const PG8_GAS float* sp = (const PG8_GAS float*)ssp; float pr[8][4];
#pragma unroll
    for (int r = 0; r < 8; ++r)
#pragma unroll
        for (int i = 0; i < 4; ++i) { const int j = fq * 4 + i; pr[r][i] = sp[(size_t)(j < npart ? j : 0) * SS_ROWS + row0 + (r >> 2) * HALF + (r & 3) * 16]; }
#pragma unroll
    for (int r = 0; r < 8; ++r) { float s = 0.f;
#pragma unroll
        for (int i = 0; i < 4; ++i) s += (fq * 4 + i < npart) ? pr[r][i] : 0.f;
        s += __shfl_xor(s, 16); s += __shfl_xor(s, 32);
        rs[r] = rsqrtf(s * (1.0f / 1024.0f) + RMS_EPS); }
}
struct EpiSwiGLU {
    static constexpr bool PERM = true, AFTER_DRAIN = false;
    bf16_t* O; int ldc; const float* ss; int npart;
    __device__ __forceinline__ void operator()(const f32x4 (&acc)[2][2][4][2], const Unit& u, int wr, int wc, int fr, int fq) const {
        const int row0 = u.pm * BM + wr * 64 + fr, col0 = u.pn * HALF + wc * 32 + 8 * fq;
        float rsv[8]; row_rs8(rsv, ss, npart, row0, fq);
#pragma unroll
        for (int ai = 0; ai < 2; ++ai)
#pragma unroll
            for (int m = 0; m < 4; ++m) {
                const int row = row0 + ai * HALF + m * 16; const float rs = rsv[ai * 4 + m];
                float h[8];
#pragma unroll
                for (int n = 0; n < 2; ++n)
#pragma unroll
                    for (int i = 0; i < 4; ++i) { const float g = acc[ai][0][m][n][i] * rs, up = acc[ai][1][m][n][i] * rs; h[n * 4 + i] = g * __builtin_amdgcn_rcpf(1.0f + __expf(-g)) * up; }
                u32x4 w; w.x = cvt_pk_bf16(h[0], h[1]); w.y = cvt_pk_bf16(h[2], h[3]); w.z = cvt_pk_bf16(h[4], h[5]); w.w = cvt_pk_bf16(h[6], h[7]);
                *(PG8_GAS u32x4*)(O + (size_t)row * ldc + col0) = w;
            }
    }
};
struct EpiScaleBf16 {
    static constexpr bool PERM = true, AFTER_DRAIN = false;
    bf16_t* O; int ldc; const float* ss; int npart;
    __device__ __forceinline__ void operator()(const f32x4 (&acc)[2][2][4][2], const Unit& u, int wr, int wc, int fr, int fq) const {
        const int row0 = u.pm * BM + wr * 64 + fr, col0 = u.pn * BM + wc * 32 + 8 * fq;
        float rsv[8]; row_rs8(rsv, ss, npart, row0, fq);
#pragma unroll
        for (int ai = 0; ai < 2; ++ai)
#pragma unroll
            for (int m = 0; m < 4; ++m) {
                const int row = row0 + ai * HALF + m * 16; const float rs = rsv[ai * 4 + m];
#pragma unroll
                for (int bj = 0; bj < 2; ++bj) { const f32x4 v0 = acc[ai][bj][m][0] * rs, v1 = acc[ai][bj][m][1] * rs;
                    u32x4 w; w.x = cvt_pk_bf16(v0[0], v0[1]); w.y = cvt_pk_bf16(v0[2], v0[3]); w.z = cvt_pk_bf16(v1[0], v1[1]); w.w = cvt_pk_bf16(v1[2], v1[3]);
                    *(PG8_GAS u32x4*)(O + (size_t)row * ldc + col0 + bj * HALF) = w; }
            }
    }
};
struct EpiResid {
    static constexpr bool PERM = false, AFTER_DRAIN = false;
    const float* base32; const bf16_t* baseb; bf16_t* xb; float* ssn; float scale;
    __device__ __forceinline__ void operator()(const f32x4 (&acc)[2][2][4][2], const Unit& u, int wr, int wc, int fr, int fq) const {
        const int col0 = u.pn * BM + wc * 32 + 4 * fq;
#pragma unroll
        for (int ai = 0; ai < 2; ++ai) {
            f32x4 b[4][2][2];
            if (base32) {
#pragma unroll
                for (int m = 0; m < 4; ++m) { const size_t off = (size_t)(u.pm * BM + ai * HALF + wr * 64 + m * 16 + fr) * 1024 + col0;
#pragma unroll
                    for (int bj = 0; bj < 2; ++bj)
#pragma unroll
                        for (int n = 0; n < 2; ++n) b[m][bj][n] = *(const PG8_GAS f32x4*)(base32 + off + bj * HALF + n * 16); }
            } else {
                u32x2 w[4][2][2];
#pragma unroll
                for (int m = 0; m < 4; ++m) { const size_t off = (size_t)(u.pm * BM + ai * HALF + wr * 64 + m * 16 + fr) * 1024 + col0;
#pragma unroll
                    for (int bj = 0; bj < 2; ++bj)
#pragma unroll
                        for (int n = 0; n < 2; ++n) w[m][bj][n] = *(const PG8_GAS u32x2*)(baseb + off + bj * HALF + n * 16); }
#pragma unroll
                for (int m = 0; m < 4; ++m)
#pragma unroll
                    for (int bj = 0; bj < 2; ++bj)
#pragma unroll
                        for (int n = 0; n < 2; ++n) { const u32x2 x = w[m][bj][n]; b[m][bj][n] = (f32x4){__uint_as_float(x.x << 16), __uint_as_float(x.x & 0xffff0000u), __uint_as_float(x.y << 16), __uint_as_float(x.y & 0xffff0000u)}; }
            }
#pragma unroll
            for (int m = 0; m < 4; ++m) {
                const int row = u.pm * BM + ai * HALF + wr * 64 + m * 16 + fr; const size_t off = (size_t)row * 1024 + col0; float s = 0.f;
#pragma unroll
                for (int bj = 0; bj < 2; ++bj)
#pragma unroll
                    for (int n = 0; n < 2; ++n) { const f32x4 v = b[m][bj][n] + acc[ai][bj][m][n] * scale; s += (v[0] * v[0] + v[1] * v[1]) + (v[2] * v[2] + v[3] * v[3]);
                        u32x2 w2; w2.x = cvt_pk_bf16(v[0], v[1]); w2.y = cvt_pk_bf16(v[2], v[3]); *(PG8_GAS u32x2*)(xb + off + bj * HALF + n * 16) = w2; }
                s += __shfl_xor(s, 16); s += __shfl_xor(s, 32);
                if (fq == 0) ((PG8_GAS float*)ssn)[(size_t)(u.pn * 4 + wc) * SS_ROWS + row] = s;
            }
        }
    }
};
}
#define GAS __attribute__((address_space(1)))
#define LAS __attribute__((address_space(3)))
typedef unsigned short bf16;
typedef unsigned v4u __attribute__((ext_vector_type(4)));
typedef float f32x4 __attribute__((ext_vector_type(4)));
typedef short bf16x8 __attribute__((ext_vector_type(8)));
typedef GAS unsigned gu32;
typedef GAS unsigned long long gu64;
#define RLX_AGENT __ATOMIC_RELAXED, __HIP_MEMORY_SCOPE_AGENT
#define LDS_WAIT() asm volatile("s_waitcnt lgkmcnt(0)" ::: "memory")
#define VM_WAIT() asm volatile("s_waitcnt vmcnt(0)" ::: "memory")
__device__ __forceinline__ unsigned long long rt() { return __builtin_amdgcn_s_memrealtime(); }
__device__ __forceinline__ unsigned f2bf(float f) { unsigned u = __builtin_bit_cast(unsigned, f); return (u + 0x7fffu + ((u >> 16) & 1u)) >> 16; }
__device__ __forceinline__ unsigned pk2(float lo, float hi) { return f2bf(lo) | (f2bf(hi) << 16); }

#define XB_TMO      128
#define XB_XCNT(j)  (256  + 64 * (j))
#define XB_XSUB(j)  (1280 + 64 * (j))
#define XB_XGEN(j)  (2304 + 64 * (j))
#define XB_TOP      3328
#define XB_TOPGEN   3392
#define XCD_BAR_WORDS 3456
#define XB_SPIN_CAP (1u << 18)

__device__ __forceinline__ unsigned xb_ld(unsigned* p)              { return __hip_atomic_load(p, __ATOMIC_RELAXED, __HIP_MEMORY_SCOPE_AGENT); }
__device__ __forceinline__ unsigned xb_add(unsigned* p, unsigned v) { return __hip_atomic_fetch_add(p, v, __ATOMIC_RELAXED, __HIP_MEMORY_SCOPE_AGENT); }
__device__ __forceinline__ unsigned xb_xcc_id() { return (unsigned)__builtin_amdgcn_s_getreg((3 << 11) | 20) & 0xFu; }
#define XB_SPIN(cond, bar) do { unsigned _sp = 0; while (cond) { __builtin_amdgcn_s_sleep(1); \
    if ((++_sp & 255u) == 0u) { if (xb_ld(&(bar)[XB_TMO])) break; if (_sp > XB_SPIN_CAP) { atomicAdd(&(bar)[XB_TMO], 1u); break; } } } } while (0)

struct XcdBarrier {
    unsigned* bar; unsigned x; bool w0;
    volatile LAS unsigned* st;
};

__device__ __forceinline__ XcdBarrier xcd_barrier_post(unsigned* bar, volatile LAS unsigned* st, int wave_s) {
    XcdBarrier b; b.bar = bar; b.x = xb_xcc_id(); b.st = st; b.w0 = wave_s == 0;
    if (wave_s == 0 && MK_LANE() == 0) (void)xb_add(&bar[XB_XCNT(b.x)], 1u);
    return b;
}
__device__ __forceinline__ void xcd_barrier_complete(unsigned* bar, unsigned x, unsigned& nloc, unsigned& nx) {
    const unsigned G = gridDim.x * gridDim.y * gridDim.z;
    unsigned sum, cnt, mine, sp = 0u;
    for (;;) {
        sum = 0u; cnt = 0u; mine = 0u;
#pragma unroll
        for (unsigned j = 0; j < 16; ++j) { const unsigned c = xb_ld(&bar[XB_XCNT(j)]); sum += c; cnt += (c > 0u) ? 1u : 0u; mine = (j == x) ? c : mine; }
        if (sum == G) break;
        __builtin_amdgcn_s_sleep(1);
        if ((++sp & 255u) == 0u) { if (xb_ld(&bar[XB_TMO])) break; if (sp > XB_SPIN_CAP) { atomicAdd(&bar[XB_TMO], 1u); break; } }
    }
    nloc = mine > 0u ? mine : 1u; nx = cnt > 0u ? cnt : 1u;
}

__device__ __forceinline__ void xcd_barrier(const XcdBarrier& b) {
    asm volatile("s_waitcnt vmcnt(0)" ::: "memory");
    __syncthreads();
    if (b.w0 && MK_LANE() == 0) {
        unsigned* bar = b.bar;
        __builtin_amdgcn_s_waitcnt(0);
        unsigned nloc = b.st[0], nx = b.st[1];
        if (nloc == 0u) { xcd_barrier_complete(bar, b.x, nloc, nx); b.st[0] = nloc; b.st[1] = nx; }
        const unsigned old = xb_add(&bar[XB_XSUB(b.x)], 1u);
        const unsigned gen = old / nloc;
        if (old + 1u == (gen + 1u) * nloc) {
            __builtin_amdgcn_fence(__ATOMIC_RELEASE, "agent");
            asm volatile("s_waitcnt vmcnt(0)" ::: "memory");
            const unsigned og = xb_add(&bar[XB_TOP], 1u);
            const unsigned tg = og / nx;
            if (og + 1u == (tg + 1u) * nx) xb_add(&bar[XB_TOPGEN], 1u);
            else XB_SPIN(xb_ld(&bar[XB_TOPGEN]) == tg, bar);
            __builtin_amdgcn_fence(__ATOMIC_ACQUIRE, "agent");
            xb_add(&bar[XB_XGEN(b.x)], 1u);
            asm volatile("s_waitcnt vmcnt(0)" ::: "memory");
        } else {
            XB_SPIN(xb_ld(&bar[XB_XGEN(b.x)]) == gen, bar);
            __builtin_amdgcn_fence(__ATOMIC_ACQUIRE, "agent");
            asm volatile("s_waitcnt vmcnt(0)" ::: "memory");
        }
    }
    __syncthreads();
}
constexpr int NWAVES = 8;
constexpr int BATCH = 2, SEQ = 8192, D = 1024, M = BATCH * SEQ, FF = 2816, HD = 64, HYB = 3584, SBW = 3072;
constexpr size_t MiB = 1u << 20;
constexpr size_t WS_CTL = 0, CTL_ZERO_BYTES = 1 * MiB;
constexpr size_t WS_W = 1 * MiB;
constexpr size_t WS_XBA = 43 * MiB, WS_XBB = 75 * MiB;
constexpr size_t WS_BIG = 107 * MiB;
constexpr size_t WS_KV = 219 * MiB;
constexpr size_t WS_ST = 235 * MiB;
constexpr size_t WS_TAB = 243 * MiB;
constexpr size_t WS_SS = 246 * MiB;
constexpr size_t WS_LSE = 247 * MiB;
constexpr size_t WS_SSP = 248 * MiB;
constexpr size_t WO_F1IN = 0, WO_F1OUT = 5767168, WO_MIXIN = 8650752, WO_MIXOUT = 12320768, WO_F2IN = 13369344, WO_F2OUT = 19136512;
constexpr int CW_BAR = 4096;
constexpr int RING_OFF = 0, RING_BYTES = 131072, LDSCTL_OFF = RING_BYTES, MISC_OFF = LDSCTL_OFF + 320, LDS_BYTES = 147456;

__device__ __forceinline__ float wave_sum(float v) {
#pragma unroll
    for (int o = 1; o < 64; o <<= 1) v += __shfl_xor(v, o);
    return v;
}
__device__ __forceinline__ float bf2f(bf16 v) { return __uint_as_float(((unsigned)v) << 16); }

__device__ __forceinline__ void transpose_item(const float* W, const float* gain, int K, int N, bf16* WT, int dest_row0, int k0, int n0, LAS float* scr, int lane) {
    float wv[32];
#pragma unroll
    for (int i = 0; i < 32; ++i) wv[i] = ((const GAS float*)W)[(size_t)(k0 + 2 * i + (lane >> 5)) * N + n0 + (lane & 31)];
#pragma unroll
    for (int i = 0; i < 32; ++i) { const int kk = 2 * i + (lane >> 5); const float gk = gain ? gain[k0 + kk] : 1.0f; scr[kk * 33 + (lane & 31)] = wv[i] * gk; }
    LDS_WAIT(); asm volatile("" ::: "memory");
    const int c = lane & 7;
#pragma unroll
    for (int j = 0; j < 4; ++j) { const int n = (lane >> 3) + 8 * j; const LAS float* s = scr + (8 * c) * 33 + n;
        v4u o; o.x = pk2(s[0 * 33], s[1 * 33]); o.y = pk2(s[2 * 33], s[3 * 33]); o.z = pk2(s[4 * 33], s[5 * 33]); o.w = pk2(s[6 * 33], s[7 * 33]);
        *(GAS v4u*)(WT + (size_t)(dest_row0 + n) * K + k0 + 8 * c) = o; }
    LDS_WAIT(); asm volatile("" ::: "memory");
}
struct Args { const float* in[14]; float* out; unsigned char* ws; int ph_lo, ph_hi, li, mask; };

__device__ __forceinline__ void convert_layer(const Args& a, int l, LAS float* scr, int gw, int NGW, int lane) {
    bf16* Wb = (bf16*)(a.ws + WS_W);
    const int mixN = l == 0 ? HYB : SBW;
    const int I_IN = (D / 64) * (2 * FF / 32), I_OUT = (FF / 64) * (D / 32), I_MI = (D / 64) * (mixN / 32), I_MO = (D / 64) * (D / 32);
    const int NITEMS = 2 * I_IN + 2 * I_OUT + I_MI + I_MO;
    for (int it = gw; it < NITEMS; it += NGW) {
        int r = it; const float* W; const float* gain = nullptr; int K, N; bf16* WT; bool swi = false;
        if (r < I_IN) { W = a.in[2] + (size_t)l * D * 2 * FF; gain = a.in[1] + l * D; K = D; N = 2 * FF; WT = Wb + WO_F1IN; swi = true; }
        else if ((r -= I_IN) < I_IN) { W = a.in[6] + (size_t)l * D * 2 * FF; gain = a.in[5] + l * D; K = D; N = 2 * FF; WT = Wb + WO_F2IN; swi = true; }
        else if ((r -= I_IN) < I_OUT) { W = a.in[3] + (size_t)l * FF * D; K = FF; N = D; WT = Wb + WO_F1OUT; }
        else if ((r -= I_OUT) < I_OUT) { W = a.in[7] + (size_t)l * FF * D; K = FF; N = D; WT = Wb + WO_F2OUT; }
        else if ((r -= I_OUT) < I_MI) { W = l == 0 ? a.in[8] : a.in[11]; gain = a.in[4] + l * D; K = D; N = mixN; WT = Wb + WO_MIXIN; }
        else { r -= I_MI; W = l == 0 ? a.in[10] : a.in[12]; K = D; N = D; WT = Wb + WO_MIXOUT; }
        const int nblk = N / 32, kb = r / nblk, nb = r % nblk, n0 = 32 * nb; int dest = n0;
        if (swi) { const int up = n0 >= FF ? 1 : 0, j0 = n0 - up * FF; dest = (j0 / 128) * 256 + up * 128 + (j0 % 128); }
        transpose_item(W, gain, K, N, WT, dest, 64 * kb, n0, scr, lane);
    }
}
namespace mix {
typedef short bfx8 __attribute__((ext_vector_type(8)));
typedef unsigned u32x2v __attribute__((ext_vector_type(2)));
typedef unsigned short u16;
#define MFMA16(a, b, c) __builtin_amdgcn_mfma_f32_16x16x32_bf16(a, b, c, 0, 0, 0)
constexpr int QP = 72;
constexpr int OFF_Q = 0, OFF_K = 18432, OFF_V = 55296, OFF_FLAG = 89088;
constexpr float LOG2E = 1.4426950408889634f, LN2 = 0.6931471805599453f;

__device__ __forceinline__ float bfe(const v4u& a, int e) { return __uint_as_float((e & 1) ? (a[e >> 1] & 0xffff0000u) : (a[e >> 1] << 16)); }
typedef float f32x2_t __attribute__((ext_vector_type(2))); typedef __bf16 bf16x2_t __attribute__((ext_vector_type(2)));
__device__ __forceinline__ unsigned pkbf(float lo, float hi) { const f32x2_t v = {lo, hi}; const bf16x2_t b = __builtin_convertvector(v, bf16x2_t); return __builtin_bit_cast(unsigned, b); }
__device__ __forceinline__ bfx8 pack8(const f32x4& p0, const f32x4& p1) { v4u w; w.x = pkbf(p0[0], p0[1]); w.y = pkbf(p0[2], p0[3]); w.z = pkbf(p1[0], p1[1]); w.w = pkbf(p1[2], p1[3]); return __builtin_bit_cast(bfx8, w); }

template <int MODE>
__device__ __forceinline__ void stage_rows(LAS bf16* dst, const bf16* src, size_t rowStride, int nrows, int pos0, int posStride, const float* ctab, const float* stab, int tid) {
    for (int it = tid; it < nrows * 4; it += 512) {
        const int row = it >> 2, c = it & 3; const bf16* p = src + (size_t)row * rowStride;
        v4u a = *(const GAS v4u*)(p + 8 * c), b = *(const GAS v4u*)(p + 32 + 8 * c);
        if (MODE == 1) {
            const int pos = pos0 + row * posStride; const GAS f32x4* ct = (const GAS f32x4*)(ctab + pos * 32 + 8 * c); const GAS f32x4* sn = (const GAS f32x4*)(stab + pos * 32 + 8 * c);
            const f32x4 c0 = ct[0], c1 = ct[1], s0 = sn[0], s1 = sn[1]; float y1[8], y2[8];
#pragma unroll
            for (int e = 0; e < 8; ++e) { const float cs = e < 4 ? c0[e & 3] : c1[e & 3], si = e < 4 ? s0[e & 3] : s1[e & 3]; const float x1 = bfe(a, e), x2 = bfe(b, e); y1[e] = x1 * cs - x2 * si; y2[e] = x2 * cs + x1 * si; }
            a.x = pkbf(y1[0], y1[1]); a.y = pkbf(y1[2], y1[3]); a.z = pkbf(y1[4], y1[5]); a.w = pkbf(y1[6], y1[7]);
            b.x = pkbf(y2[0], y2[1]); b.y = pkbf(y2[2], y2[3]); b.z = pkbf(y2[4], y2[5]); b.w = pkbf(y2[6], y2[7]);
        }
        if (MODE == 2) {
            v4u o; o.x = __shfl_xor(a.x, 1); o.y = __shfl_xor(a.y, 1); o.z = __shfl_xor(a.z, 1); o.w = __shfl_xor(a.w, 1);
            if (c < 2) {
                const int pos = pos0 + row * posStride; const GAS f32x4* ct = (const GAS f32x4*)(ctab + pos * 8); const GAS f32x4* sn = (const GAS f32x4*)(stab + pos * 8);
                const f32x4 c0 = ct[0], c1 = ct[1], s0 = sn[0], s1 = sn[1]; float y[8];
#pragma unroll
                for (int e = 0; e < 8; ++e) { const float cs = e < 4 ? c0[e & 3] : c1[e & 3], si = e < 4 ? s0[e & 3] : s1[e & 3]; const float xo = bfe(a, e), xp = bfe(o, e); y[e] = c == 0 ? (xo * cs - xp * si) : (xo * cs + xp * si); }
                a.x = pkbf(y[0], y[1]); a.y = pkbf(y[2], y[3]); a.z = pkbf(y[4], y[5]); a.w = pkbf(y[6], y[7]);
            }
        }
        *(LAS v4u*)(dst + row * QP + 8 * c) = a; *(LAS v4u*)(dst + row * QP + 32 + 8 * c) = b;
    }
}
__device__ __forceinline__ void stage_vt(LAS bf16* dst, int pitch, int key_off, const bf16* src, size_t rowStride, int tid) {
    for (int it = tid; it < 128 * 8; it += 512) {
        const int key = it & 127, c = it >> 7; const v4u a = *(const GAS v4u*)(src + (size_t)key * rowStride + 8 * c);
#pragma unroll
        for (int e = 0; e < 8; ++e) dst[(8 * c + e) * pitch + key_off + key] = (bf16)((e & 1) ? (a[e >> 1] >> 16) : (a[e >> 1] & 0xffffu));
    }
}
struct RR { v4u a, b; };
struct TT { f32x4 c0, c1, s0, s1; };
struct VV { v4u v0, v1; };
__device__ __forceinline__ void ld_rows(RR& r, const bf16* src, size_t rowStride, int tid) { const bf16* p = src + (size_t)(tid >> 2) * rowStride + 8 * (tid & 3); r.a = *(const GAS v4u*)p; r.b = *(const GAS v4u*)(p + 32); }
__device__ __forceinline__ void st_rows(LAS bf16* dst, const RR& r, int tid) { LAS bf16* q = dst + (tid >> 2) * QP + 8 * (tid & 3); *(LAS v4u*)q = r.a; *(LAS v4u*)(q + 32) = r.b; }
__device__ __forceinline__ void ld_tab(TT& t, const float* ctab, const float* stab, int idx) { const GAS f32x4* ct = (const GAS f32x4*)(ctab + idx); const GAS f32x4* sn = (const GAS f32x4*)(stab + idx); t.c0 = ct[0]; t.c1 = ct[1]; t.s0 = sn[0]; t.s1 = sn[1]; }
__device__ __forceinline__ void rot1(RR& r, const TT& t) {
    float y1[8], y2[8];
#pragma unroll
    for (int e = 0; e < 8; ++e) { const float cs = e < 4 ? t.c0[e & 3] : t.c1[e & 3], si = e < 4 ? t.s0[e & 3] : t.s1[e & 3]; const float x1 = bfe(r.a, e), x2 = bfe(r.b, e); y1[e] = x1 * cs - x2 * si; y2[e] = x2 * cs + x1 * si; }
    r.a.x = pkbf(y1[0], y1[1]); r.a.y = pkbf(y1[2], y1[3]); r.a.z = pkbf(y1[4], y1[5]); r.a.w = pkbf(y1[6], y1[7]);
    r.b.x = pkbf(y2[0], y2[1]); r.b.y = pkbf(y2[2], y2[3]); r.b.z = pkbf(y2[4], y2[5]); r.b.w = pkbf(y2[6], y2[7]);
}
__device__ __forceinline__ void rot2(RR& r, const TT& t, int c) {
    v4u o; o.x = __shfl_xor(r.a.x, 1); o.y = __shfl_xor(r.a.y, 1); o.z = __shfl_xor(r.a.z, 1); o.w = __shfl_xor(r.a.w, 1);
    if (c < 2) { float y[8];
#pragma unroll
        for (int e = 0; e < 8; ++e) { const float cs = e < 4 ? t.c0[e & 3] : t.c1[e & 3], si = e < 4 ? t.s0[e & 3] : t.s1[e & 3]; const float xo = bfe(r.a, e), xp = bfe(o, e); y[e] = c == 0 ? (xo * cs - xp * si) : (xo * cs + xp * si); }
        r.a.x = pkbf(y[0], y[1]); r.a.y = pkbf(y[2], y[3]); r.a.z = pkbf(y[4], y[5]); r.a.w = pkbf(y[6], y[7]); }
}
__device__ __forceinline__ void ld_vt(VV& v, const bf16* src, size_t rowStride, int tid) { const bf16* p = src + (size_t)(2 * (tid & 63)) * rowStride + 8 * (tid >> 6); v.v0 = *(const GAS v4u*)p; v.v1 = *(const GAS v4u*)(p + rowStride); }
__device__ __forceinline__ void st_vt(LAS bf16* dst, int pitch, int key_off, const VV& v, int tid) { const int kp = tid & 63, c = tid >> 6;
#pragma unroll
    for (int e = 0; e < 8; ++e) { const unsigned a = v.v0[e >> 1], b2 = v.v1[e >> 1]; const unsigned wd = (e & 1) ? ((a >> 16) | (b2 & 0xffff0000u)) : ((a & 0xffffu) | (b2 << 16));
        *(LAS unsigned*)(dst + (8 * c + e) * pitch + key_off + 2 * kp) = wd; }
}
__device__ __forceinline__ void stage_kt_ret(LAS bf16* dst, const bf16* src, size_t rowStride, int pos0, const float* ctab, const float* stab, float log2g, int tid) {
    { const int it = tid; const int key = it & 127, c = it >> 7; const bf16* p = src + (size_t)key * rowStride;
        const v4u a = *(const GAS v4u*)(p + 8 * c), b = *(const GAS v4u*)(p + 32 + 8 * c);
        const int pos = pos0 + key; const GAS f32x4* ct = (const GAS f32x4*)(ctab + pos * 32 + 8 * c); const GAS f32x4* sn = (const GAS f32x4*)(stab + pos * 32 + 8 * c);
        const f32x4 c0 = ct[0], c1 = ct[1], s0 = sn[0], s1 = sn[1]; const float kd = 0.125f * exp2f((float)(127 - key) * log2g);
#pragma unroll
        for (int e = 0; e < 8; ++e) { const float cs = e < 4 ? c0[e & 3] : c1[e & 3], si = e < 4 ? s0[e & 3] : s1[e & 3]; const float x1 = bfe(a, e), x2 = bfe(b, e);
            dst[(8 * c + e) * 136 + key] = (bf16)f2bf((x1 * cs - x2 * si) * kd); dst[(32 + 8 * c + e) * 136 + key] = (bf16)f2bf((x2 * cs + x1 * si) * kd); }
    }
}
__device__ __forceinline__ f32x4 st_tile(const LAS bf16* Ks, int T, const bfx8 (&qf)[2], int c16, int g) {
    f32x4 acc = (f32x4){0.f, 0.f, 0.f, 0.f};
#pragma unroll
    for (int ks = 0; ks < 2; ++ks) { const bfx8 a = *(const LAS bfx8*)(Ks + (16 * T + c16) * QP + 32 * ks + 8 * g); acc = MFMA16(a, qf[ks], acc); }
    return acc;
}
__device__ __forceinline__ void st_tiles8(const LAS bf16* Ks, int T0, const bfx8 (&qf)[2], int c16, int g, f32x4 (&out)[8]) {
    bfx8 a[8][2];
#pragma unroll
    for (int T = 0; T < 8; ++T)
#pragma unroll
        for (int ks = 0; ks < 2; ++ks) a[T][ks] = *(const LAS bfx8*)(Ks + (16 * (T0 + T) + c16) * QP + 32 * ks + 8 * g);
#pragma unroll
    for (int T = 0; T < 8; ++T) { f32x4 acc = (f32x4){0.f, 0.f, 0.f, 0.f};
#pragma unroll
        for (int ks = 0; ks < 2; ++ks) acc = MFMA16(a[T][ks], qf[ks], acc);
        out[T] = acc; }
}
__device__ __forceinline__ void pv_pair(f32x4 (&o)[4], const LAS bf16* Vs, int vp, int t0, int t1, const f32x4& p0, const f32x4& p1, int c16, int g) {
    const bfx8 pb = pack8(p0, p1); u32x2v lo[4], hi[4];
#pragma unroll
    for (int dt = 0; dt < 4; ++dt) { lo[dt] = *(const LAS u32x2v*)(Vs + (16 * dt + c16) * vp + 16 * t0 + 4 * g); hi[dt] = *(const LAS u32x2v*)(Vs + (16 * dt + c16) * vp + 16 * t1 + 4 * g); }
#pragma unroll
    for (int dt = 0; dt < 4; ++dt) { v4u av; av.x = lo[dt].x; av.y = lo[dt].y; av.z = hi[dt].x; av.w = hi[dt].y; o[dt] = MFMA16(__builtin_bit_cast(bfx8, av), pb, o[dt]); }
}

__device__ __forceinline__ void ret_kv_unit(int u, const bf16* proj, const float* rc, const float* rs, float* kv, LAS unsigned char* lds, int tid) {
    const int n = u & 63, bh = u >> 6, h = bh & 7, b = bh >> 3; const int lane = tid & 63, w = __builtin_amdgcn_readfirstlane(tid >> 6), c16 = lane & 15, g = lane >> 4;
    const float log2g = log2f(1.0f - exp2f(-5.0f - (float)h));
    const bf16* rowp = proj + (size_t)(b * SEQ + n * 128) * HYB + h * 64;
    LAS bf16* Kt = (LAS bf16*)(lds + OFF_Q); LAS bf16* Vt = (LAS bf16*)(lds + OFF_V);
    { const int key = tid & 127, c = tid >> 7; const bf16* p = rowp + 512 + (size_t)key * HYB;
        const v4u a = *(const GAS v4u*)(p + 8 * c), b2 = *(const GAS v4u*)(p + 32 + 8 * c); TT t; ld_tab(t, rc, rs, (n * 128 + key) * 32 + 8 * c); VV vv; ld_vt(vv, rowp + 1024, HYB, tid);
        const float kd = 0.125f * __builtin_amdgcn_exp2f((float)(127 - key) * log2g);
#pragma unroll
        for (int e = 0; e < 8; ++e) { const float cs = e < 4 ? t.c0[e & 3] : t.c1[e & 3], si = e < 4 ? t.s0[e & 3] : t.s1[e & 3]; const float x1 = bfe(a, e), x2 = bfe(b2, e);
            Kt[(8 * c + e) * 136 + key] = (bf16)f2bf((x1 * cs - x2 * si) * kd); Kt[(32 + 8 * c + e) * 136 + key] = (bf16)f2bf((x2 * cs + x1 * si) * kd); }
        st_vt(Vt, 136, 0, vv, tid); }
    __syncthreads();
    const int dvt = w >> 1;
#pragma unroll
    for (int i = 0; i < 2; ++i) { const int dkt = 2 * (w & 1) + i; f32x4 acc = (f32x4){0.f, 0.f, 0.f, 0.f};
#pragma unroll
        for (int ks = 0; ks < 4; ++ks) { const bfx8 a = *(const LAS bfx8*)(Vt + (16 * dvt + c16) * 136 + 32 * ks + 8 * g), bb = *(const LAS bfx8*)(Kt + (16 * dkt + c16) * 136 + 32 * ks + 8 * g); acc = MFMA16(a, bb, acc); }
        float* o = kv + ((size_t)n * 16 + bh) * 4096;
#pragma unroll
        for (int r = 0; r < 4; ++r) o[(16 * dvt + 4 * g + r) * 64 + 16 * dkt + c16] = acc[r]; }
    __syncthreads();
}
__device__ __forceinline__ void ret_scan(int chain, const float* kv, bf16* St) {
    const int h = (chain >> 12) & 7; const float cd = exp2f(128.0f * log2f(1.0f - exp2f(-5.0f - (float)h)));
    float state = 0.f; const GAS float* kvp = (const GAS float*)kv + chain; GAS bf16* stp = (GAS bf16*)St + chain;
#pragma unroll
    for (int n0 = 0; n0 < 64; n0 += 32) {
        float v[32];
#pragma unroll
        for (int i = 0; i < 32; ++i) v[i] = kvp[(size_t)(n0 + i) * 65536];
#pragma unroll
        for (int i = 0; i < 32; ++i) { stp[(size_t)(n0 + i) * 65536] = (bf16)f2bf(state); state = state * cd + v[i]; }
    }
}
__device__ __forceinline__ void ret_out_unit(int u, const bf16* proj, const float* rc, const float* rs, const bf16* St, const float* gn, bf16* cat, LAS unsigned char* lds, int tid) {
    const int n = u & 63, bh = u >> 6, h = bh & 7, b = bh >> 3; const int lane = tid & 63, w = __builtin_amdgcn_readfirstlane(tid >> 6), c16 = lane & 15, g = lane >> 4;
    const float log2g = log2f(1.0f - exp2f(-5.0f - (float)h));
    const size_t row0 = (size_t)(b * SEQ + n * 128); const bf16* rowp = proj + row0 * HYB + h * 64;
    LAS bf16* Qs = (LAS bf16*)(lds + OFF_Q); LAS bf16* Ks = (LAS bf16*)(lds + OFF_K); LAS bf16* Vs = (LAS bf16*)(lds + OFF_V);
    { RR rq, rk, rst; TT t; VV vv;
        ld_rows(rq, rowp, HYB, tid); ld_rows(rk, rowp + 512, HYB, tid); ld_tab(t, rc, rs, (n * 128 + (tid >> 2)) * 32 + 8 * (tid & 3)); ld_vt(vv, rowp + 1024, HYB, tid);
        if (tid < 256) ld_rows(rst, St + ((size_t)n * 16 + bh) * 4096, 64, tid);
        rot1(rq, t); rot1(rk, t); st_rows(Qs, rq, tid); st_rows(Ks, rk, tid); st_vt(Vs, 136, 0, vv, tid);
        if (tid < 256) st_rows(Ks + 128 * QP, rst, tid); }
    __syncthreads();
    bfx8 qf[2];
#pragma unroll
    for (int ks = 0; ks < 2; ++ks) qf[ks] = *(const LAS bfx8*)(Qs + (16 * w + c16) * QP + 32 * ks + 8 * g);
    const int qi = 16 * w + c16;
    f32x4 o[4], cr[4];
#pragma unroll
    for (int dt = 0; dt < 4; ++dt) { o[dt] = (f32x4){0.f, 0.f, 0.f, 0.f}; cr[dt] = (f32x4){0.f, 0.f, 0.f, 0.f}; }
#pragma unroll
    for (int tp = 0; tp < 4; ++tp) {
        f32x4 p[2];
#pragma unroll
        for (int i = 0; i < 2; ++i) { const int T = 2 * tp + i; const f32x4 s = st_tile(Ks, T, qf, c16, g);
#pragma unroll
            for (int r = 0; r < 4; ++r) { const int kj = 16 * T + 4 * g + r; const int dd = qi - kj; p[i][r] = dd >= 0 ? s[r] * 0.125f * __builtin_amdgcn_exp2f((float)dd * log2g) : 0.f; } }
        pv_pair(o, Vs, 136, 2 * tp, 2 * tp + 1, p[0], p[1], c16, g);
    }
#pragma unroll
    for (int dt = 0; dt < 4; ++dt) cr[dt] = st_tile(Ks, 8 + dt, qf, c16, g);
    const float qd = exp2f((float)(qi + 1) * log2g);
    float sum = 0.f;
#pragma unroll
    for (int dt = 0; dt < 4; ++dt) { o[dt] = o[dt] + cr[dt] * qd; sum += (o[dt][0] + o[dt][1]) + (o[dt][2] + o[dt][3]); }
    sum += __shfl_xor(sum, 16); sum += __shfl_xor(sum, 32);
    const float mu = sum * (1.0f / 64.0f); float var = 0.f;
#pragma unroll
    for (int dt = 0; dt < 4; ++dt) { o[dt] = o[dt] - mu; var += (o[dt][0] * o[dt][0] + o[dt][1] * o[dt][1]) + (o[dt][2] * o[dt][2] + o[dt][3] * o[dt][3]); }
    var += __shfl_xor(var, 16); var += __shfl_xor(var, 32);
    const float rstd = rsqrtf(var * (1.0f / 64.0f) + 1e-5f);
    const size_t tok = row0 + qi;
    f32x4 ggv[4]; u32x2v rgv[4];
#pragma unroll
    for (int dt = 0; dt < 4; ++dt) { const int d0 = 16 * dt + 4 * g; ggv[dt] = *(const GAS f32x4*)(gn + h * 64 + d0); rgv[dt] = *(const GAS u32x2v*)(proj + tok * HYB + 1536 + h * 64 + d0); }
#pragma unroll
    for (int dt = 0; dt < 4; ++dt) { const int d0 = 16 * dt + 4 * g; const f32x4 gg = ggv[dt]; const u32x2v rgw = rgv[dt];
        float y[4];
#pragma unroll
        for (int r = 0; r < 4; ++r) { const float gate = __uint_as_float((r & 1) ? (rgw[r >> 1] & 0xffff0000u) : (rgw[r >> 1] << 16)); y[r] = o[dt][r] * rstd * gg[r] * (gate * __builtin_amdgcn_rcpf(1.0f + __expf(-gate))); }
        u32x2v wv; wv.x = pkbf(y[0], y[1]); wv.y = pkbf(y[2], y[3]); *(GAS u32x2v*)(cat + tok * D + h * 64 + d0) = wv; }
    __syncthreads();
}

__device__ __forceinline__ void dil_unit(int u, const bf16* proj, const float* dc, const float* ds, bf16* part, float* lsep, bf16* cat, LAS unsigned char* lds, int tid) {
    const int idx = u & 63, h = (u >> 6) & 7, b = (u >> 9) & 1, p = u >> 10; const int dil = p == 0 ? 1 : (p == 1 ? 4 : 16), nper = 64 / dil, r = idx / nper, nbi = idx % nper;
    const int lane = tid & 63, w = __builtin_amdgcn_readfirstlane(tid >> 6), c16 = lane & 15, g = lane >> 4;
    const bf16* bp = proj + (size_t)b * SEQ * HYB + h * 64; const int t0 = (128 * nbi) * dil + r;
    LAS bf16* Qs = (LAS bf16*)(lds + OFF_Q); LAS bf16* Ks = (LAS bf16*)(lds + OFF_K); LAS bf16* Vs = (LAS bf16*)(lds + OFF_V);
    const size_t rstr = (size_t)dil * HYB;
    { RR rq, rk, rkp; TT t, tp_; VV vv, vvp; const int tp = t0 - 128 * dil, srow = tid >> 2, sc = tid & 3;
        ld_rows(rq, bp + (size_t)t0 * HYB + 2048, rstr, tid); ld_rows(rk, bp + (size_t)t0 * HYB + 2560, rstr, tid); ld_tab(t, dc, ds, (t0 + srow * dil) * 8); ld_vt(vv, bp + (size_t)t0 * HYB + 3072, rstr, tid);
        if (nbi > 0) { ld_rows(rkp, bp + (size_t)tp * HYB + 2560, rstr, tid); ld_tab(tp_, dc, ds, (tp + srow * dil) * 8); ld_vt(vvp, bp + (size_t)tp * HYB + 3072, rstr, tid); }
        rot2(rq, t, sc); rot2(rk, t, sc); st_rows(Qs, rq, tid); st_rows(Ks + 128 * QP, rk, tid); st_vt(Vs, 264, 128, vv, tid);
        if (nbi > 0) { rot2(rkp, tp_, sc); st_rows(Ks, rkp, tid); st_vt(Vs, 264, 0, vvp, tid); } }
    __syncthreads();
    bfx8 qf[2];
#pragma unroll
    for (int ks = 0; ks < 2; ++ks) qf[ks] = *(const LAS bfx8*)(Qs + (16 * w + c16) * QP + 32 * ks + 8 * g);
    const int qi = 16 * w + c16; const int Tlo = nbi > 0 ? w : 8, Thi = 8 + w;
    f32x4 s[16]; float m = -INFINITY;
#pragma unroll
    for (int T = 0; T < 16; ++T) { s[T] = (f32x4){-INFINITY, -INFINITY, -INFINITY, -INFINITY};
        if (T >= Tlo && T <= Thi) { const f32x4 a = st_tile(Ks, T, qf, c16, g);
#pragma unroll
            for (int rr = 0; rr < 4; ++rr) { const int kj = 16 * (T & 7) + 4 * g + rr; const bool ok = T < 8 ? (kj >= qi) : (kj <= qi); s[T][rr] = ok ? a[rr] * 0.125f : -INFINITY; m = fmaxf(m, s[T][rr]); } } }
    m = fmaxf(m, __shfl_xor(m, 16)); m = fmaxf(m, __shfl_xor(m, 32));
    float l = 0.f;
#pragma unroll
    for (int T = 0; T < 16; ++T) {
        if (T >= Tlo && T <= Thi) {
#pragma unroll
            for (int rr = 0; rr < 4; ++rr) { const float e = __builtin_amdgcn_exp2f((s[T][rr] - m) * LOG2E); s[T][rr] = e; l += e; }
        } else s[T] = (f32x4){0.f, 0.f, 0.f, 0.f};
    }
    l += __shfl_xor(l, 16); l += __shfl_xor(l, 32);
    f32x4 o[4];
#pragma unroll
    for (int dt = 0; dt < 4; ++dt) o[dt] = (f32x4){0.f, 0.f, 0.f, 0.f};
#pragma unroll
    for (int tp = 0; tp < 8; ++tp) if (2 * tp + 1 >= Tlo && 2 * tp <= Thi) {
        const int ta = 2 * tp, tb = 2 * tp + 1;
        const int ra = ta >= Tlo ? ta : tb, rb = tb <= Thi ? tb : ta;
        pv_pair(o, Vs, 264, ra, rb, s[ta], s[tb], c16, g);
    }
    const float rl = 1.0f / l, lse = m + __logf(l);
    const size_t tok = (size_t)b * SEQ + t0 + (size_t)qi * dil;
    if (p < 2) {
        if (g == 0) lsep[(size_t)p * M * 8 + tok * 8 + h] = lse;
#pragma unroll
        for (int dt = 0; dt < 4; ++dt) { u32x2v wv; wv.x = pkbf(o[dt][0] * rl, o[dt][1] * rl); wv.y = pkbf(o[dt][2] * rl, o[dt][3] * rl); *(GAS u32x2v*)(part + (size_t)p * M * 512 + tok * 512 + h * 64 + 16 * dt + 4 * g) = wv; }
    } else {
        const float l0 = ((const GAS float*)lsep)[tok * 8 + h], l1 = ((const GAS float*)lsep)[(size_t)M * 8 + tok * 8 + h];
        u32x2v x0v[4], x1v[4];
#pragma unroll
        for (int dt = 0; dt < 4; ++dt) { const int d0 = h * 64 + 16 * dt + 4 * g; x0v[dt] = *(const GAS u32x2v*)(part + tok * 512 + d0); x1v[dt] = *(const GAS u32x2v*)(part + (size_t)M * 512 + tok * 512 + d0); }
        const float mm = fmaxf(lse, fmaxf(l0, l1));
        const float w0 = __expf(l0 - mm), w1 = __expf(l1 - mm), w2 = __expf(lse - mm); const float inv = 1.0f / (w0 + w1 + w2); const float a0 = w0 * inv, a1 = w1 * inv, a2 = w2 * inv * rl;
#pragma unroll
        for (int dt = 0; dt < 4; ++dt) { const int d0 = h * 64 + 16 * dt + 4 * g; const u32x2v x0 = x0v[dt], x1 = x1v[dt]; float y[4];
#pragma unroll
            for (int rr = 0; rr < 4; ++rr) { const float v0 = __uint_as_float((rr & 1) ? (x0[rr >> 1] & 0xffff0000u) : (x0[rr >> 1] << 16)), v1 = __uint_as_float((rr & 1) ? (x1[rr >> 1] & 0xffff0000u) : (x1[rr >> 1] << 16)); y[rr] = a0 * v0 + a1 * v1 + a2 * o[dt][rr]; }
            u32x2v wv; wv.x = pkbf(y[0], y[1]); wv.y = pkbf(y[2], y[3]); *(GAS u32x2v*)(cat + tok * D + 512 + d0) = wv; }
    }
    __syncthreads();
}
}
namespace mix {
__device__ __forceinline__ void sb_unit(int u, const bf16* qkv, bf16* cat, LAS unsigned char* lds, int tid) {
    const int qb = 63 - (u & 63), h = (u >> 6) & 15, b = u >> 10; const int lane = tid & 63, w = __builtin_amdgcn_readfirstlane(tid >> 6), c16 = lane & 15, g = lane >> 4;
    const bf16* bp = qkv + (size_t)b * SEQ * SBW + h * 64;
    LAS bf16* Qs = (LAS bf16*)(lds + OFF_Q); LAS bf16* Ks = (LAS bf16*)(lds + OFF_K); LAS bf16* Vs = (LAS bf16*)(lds + OFF_V); volatile LAS int* flags = (volatile LAS int*)(lds + OFF_FLAG);
    const int qi = 16 * w + c16;
    v4u onesw, tri0w, tri1w;
    {
        unsigned t0e[8], t1e[8];
#pragma unroll
        for (int j = 0; j < 8; ++j) { t0e[j] = j < 4 ? ((4 * g + j > c16) ? 0x3F80u : 0u) : 0x3F80u; t1e[j] = j < 4 ? 0u : ((4 * g + (j - 4) > c16) ? 0x3F80u : 0u); }
        onesw = (v4u){0x3F803F80u, 0x3F803F80u, 0x3F803F80u, 0x3F803F80u};
        tri0w = (v4u){t0e[0] | (t0e[1] << 16), t0e[2] | (t0e[3] << 16), t0e[4] | (t0e[5] << 16), t0e[6] | (t0e[7] << 16)};
        tri1w = (v4u){t1e[0] | (t1e[1] << 16), t1e[2] | (t1e[3] << 16), t1e[4] | (t1e[5] << 16), t1e[6] | (t1e[7] << 16)};
    }
    const bfx8 ones = __builtin_bit_cast(bfx8, onesw), tri0 = __builtin_bit_cast(bfx8, tri0w), tri1 = __builtin_bit_cast(bfx8, tri1w);
    f32x4 o[4];
#pragma unroll
    for (int dt = 0; dt < 4; ++dt) o[dt] = (f32x4){0.f, 0.f, 0.f, 0.f};
    float carry = 0.f;
    bfx8 qf[2];
    const int krow = tid >> 2, kc = tid & 3, vkp = tid & 63, vc = tid >> 6;
    v4u ka, kb2, va0, va1;
#define SB_LOAD(blk) do { const bf16* kp_ = bp + (size_t)((blk) * 128 + krow) * SBW + 1024; ka = *(const GAS v4u*)(kp_ + 8 * kc); kb2 = *(const GAS v4u*)(kp_ + 32 + 8 * kc); \
        const bf16* vp_ = bp + (size_t)((blk) * 128 + 2 * vkp) * SBW + 2048 + 8 * vc; va0 = *(const GAS v4u*)vp_; va1 = *(const GAS v4u*)(vp_ + SBW); } while (0)
    SB_LOAD(qb);
    { RR rq; ld_rows(rq, bp + (size_t)(qb * 128) * SBW, SBW, tid); st_rows(Qs, rq, tid); }
    for (int kb = qb; kb >= 0; --kb) {
        *(LAS v4u*)(Ks + krow * QP + 8 * kc) = ka; *(LAS v4u*)(Ks + krow * QP + 32 + 8 * kc) = kb2;
#pragma unroll
        for (int e = 0; e < 8; ++e) { const unsigned a_ = va0[e >> 1], b_ = va1[e >> 1]; *(LAS unsigned*)(Vs + (8 * vc + e) * 136 + 2 * vkp) = (e & 1) ? ((a_ >> 16) | (b_ & 0xffff0000u)) : ((a_ & 0xffffu) | (b_ << 16)); }
        __syncthreads();
        if (kb > 0) SB_LOAD(kb - 1);
        if (kb == qb) {
#pragma unroll
            for (int ks = 0; ks < 2; ++ks) qf[ks] = *(const LAS bfx8*)(Qs + (16 * w + c16) * QP + 32 * ks + 8 * g);
        }
        const bool diag = kb == qb;
        if (__any(carry >= -104.0f)) {
        f32x4 ls[8], lg[8];
        f32x4 zt[8]; st_tiles8(Ks, 0, qf, c16, g, zt);
#pragma unroll
        for (int T = 0; T < 8; ++T) { const f32x4 a = zt[T];
#pragma unroll
            for (int r = 0; r < 4; ++r) { const int kj = 16 * T + 4 * g + r; const bool ok = !diag || kj < qi; const float z = a[r] * 0.125f;
                const float sp = fmaxf(z, 0.f) + __log2f(1.0f + __builtin_amdgcn_exp2f(-fabsf(z) * LOG2E)) * LN2;
                ls[T][r] = ok ? -sp : 0.f; lg[T][r] = ok ? z - sp : -INFINITY; } }
        float tot[4]; f32x4 later[8];
#pragma unroll
        for (int s = 0; s < 4; ++s) {
            f32x4 hi0, hi1, lo0, lo1;
#pragma unroll
            for (int r = 0; r < 4; ++r) { hi0[r] = __uint_as_float(__float_as_uint(ls[2 * s][r]) & 0xffff0000u); lo0[r] = ls[2 * s][r] - hi0[r]; hi1[r] = __uint_as_float(__float_as_uint(ls[2 * s + 1][r]) & 0xffff0000u); lo1[r] = ls[2 * s + 1][r] - hi1[r]; }
            const bfx8 bh = pack8(hi0, hi1), bl = pack8(lo0, lo1);
            f32x4 t = (f32x4){0.f, 0.f, 0.f, 0.f}; t = MFMA16(ones, bh, t); t = MFMA16(ones, bl, t); tot[s] = t[0];
            f32x4 a0 = (f32x4){0.f, 0.f, 0.f, 0.f}, a1 = (f32x4){0.f, 0.f, 0.f, 0.f};
            a0 = MFMA16(tri0, bh, a0); a0 = MFMA16(tri0, bl, a0); a1 = MFMA16(tri1, bh, a1); a1 = MFMA16(tri1, bl, a1);
            later[2 * s] = a0; later[2 * s + 1] = a1;
        }
        float suf = carry;
#pragma unroll
        for (int s = 3; s >= 0; --s) {
            f32x4 p0, p1;
#pragma unroll
            for (int r = 0; r < 4; ++r) { p0[r] = __builtin_amdgcn_exp2f((lg[2 * s][r] + later[2 * s][r] + suf) * LOG2E); p1[r] = __builtin_amdgcn_exp2f((lg[2 * s + 1][r] + later[2 * s + 1][r] + suf) * LOG2E); }
            pv_pair(o, Vs, 136, 2 * s, 2 * s + 1, p0, p1, c16, g);
            suf += tot[s];
        }
        carry = suf;
        }
        const int alive = __any(carry >= -104.0f) ? 1 : 0;
        if (lane == 0) flags[w] = alive;
        __syncthreads();
        int any = 0;
#pragma unroll
        for (int i = 0; i < 8; ++i) any |= flags[i];
        if (!any) break;
    }
#undef SB_LOAD
    const size_t tok = (size_t)b * SEQ + qb * 128 + qi;
#pragma unroll
    for (int dt = 0; dt < 4; ++dt) { u32x2v wv; wv.x = pkbf(o[dt][0], o[dt][1]); wv.y = pkbf(o[dt][2], o[dt][3]); *(GAS u32x2v*)(cat + tok * D + h * 64 + 16 * dt + 4 * g) = wv; }
    __syncthreads();
}
}
__global__ void __launch_bounds__(NWAVES * 64, 2) mega(Args args) {
    extern __shared__ __attribute__((aligned(16))) unsigned char lds_raw[];
    LAS unsigned char* lds = (LAS unsigned char*)lds_raw;
    volatile LAS unsigned* MISC = (volatile LAS unsigned*)(lds + MISC_OFF);
    const int G = gridDim.x; const int bx = blockIdx.x;
    const int wave_s = __builtin_amdgcn_readfirstlane((int)threadIdx.x >> 6);
    for (int u = wave_s * 64 + MK_LANE(); u < (LDS_BYTES - LDSCTL_OFF) / 4; u += NWAVES * 64) ((LAS unsigned*)(lds + LDSCTL_OFF))[u] = 0u;
    __syncthreads();
    XcdBarrier bar = xcd_barrier_post((unsigned*)((gu32*)(args.ws + WS_CTL) + CW_BAR) + args.li * XCD_BAR_WORDS, MISC + 8, wave_s);

    for (int ph = args.ph_lo; ph < args.ph_hi; ++ph) {
        int tid = wave_s * 64 + MK_LANE(); asm volatile("" : "+v"(tid));
        unsigned char* ws = args.ws; asm volatile("" : "+s"(ws));
        const int lane = tid & 63, wave = __builtin_amdgcn_readfirstlane(tid >> 6);
        const int vcu = (G % 8 == 0) ? (bx % 8) * (G / 8) + bx / 8 : bx;
        const int gw = vcu * NWAVES + wave, NGW = G * NWAVES;
        bf16* Wb = (bf16*)(ws + WS_W); bf16* xbA = (bf16*)(ws + WS_XBA); bf16* xbB = (bf16*)(ws + WS_XBB); bf16* big = (bf16*)(ws + WS_BIG);
        float* SS = (float*)(ws + WS_SS); float* out = args.out;
        const int l = ph >= 11 ? 1 : 0, s = (ph >= 1 && ph <= 9) ? ph : (ph >= 11 && ph <= 19 ? ph - 10 : 0);
        if (l == 1 && (s == 5 || s == 6)) continue;
        if (ph == 0) {
            LAS float* scr = (LAS float*)(lds + RING_OFF + wave * 16384);
            float* rc = (float*)(ws + WS_TAB); float* rs = rc + SEQ * 32; float* dc = rs + SEQ * 32; float* ds = dc + SEQ * 8;
            for (int idx = gw * 64 + lane; idx < SEQ * 32; idx += NGW * 64) {
                { const int pos = idx / 32, i = idx % 32; const float inv = 1.0f / powf(10000.0f, (float)i / 32.0f); const float ang = (float)pos * inv; rc[idx] = cosf(ang); rs[idx] = sinf(ang); }
                if (idx < SEQ * 8) { const int pos = idx / 8, i = idx % 8; const float inv = 1.0f / powf(500000.0f, (float)i / 8.0f); const float ang = (float)pos * inv; dc[idx] = cosf(ang); ds[idx] = sinf(ang); }
            }
            for (int m0 = gw; m0 < M; m0 += 2 * NGW) {
                f32x4 v[2][4];
#pragma unroll
                for (int r = 0; r < 2; ++r) { const int m = m0 + r * NGW < M ? m0 + r * NGW : m0; const GAS f32x4* xr = (const GAS f32x4*)(args.in[0] + (size_t)m * D) + lane;
#pragma unroll
                    for (int j = 0; j < 4; ++j) v[r][j] = xr[64 * j]; }
#pragma unroll
                for (int r = 0; r < 2; ++r) { const int m = m0 + r * NGW; if (m < M) { float sq = 0.f;
#pragma unroll
                    for (int j = 0; j < 4; ++j) sq += (v[r][j].x * v[r][j].x + v[r][j].y * v[r][j].y) + (v[r][j].z * v[r][j].z + v[r][j].w * v[r][j].w);
                    sq = wave_sum(sq); if (lane == 0) SS[m] = sq;
                    GAS unsigned long long* o8 = (GAS unsigned long long*)(xbA + (size_t)m * D) + lane;
#pragma unroll
                    for (int j = 0; j < 4; ++j) o8[64 * j] = (unsigned long long)pk2(v[r][j].x, v[r][j].y) | ((unsigned long long)pk2(v[r][j].z, v[r][j].w) << 32); } }
            }
            convert_layer(args, 0, scr, gw, NGW, lane);
        } else if (ph == 10) {
            LAS float* scr = (LAS float*)(lds + RING_OFF + wave * 16384);
            convert_layer(args, 1, scr, gw, NGW, lane);
        } else if (ph == 20) {
            const float* ssf = (const float*)(ws + WS_SSP) + (size_t)5 * 16 * M; const float* g = args.in[13];
            for (int m0 = gw; m0 < M; m0 += 4 * NGW) {
                float part[4]; unsigned long long wv[4][4];
#pragma unroll
                for (int r = 0; r < 4; ++r) { const int m = m0 + r * NGW; part[r] = (lane < 16 && m < M) ? ((const GAS float*)ssf)[(size_t)lane * M + m] : 0.f;
                    const GAS unsigned long long* xi = (const GAS unsigned long long*)(xbA + (size_t)(m < M ? m : 0) * D) + lane;
#pragma unroll
                    for (int j = 0; j < 4; ++j) wv[r][j] = xi[64 * j]; }
#pragma unroll
                for (int r = 0; r < 4; ++r) { const int m = m0 + r * NGW; const float rs = rsqrtf(wave_sum(part[r]) * (1.0f / 1024.0f) + 1e-6f);
                    if (m < M) { GAS f32x4* xr = (GAS f32x4*)(out + (size_t)m * D) + lane; const GAS f32x4* gr = (const GAS f32x4*)g + lane;
#pragma unroll
                        for (int j = 0; j < 4; ++j) { const unsigned lo = (unsigned)wv[r][j], hi = (unsigned)(wv[r][j] >> 32);
                            f32x4 v = (f32x4){__uint_as_float(lo << 16), __uint_as_float(lo & 0xffff0000u), __uint_as_float(hi << 16), __uint_as_float(hi & 0xffff0000u)}; v = v * rs * gr[64 * j]; xr[64 * j] = v; } } }
            }
        } else if (s == 1 || s == 8) {
            pg8::Gemm g{s == 1 ? xbA : xbB, Wb + (s == 1 ? WO_F1IN : WO_F2IN), M, 2 * FF, D};
            pg8::StaticOrder S; S.init(M, 2 * FF, G, bx);
            const int kss = 3 * l + (s == 1 ? 0 : 2);
            pg8::EpiSwiGLU E{big, FF, kss == 0 ? (const float*)SS : (const float*)(ws + WS_SSP) + (size_t)(kss - 1) * 16 * M, kss == 0 ? 1 : 16};
            pg8::gemm_phase<pg8::EpiSwiGLU, pg8::StaticOrder, PG8_ALIGN, PG8_SP2>(lds + RING_OFF, g, S, E, wave_s);
        } else if (s == 3) {
            const int N = l == 0 ? HYB : SBW;
            pg8::Gemm g{xbB, Wb + WO_MIXIN, M, N, D};
            pg8::StaticOrder S; S.init(M, N, G, bx);
            pg8::EpiScaleBf16 E{big, N, (const float*)(ws + WS_SSP) + (size_t)(3 * l) * 16 * M, 16};
            pg8::gemm_phase<pg8::EpiScaleBf16, pg8::StaticOrder, PG8_ALIGN, PG8_SP2>(lds + RING_OFF, g, S, E, wave_s);
        } else if (s == 2 || s == 7 || s == 9) {
            const bf16* A = s == 7 ? xbA : big; const int K = s == 7 ? D : FF;
            const bf16* Bt = Wb + (s == 2 ? WO_F1OUT : s == 7 ? WO_MIXOUT : WO_F2OUT);
            const float* base32 = (l == 0 && s == 2) ? args.in[0] : nullptr; const bf16* baseb = s == 2 ? xbA : xbB;
            bf16* xbo = s == 9 ? xbA : xbB; float* ssn = (float*)(ws + WS_SSP) + (size_t)(3 * l + (s == 2 ? 0 : s == 7 ? 1 : 2)) * 16 * M;
            pg8::Gemm g{A, Bt, M, D, K};
            pg8::StaticOrder S; S.init(M, D, G, bx);
            pg8::EpiResid E{base32, baseb, xbo, ssn, s == 7 ? 1.0f : 0.5f};
            pg8::gemm_phase<pg8::EpiResid, pg8::StaticOrder, PG8_ALIGN, PG8_SP2>(lds + RING_OFF, g, S, E, wave_s);
        } else if (l == 0) {
            const float* rc = (const float*)(ws + WS_TAB); const float* rs = rc + SEQ * 32; const float* dc = rs + SEQ * 32; const float* ds = dc + SEQ * 8;
            float* kv = (float*)(ws + WS_KV); bf16* St = (bf16*)(ws + WS_ST); bf16* part = (bf16*)out;     float* lsep = (float*)(ws + WS_LSE);
            if (s == 4) { for (int u = bx; u < 1024; u += G) mix::ret_kv_unit(u, big, rc, rs, kv, lds, tid); }
            else if (s == 5) {
                for (int chain = bx * 512 + tid; chain < 65536; chain += G * 512) mix::ret_scan(chain, kv, St);
                for (int u = bx; u < 2048; u += G) mix::dil_unit(u, big, dc, ds, part, lsep, xbA, lds, tid);
            } else {
                for (int v = bx; v < 2048; v += G) { if (v < 1024) mix::ret_out_unit(v, big, rc, rs, St, args.in[9], xbA, lds, tid); else mix::dil_unit(v + 1024, big, dc, ds, part, lsep, xbA, lds, tid); }
            }
        } else {
            for (int u = bx; u < 2048; u += G) mix::sb_unit(u, big, xbA, lds, tid);
        }
        if (ph + 1 < args.ph_hi) { if (args.li != 0) cooperative_groups::this_grid().sync(); else xcd_barrier(bar); }
    }
}
extern "C" void kernel_launch(void* const* d_in, const int* in_sizes, int n_in, void* d_out, int out_size, void* d_ws, size_t ws_size, hipStream_t stream) {
    static int grid = 0;
    if (grid == 0) {
        int dev = 0, cus = 0, per_cu = 0;
        hipGetDevice(&dev); hipDeviceGetAttribute(&cus, hipDeviceAttributeMultiprocessorCount, dev);
        if (hipFuncSetAttribute((const void*)mega, hipFuncAttributeMaxDynamicSharedMemorySize, LDS_BYTES) != hipSuccess) { fprintf(stderr, "kernel_launch: hipFuncSetAttribute failed\n"); grid = -1; return; }
        if (hipOccupancyMaxActiveBlocksPerMultiprocessor(&per_cu, (const void*)mega, NWAVES * 64, LDS_BYTES) != hipSuccess || per_cu < 1) per_cu = 1;
        (void)hipGetLastError();
        grid = (cus > 0 ? cus : 256) * 1;
    }
    if (grid < 0) return;
    hipMemsetAsync((char*)d_ws + WS_CTL, 0, CTL_ZERO_BYTES, stream);
    Args a{};
    for (int i = 0; i < 14; ++i) a.in[i] = (const float*)d_in[i];
    a.out = (float*)d_out; a.ws = (unsigned char*)d_ws; a.ph_lo = 0; a.ph_hi = 21; a.li = 0; a.mask = 0;
    void* kargs[] = {&a};
    hipError_t e = hipLaunchCooperativeKernel((const void*)mega, dim3(grid), dim3(NWAVES * 64), kargs, LDS_BYTES, stream);
    if (e != hipSuccess) fprintf(stderr, "kernel_launch: cooperative launch failed: %s (grid %d)\n", hipGetErrorString(e), grid);
}
```

```cpp
#include <hip/hip_runtime.h>
#include <hip/hip_cooperative_groups.h>
#include <cstdio>
#include <cstdint>
__device__ __forceinline__ int mk_lane() { int z = 0; asm volatile("" : "+s"(z)); return (int)__builtin_amdgcn_mbcnt_hi(~0u, __builtin_amdgcn_mbcnt_lo(~0u, (unsigned)z)); }
#define MK_LANE() mk_lane()
namespace pg8 {
#define PG8_LAS __attribute__((address_space(3)))
typedef unsigned short bf16_t;
typedef short bf16x8 __attribute__((ext_vector_type(8)));
typedef float f32x4 __attribute__((ext_vector_type(4)));
typedef unsigned u32x4 __attribute__((ext_vector_type(4)));
constexpr int BM = 256, BK = 64, HALF = 128, HTB = HALF * BK * 2  , STAGE_BYTES = 8 * HTB, NXCD = 8, WGM = 8;

__host__ __device__ __forceinline__ int lds_byte(int r, int c) { const int st = (r >> 4) * 2 + (c >> 5), rr = r & 15, cc = c & 31, ob = rr * 64 + cc * 2; return st * 1024 + (ob ^ (((ob >> 9) & 1) << 5)); }
__host__ __device__ __forceinline__ void stage_rc(int b, int& R, int& C) { const int st = b / 1024, sb = b % 1024, swz = sb ^ (((sb >> 9) & 1) << 5); R = (st >> 1) * 16 + swz / 64; C = (st & 1) * 32 + (swz % 64) / 2; }
__host__ __device__ __forceinline__ int perm32(int rho) { const int n = rho >> 4, i = rho & 15; return 8 * (i >> 2) + 4 * n + (i & 3); }

struct Unit { int pm, pn; };
struct Gemm { const bf16_t* A; const bf16_t* Bt; int M, N, K; };

struct StaticOrder {
    int nM, nN, nwg, G, c;
    __host__ __device__ void init(int M, int N, int G_, int c_) { nM = M / BM; nN = N / BM; nwg = nM * nN; G = G_; c = c_; }
    __host__ __device__ bool next(int i, Unit& u) const {
        const long L = (long)i * G + c; if (L >= nwg) return false;
        int wgid = (int)L; { const int q = nwg / NXCD, r = nwg % NXCD, xcd = wgid % NXCD, off = wgid / NXCD; wgid = (xcd < r ? xcd * (q + 1) : r * (q + 1) + (xcd - r) * q) + off; }
        const int nig = WGM * nN, gid = wgid / nig, fm = gid * WGM, gsz = (nM - fm) < WGM ? (nM - fm) : WGM;
        u.pm = fm + ((wgid % nig) % gsz); u.pn = (wgid % nig) / gsz; return true;
    }
    __device__ __forceinline__ void a_ready(const Unit&) const {}
    __device__ __forceinline__ void done(const Unit&) const {}
};

__device__ __forceinline__ unsigned cvt_pk_bf16(float lo, float hi) { unsigned r; asm volatile("v_cvt_pk_bf16_f32 %0, %1, %2" : "=v"(r) : "v"(lo), "v"(hi)); return r; }
typedef float f32x2 __attribute__((ext_vector_type(2)));
__device__ __forceinline__ f32x2 gelu_pk(f32x2 v) {
    const f32x2 av = __builtin_elementwise_abs(v), d = av * 0.2316418882f + 1.0f;
    f32x2 t; t.x = __builtin_amdgcn_rcpf(d.x); t.y = __builtin_amdgcn_rcpf(d.y);
    f32x2 q = t * 0.5307027145f + (-0.7265760135f); q = q * t + 0.7107068705f; q = q * t + (-0.142248368f); q = q * t + 0.127414796f; q = q * t;
    const f32x2 s = (v * v) * (-0.72134752044f);
    f32x2 e; e.x = __builtin_amdgcn_exp2f(s.x); e.y = __builtin_amdgcn_exp2f(s.y);
    const f32x2 m = v * (q * e), r = v - m;
    f32x2 o; o.x = v.x < 0.f ? m.x : r.x; o.y = v.y < 0.f ? m.y : r.y; return o;
}

template <int ACT  > struct EpiBf16 {
    static constexpr bool PERM = true, AFTER_DRAIN = false; static_assert(ACT == 0 || ACT == 1, "EpiBf16: ACT is 0 (none) or 1 (gelu_pk)");
    bf16_t* O; int ldc; const float* bias; int split_cols; size_t split_stride; float scale0;
    __device__ __forceinline__ void operator()(const f32x4 (&acc)[2][2][4][2], const Unit& u, int wr, int wc, int fr, int fq) const {
        const int row0 = u.pm * BM + wr * 64 + fr; int colt = u.pn * BM; bf16_t* base = O;
        float sc = 1.f; if (split_cols) { const int t = colt / split_cols; base += (size_t)t * split_stride; colt -= t * split_cols; if (t == 0) sc = scale0; }
        const int col0 = colt + wc * 32 + 8 * fq, bcol0 = u.pn * BM + wc * 32 + 8 * fq;
        f32x4 bv[2][2];
#pragma unroll
        for (int bj = 0; bj < 2; ++bj)
#pragma unroll
            for (int n = 0; n < 2; ++n) bv[bj][n] = bias ? *(const f32x4*)(bias + bcol0 + bj * HALF + 4 * n) : (f32x4){0.f, 0.f, 0.f, 0.f};
#pragma unroll
        for (int ai = 0; ai < 2; ++ai)
#pragma unroll
            for (int m = 0; m < 4; ++m) { bf16_t* rowp = base + (size_t)(row0 + ai * HALF + m * 16) * ldc + col0;
#pragma unroll
                for (int bj = 0; bj < 2; ++bj) { f32x4 v0 = acc[ai][bj][m][0] + bv[bj][0], v1 = acc[ai][bj][m][1] + bv[bj][1];
                    if (ACT == 1) { f32x2 a = gelu_pk((f32x2){v0[0], v0[1]}), b = gelu_pk((f32x2){v0[2], v0[3]}), c = gelu_pk((f32x2){v1[0], v1[1]}), d = gelu_pk((f32x2){v1[2], v1[3]});
                        v0 = (f32x4){a.x, a.y, b.x, b.y}; v1 = (f32x4){c.x, c.y, d.x, d.y}; }
                    v0 = v0 * sc; v1 = v1 * sc; u32x4 w; w.x = cvt_pk_bf16(v0[0], v0[1]); w.y = cvt_pk_bf16(v0[2], v0[3]); w.z = cvt_pk_bf16(v1[0], v1[1]); w.w = cvt_pk_bf16(v1[2], v1[3]);
                    *(u32x4*)(rowp + bj * HALF) = w; } }
    }
};

struct PanelStats {
    unsigned* xbuf;
    unsigned* cnt;
    unsigned* tmo;
    int ntn; float eps;
    unsigned code;
    __device__ __forceinline__ bool run(const f32x4 (&v)[2][2][4][2], const Unit& u, int wr, int wc, int fr, int fq, PG8_LAS unsigned char* lds, int wid, int lane) const {
        typedef float f32x2v __attribute__((ext_vector_type(2)));
        PG8_LAS f32x2v* P = (PG8_LAS f32x2v*)lds;
        PG8_LAS f32x2v* S = (PG8_LAS f32x2v*)(lds + 8192);
        PG8_LAS unsigned* flag = (PG8_LAS unsigned*)(lds + 8192 + 2048);
#pragma unroll
        for (int ai = 0; ai < 2; ++ai)
#pragma unroll
            for (int m = 0; m < 4; ++m) {
                float s = 0.f;
#pragma unroll
                for (int bj = 0; bj < 2; ++bj)
#pragma unroll
                    for (int n = 0; n < 2; ++n) { const f32x4 x = v[ai][bj][m][n]; s += (x[0] + x[1]) + (x[2] + x[3]); }
                s += __shfl_xor(s, 16); s += __shfl_xor(s, 32);
                const float mw = s * (1.0f / 64.0f); float q = 0.f;
#pragma unroll
                for (int bj = 0; bj < 2; ++bj)
#pragma unroll
                    for (int n = 0; n < 2; ++n) { const f32x4 d = v[ai][bj][m][n] - mw; q += (d[0] * d[0] + d[1] * d[1]) + (d[2] * d[2] + d[3] * d[3]); }
                q += __shfl_xor(q, 16); q += __shfl_xor(q, 32);
                if (fq == 0) P[(ai * HALF + wr * 64 + m * 16 + fr) * 4 + wc] = (f32x2v){mw, q};
            }
        asm volatile("s_waitcnt lgkmcnt(0)" ::: "memory"); __builtin_amdgcn_s_barrier(); asm volatile("" ::: "memory");
#if defined(BROKEN_EXCHANGE_NO_WAIT)
#warning BROKEN CONTROL BUILD: the row-statistics exchange does not wait; results are wrong by design
        if (blockIdx.x >= 64) { const long long t0_ = clock64(); while (clock64() - t0_ < 60000) __builtin_amdgcn_s_sleep(8); }
#endif
        const int row = wid * 32 + (lane & 31);
        if (lane < 32) {
            const f32x2v a = P[row * 4 + 0], b = P[row * 4 + 1], c = P[row * 4 + 2], d = P[row * 4 + 3];
            const float mt = (a.x + b.x + c.x + d.x) * 0.25f;
            const float da = a.x - mt, db = b.x - mt, dc = c.x - mt, dd = d.x - mt;
            const float m2 = (a.y + b.y) + (c.y + d.y) + 64.0f * ((da * da + db * db) + (dc * dc + dd * dd));
            unsigned long long* slot = (unsigned long long*)xbuf + ((size_t)(u.pm * BM + row) * 4 + u.pn);
            __hip_atomic_store(slot, ((unsigned long long)__float_as_uint(m2) << 32) | __float_as_uint(mt), __ATOMIC_RELAXED, __HIP_MEMORY_SCOPE_AGENT);
        }
        asm volatile("s_waitcnt vmcnt(0)" ::: "memory");
        if (lane == 0) __hip_atomic_fetch_add(cnt + 64 * u.pm, 1u, __ATOMIC_RELAXED, __HIP_MEMORY_SCOPE_AGENT);
        if (wid == 0) {
            bool dead = false; const unsigned long long t0 = __builtin_amdgcn_s_memrealtime(); const unsigned want = 8u * (unsigned)ntn;
            for (;;) {
#if defined(BROKEN_EXCHANGE_NO_WAIT)
                break;
#endif
                if ((unsigned)__builtin_amdgcn_readfirstlane(__hip_atomic_load(cnt + 64 * u.pm, __ATOMIC_RELAXED, __HIP_MEMORY_SCOPE_AGENT)) >= want) break;
                if (__builtin_amdgcn_s_memrealtime() - t0 > 2000000ull) {
                    if (lane == 0) { unsigned expect = 0u; __hip_atomic_compare_exchange_strong(tmo + 1, &expect, code | (unsigned)(u.pm & 0xff), __ATOMIC_RELAXED, __ATOMIC_RELAXED, __HIP_MEMORY_SCOPE_AGENT);
                                     __hip_atomic_store(tmo, 1u, __ATOMIC_RELAXED, __HIP_MEMORY_SCOPE_AGENT); }
                    dead = true; break; }
                __builtin_amdgcn_s_sleep(2);
            }
            __builtin_amdgcn_fence(__ATOMIC_ACQUIRE, "agent");
            if (lane == 0) flag[0] = dead ? 1u : 0u;
        }
        asm volatile("s_waitcnt vmcnt(0) lgkmcnt(0)" ::: "memory"); __builtin_amdgcn_s_barrier(); asm volatile("" ::: "memory");
        const bool bad = flag[0] != 0u;
        if (lane < 32) {
            const unsigned long long* slot = (const unsigned long long*)xbuf + (size_t)(u.pm * BM + row) * 4; float mt[4], m2[4]; float ms = 0.f;
#pragma unroll
            for (int t = 0; t < 4; ++t) { if (t < ntn) { const unsigned long long w = __hip_atomic_load(slot + t, __ATOMIC_RELAXED, __HIP_MEMORY_SCOPE_AGENT); mt[t] = __uint_as_float((unsigned)w); m2[t] = __uint_as_float((unsigned)(w >> 32)); } else { mt[t] = 0.f; m2[t] = 0.f; } ms += mt[t]; }
            const float mean = ms / (float)ntn; float q = 0.f;
#pragma unroll
            for (int t = 0; t < 4; ++t) if (t < ntn) { const float dm = mt[t] - mean; q += m2[t] + 256.0f * dm * dm; }
            S[row] = (f32x2v){mean, 1.0f / sqrtf(q / (256.0f * (float)ntn) + eps)};
        }
        asm volatile("s_waitcnt lgkmcnt(0)" ::: "memory"); __builtin_amdgcn_s_barrier(); asm volatile("" ::: "memory");
        return bad;
    }
};
struct EpiLnRes {
    static constexpr bool PERM = false, AFTER_DRAIN = true;
    const float* base; float* out; int ldc; const float* bias; PanelStats st; unsigned poison;
    __device__ __forceinline__ void fused(f32x4 (&acc)[2][2][4][2], const Unit& u, int wr, int wc, int fr, int fq, PG8_LAS unsigned char* lds, int wid, int lane) const {
        typedef float f32x2v __attribute__((ext_vector_type(2)));
        const PG8_LAS f32x2v* S = (const PG8_LAS f32x2v*)(lds + 8192);
        const int col0 = u.pn * BM + wc * 32 + 4 * fq;
#pragma unroll
        for (int bj = 0; bj < 2; ++bj)
#pragma unroll
            for (int n = 0; n < 2; ++n) { const f32x4 bv = bias ? *(const f32x4*)(bias + col0 + bj * HALF + n * 16) : (f32x4){0.f, 0.f, 0.f, 0.f};
#pragma unroll
                for (int ai = 0; ai < 2; ++ai)
#pragma unroll
                    for (int m = 0; m < 4; ++m) acc[ai][bj][m][n] += bv; }
        f32x4 pre[4][2][2];
#pragma unroll
        for (int m = 0; m < 4; ++m) { const size_t off = (size_t)(u.pm * BM + wr * 64 + m * 16 + fr) * ldc + col0;
#pragma unroll
            for (int bj = 0; bj < 2; ++bj)
#pragma unroll
                for (int n = 0; n < 2; ++n) pre[m][bj][n] = *(const f32x4*)(base + off + bj * HALF + n * 16); }
        const bool bad = st.run(acc, u, wr, wc, fr, fq, lds, wid, lane) || poison != 0u;
        const float qnan = __builtin_nanf("");
#pragma unroll
        for (int ai = 0; ai < 2; ++ai)
#pragma unroll
            for (int m = 0; m < 4; ++m) { const int r = ai * HALF + wr * 64 + m * 16 + fr; const f32x2v sr = S[r]; const size_t off = (size_t)(u.pm * BM + r) * ldc + col0;
#pragma unroll
                for (int bj = 0; bj < 2; ++bj)
#pragma unroll
                    for (int n = 0; n < 2; ++n) { const f32x4 bs = ai == 0 ? pre[m][bj][n] : *(const f32x4*)(base + off + bj * HALF + n * 16); f32x4 o = bs + (acc[ai][bj][m][n] - sr.x) * sr.y;
                        if (bad) o = (f32x4){qnan, qnan, qnan, qnan}; *(f32x4*)(out + off + bj * HALF + n * 16) = o; }
                if (m & 1) asm volatile("" ::: "memory"); }
    }
};
struct EpiLnResLn {
    static constexpr bool PERM = false, AFTER_DRAIN = true;
    const float* base; float* out; bf16_t* xn; int ldc; const float* bias; PanelStats st1, st2; unsigned poison;
    __device__ __forceinline__ void fused(f32x4 (&acc)[2][2][4][2], const Unit& u, int wr, int wc, int fr, int fq, PG8_LAS unsigned char* lds, int wid, int lane) const {
        typedef float f32x2v __attribute__((ext_vector_type(2))); typedef unsigned u32x2v __attribute__((ext_vector_type(2)));
        const PG8_LAS f32x2v* S = (const PG8_LAS f32x2v*)(lds + 8192);
        const int col0 = u.pn * BM + wc * 32 + 4 * fq;
#pragma unroll
        for (int bj = 0; bj < 2; ++bj)
#pragma unroll
            for (int n = 0; n < 2; ++n) { const f32x4 bv = bias ? *(const f32x4*)(bias + col0 + bj * HALF + n * 16) : (f32x4){0.f, 0.f, 0.f, 0.f};
#pragma unroll
                for (int ai = 0; ai < 2; ++ai)
#pragma unroll
                    for (int m = 0; m < 4; ++m) acc[ai][bj][m][n] += bv; }
        bool bad = st1.run(acc, u, wr, wc, fr, fq, lds, wid, lane) || poison != 0u;
        const float qnan = __builtin_nanf("");
#pragma unroll
        for (int ai = 0; ai < 2; ++ai)
#pragma unroll
            for (int m = 0; m < 4; ++m) { const int r = ai * HALF + wr * 64 + m * 16 + fr; const f32x2v sr = S[r]; const size_t off = (size_t)(u.pm * BM + r) * ldc + col0;
#pragma unroll
                for (int bj = 0; bj < 2; ++bj)
#pragma unroll
                    for (int n = 0; n < 2; ++n) { const f32x4 bs = *(const f32x4*)(base + off + bj * HALF + n * 16); acc[ai][bj][m][n] = bs + (acc[ai][bj][m][n] - sr.x) * sr.y; }
                asm volatile("" : "+v"(acc[ai][0][m][0]), "+v"(acc[ai][0][m][1]), "+v"(acc[ai][1][m][0]), "+v"(acc[ai][1][m][1]));
                if (m & 1) asm volatile("" ::: "memory"); }
        const bool bad1 = bad;
        bad = st2.run(acc, u, wr, wc, fr, fq, lds, wid, lane) || bad;
#pragma unroll
        for (int ai = 0; ai < 2; ++ai)
#pragma unroll
            for (int m = 0; m < 4; ++m) { const int r = ai * HALF + wr * 64 + m * 16 + fr; const f32x2v sr = S[r]; const size_t off = (size_t)(u.pm * BM + r) * ldc + col0;
#pragma unroll
                for (int bj = 0; bj < 2; ++bj)
#pragma unroll
                    for (int n = 0; n < 2; ++n) { const f32x4 x1 = acc[ai][bj][m][n]; *(f32x4*)(out + off + bj * HALF + n * 16) = bad1 ? (f32x4){qnan, qnan, qnan, qnan} : x1;
                        const f32x4 o = (x1 - sr.x) * sr.y; u32x2v w; w.x = cvt_pk_bf16(o[0], o[1]); w.y = cvt_pk_bf16(o[2], o[3]);
                        if (bad) { w.x = 0x7fc07fc0u; w.y = 0x7fc07fc0u; } *(u32x2v*)(xn + off + bj * HALF + n * 16) = w; }
                asm volatile("" ::: "memory"); }
    }
};

template <class Epi, class Sched, bool ALIGN_EPI = false, bool SP2 = false>
__device__ __forceinline__ void gemm_phase(PG8_LAS unsigned char* lds, const Gemm g, const Sched& S, const Epi& E, const int wave_s  ) {
    int tid_ = wave_s * 64 + MK_LANE(); asm volatile("" : "+v"(tid_));
    const int tid = tid_, wid = __builtin_amdgcn_readfirstlane(tid >> 6), lane = tid & 63, wr = wid >> 2, wc = wid & 3, fr = lane & 15, fq = lane >> 4;
    const int K = g.K, nt = K / BK;
    unsigned voffA[2], voffB[2];
#pragma unroll
    for (int i = 0; i < 2; ++i) { int R, C; stage_rc(tid * 16 + i * 8192, R, C); const int Rb = Epi::PERM ? ((R & ~31) + perm32(R & 31)) : R;
        voffA[i] = (unsigned)(R * K + C) * 2u; voffB[i] = (unsigned)(Rb * K + C) * 2u; }
    const size_t kstep = (size_t)(BK * 2);
    const size_t hstep = (size_t)HALF * K * 2;
    const size_t tstep = 2 * hstep;
    const unsigned ldsw = (unsigned)wid * 1024u;
    const int aoff = lds_byte(wr * 64 + fr, fq * 8), boff = lds_byte(wc * 32 + fr, fq * 8);
#define PG8_SA(b, h) (((b) * 2 + (h)) * HTB)
#define PG8_SB(b, h) ((4 + (b) * 2 + (h)) * HTB)
#define PG8_STAGE(bufoff, gbase, voff) do { _Pragma("unroll") for (int _i = 0; _i < 2; ++_i) \
        __builtin_amdgcn_global_load_lds((const unsigned*)((const char*)(gbase) + (voff)[_i]), (PG8_LAS unsigned*)(lds + (bufoff) + ldsw + _i * 8192), 16, 0, 0); } while (0)
#define PG8_LDA(dst, b, h) do { _Pragma("unroll") for (int m = 0; m < 4; ++m) _Pragma("unroll") for (int k = 0; k < 2; ++k) dst[m][k] = *(const PG8_LAS bf16x8*)(lds + PG8_SA(b, h) + aoff + m * 2048 + k * 1024); } while (0)
#define PG8_LDB(dst, b, h) do { _Pragma("unroll") for (int n = 0; n < 2; ++n) _Pragma("unroll") for (int k = 0; k < 2; ++k) dst[n][k] = *(const PG8_LAS bf16x8*)(lds + PG8_SB(b, h) + boff + n * 2048 + k * 1024); } while (0)
#define PG8_MMA(ai, bj, At, Bt) do { __builtin_amdgcn_s_setprio(1); _Pragma("unroll") for (int m = 0; m < 4; ++m) _Pragma("unroll") for (int n = 0; n < 2; ++n) _Pragma("unroll") for (int k = 0; k < 2; ++k) \
        acc[ai][bj][m][n] = __builtin_amdgcn_mfma_f32_16x16x32_bf16(Bt[n][k], At[m][k], acc[ai][bj][m][n], 0, 0, 0); __builtin_amdgcn_s_setprio(0); } while (0)
#define PG8_WAIT_V(n) asm volatile("s_waitcnt vmcnt(" #n ")" ::: "memory")
#define PG8_WAIT_L(n) asm volatile("s_waitcnt lgkmcnt(" #n ")" ::: "memory")
#define PG8_BAR __builtin_amdgcn_s_barrier()
#define PG8_SCHED __builtin_amdgcn_sched_barrier(0)
    Unit cur, nxt; int ui = 0;
    if (!S.next(0, cur)) return;
    f32x4 acc[2][2][4][2];
#pragma unroll
    for (int a = 0; a < 2; ++a)
#pragma unroll
        for (int b = 0; b < 2; ++b)
#pragma unroll
            for (int m = 0; m < 4; ++m)
#pragma unroll
                for (int n = 0; n < 2; ++n) acc[a][b][m][n] = (f32x4){0.f, 0.f, 0.f, 0.f};
    bf16x8 At[4][2], B0[2][2], B1[2][2];
    const char* cA = (const char*)g.A + (size_t)cur.pm * tstep; const char* cB = (const char*)g.Bt + (size_t)cur.pn * tstep;
    S.a_ready(cur);
    if constexpr (SP2) {
        PG8_STAGE(PG8_SB(0, 0), cB, voffB); PG8_STAGE(PG8_SB(0, 1), cB + hstep, voffB); PG8_STAGE(PG8_SA(0, 0), cA, voffA); PG8_STAGE(PG8_SA(0, 1), cA + hstep, voffA);
        if (wr == 1) PG8_BAR;
        PG8_WAIT_V(2); PG8_BAR;
        PG8_STAGE(PG8_SB(1, 0), cB + kstep, voffB); PG8_STAGE(PG8_SA(1, 0), cA + kstep, voffA); PG8_STAGE(PG8_SB(1, 1), cB + hstep + kstep, voffB);
        PG8_WAIT_V(6); PG8_BAR;
    } else {
        PG8_STAGE(PG8_SB(0, 0), cB, voffB); PG8_STAGE(PG8_SA(0, 0), cA, voffA); PG8_STAGE(PG8_SB(0, 1), cB + hstep, voffB); PG8_STAGE(PG8_SA(0, 1), cA + hstep, voffA);
        if (wr == 1) PG8_BAR;
        PG8_WAIT_V(4); PG8_BAR;
        PG8_STAGE(PG8_SB(1, 0), cB + kstep, voffB); PG8_STAGE(PG8_SA(1, 0), cA + kstep, voffA); PG8_STAGE(PG8_SB(1, 1), cB + hstep + kstep, voffB);
        PG8_WAIT_V(6); PG8_BAR;
    }
    for (;;) {
        const bool has_next = S.next(ui + 1, nxt);
        const char* nA = has_next ? (const char*)g.A + (size_t)nxt.pm * tstep : cA; const char* nB = has_next ? (const char*)g.Bt + (size_t)nxt.pn * tstep : cB;
        for (int t = 0; t < nt; t += 2) {
            const bool last = (t == nt - 2);
            const char* a1 = cA + (size_t)(t + 1) * kstep;
            const char* a2 = last ? nA : cA + (size_t)(t + 2) * kstep; const char* b2 = last ? nB : cB + (size_t)(t + 2) * kstep;
            const char* a3 = a2 + kstep; const char* b3 = b2 + kstep;
            if (last && has_next) S.a_ready(nxt);
            if constexpr (SP2) {
            PG8_LDB(B0, 0, 0); PG8_LDB(B1, 0, 1); PG8_SCHED; PG8_LDA(At, 0, 0); PG8_STAGE(PG8_SA(1, 1), a1 + hstep, voffA);
            PG8_WAIT_V(8); PG8_WAIT_L(0); PG8_BAR; PG8_MMA(0, 0, At, B0); PG8_MMA(0, 1, At, B1); PG8_BAR; PG8_SCHED;
            PG8_LDA(At, 0, 1); PG8_STAGE(PG8_SB(0, 0), b2, voffB); PG8_STAGE(PG8_SB(0, 1), b2 + hstep, voffB); PG8_STAGE(PG8_SA(0, 0), a2, voffA);
            PG8_WAIT_V(8); PG8_WAIT_L(0); PG8_BAR; PG8_MMA(1, 0, At, B0); PG8_MMA(1, 1, At, B1); PG8_BAR; PG8_SCHED;
            PG8_LDB(B0, 1, 0); PG8_LDB(B1, 1, 1); PG8_SCHED; PG8_LDA(At, 1, 0); PG8_STAGE(PG8_SA(0, 1), a2 + hstep, voffA);
            PG8_WAIT_V(8); PG8_WAIT_L(0); PG8_BAR; PG8_MMA(0, 0, At, B0); PG8_MMA(0, 1, At, B1); PG8_BAR; PG8_SCHED;
            PG8_LDA(At, 1, 1); PG8_STAGE(PG8_SB(1, 0), b3, voffB); PG8_STAGE(PG8_SB(1, 1), b3 + hstep, voffB); PG8_STAGE(PG8_SA(1, 0), a3, voffA);
            PG8_WAIT_V(8); PG8_WAIT_L(0); PG8_BAR; PG8_MMA(1, 0, At, B0); PG8_MMA(1, 1, At, B1); PG8_BAR; PG8_SCHED;
            } else {
            PG8_LDB(B0, 0, 0); PG8_SCHED; PG8_LDA(At, 0, 0); PG8_STAGE(PG8_SA(1, 1), a1 + hstep, voffA);
            PG8_WAIT_L(8); PG8_BAR; PG8_WAIT_L(0); PG8_MMA(0, 0, At, B0); PG8_BAR; PG8_SCHED;
            PG8_LDB(B1, 0, 1); PG8_STAGE(PG8_SB(0, 0), b2, voffB);
            PG8_BAR; PG8_WAIT_L(0); PG8_MMA(0, 1, At, B1); PG8_BAR;
            PG8_LDA(At, 0, 1); PG8_STAGE(PG8_SA(0, 0), a2, voffA);
            PG8_BAR; PG8_WAIT_L(0); PG8_MMA(1, 0, At, B0); PG8_BAR; PG8_SCHED;
            PG8_STAGE(PG8_SB(0, 1), b2 + hstep, voffB);
            PG8_WAIT_V(6); PG8_BAR; PG8_MMA(1, 1, At, B1); PG8_BAR;
            PG8_LDB(B0, 1, 0); PG8_SCHED; PG8_LDA(At, 1, 0); PG8_STAGE(PG8_SA(0, 1), a2 + hstep, voffA);
            PG8_WAIT_L(8); PG8_BAR; PG8_WAIT_L(0); PG8_MMA(0, 0, At, B0); PG8_BAR; PG8_SCHED;
            PG8_LDB(B1, 1, 1); PG8_STAGE(PG8_SB(1, 0), b3, voffB);
            PG8_BAR; PG8_WAIT_L(0); PG8_MMA(0, 1, At, B1); PG8_BAR;
            PG8_LDA(At, 1, 1); PG8_STAGE(PG8_SA(1, 0), a3, voffA);
            PG8_BAR; PG8_WAIT_L(0); PG8_MMA(1, 0, At, B0); PG8_BAR; PG8_SCHED;
            PG8_STAGE(PG8_SB(1, 1), b3 + hstep, voffB);
            PG8_WAIT_V(6); PG8_BAR; PG8_MMA(1, 1, At, B1); PG8_BAR;
            }
        }
        if constexpr (ALIGN_EPI) { if (wr == 0) PG8_BAR; }
        if constexpr (!Epi::AFTER_DRAIN) { E(acc, cur, wr, wc, fr, fq); S.done(cur); }
        if (!has_next) break;
#pragma unroll
        for (int a = 0; a < 2; ++a)
#pragma unroll
            for (int b = 0; b < 2; ++b)
#pragma unroll
                for (int m = 0; m < 4; ++m)
#pragma unroll
                    for (int n = 0; n < 2; ++n) acc[a][b][m][n] = (f32x4){0.f, 0.f, 0.f, 0.f};
        cur = nxt; cA = nA; cB = nB; ++ui;
        if constexpr (ALIGN_EPI) { if (wr == 1) PG8_BAR; }
    }
    PG8_WAIT_V(0);
    if constexpr (!ALIGN_EPI) { if (wr == 0) PG8_BAR; }
    PG8_BAR;
    if constexpr (Epi::AFTER_DRAIN) { E.fused(acc, cur, wr, wc, fr, fq, lds, wid, lane); S.done(cur); }
#undef PG8_SA
#undef PG8_SB
#undef PG8_STAGE
#undef PG8_LDA
#undef PG8_LDB
#undef PG8_MMA
#undef PG8_WAIT_V
#undef PG8_WAIT_L
#undef PG8_BAR
#undef PG8_SCHED
}
}

#ifndef PG8_SP2
#define PG8_SP2 true
#endif
#ifndef PG8_ALIGN
#define PG8_ALIGN true
#endif
namespace pg8 {
typedef unsigned u32x2 __attribute__((ext_vector_type(2)));
#define PG8_GAS __attribute__((address_space(1)))
constexpr float RMS_EPS = 1e-6f;
constexpr int SS_ROWS = 16384;
__device__ __forceinline__ void row_rs8(float (&rs)[8], const float* ssp, int npart, int row0, int fq) {
    const PG8_GAS float* sp = (const PG8_GAS float*)ssp; float pr[8][4];
#pragma unroll
    for (int r = 0; r < 8; ++r)
#pragma unroll
        for (int i = 0; i < 4; ++i) { const int j = fq * 4 + i; pr[r][i] = sp[(size_t)(j < npart ? j : 0) * SS_ROWS + row0 + (r >> 2) * HALF + (r & 3) * 16]; }
#pragma unroll
    for (int r = 0; r < 8; ++r) { float s = 0.f;
#pragma unroll
        for (int i = 0; i < 4; ++i) s += (fq * 4 + i < npart) ? pr[r][i] : 0.f;
        s += __shfl_xor(s, 16); s += __shfl_xor(s, 32);
        rs[r] = rsqrtf(s * (1.0f / 1024.0f) + RMS_EPS); }
}
struct EpiSwiGLU {
    static constexpr bool PERM = true, AFTER_DRAIN = false;
    bf16_t* O; int ldc; const float* ss; int npart;
    __device__ __forceinline__ void operator()(const f32x4 (&acc)[2][2][4][2], const Unit& u, int wr, int wc, int fr, int fq) const {
        const int row0 = u.pm * BM + wr * 64 + fr, col0 = u.pn * HALF + wc * 32 + 8 * fq;
        float rsv[8]; row_rs8(rsv, ss, npart, row0, fq);
#pragma unroll
        for (int ai = 0; ai < 2; ++ai)
#pragma unroll
            for (int m = 0; m < 4; ++m) {
                const int row = row0 + ai * HALF + m * 16; const float rs = rsv[ai * 4 + m];
                float h[8];
#pragma unroll
                for (int n = 0; n < 2; ++n)
#pragma unroll
                    for (int i = 0; i < 4; ++i) { const float g = acc[ai][0][m][n][i] * rs, up = acc[ai][1][m][n][i] * rs; h[n * 4 + i] = g * __builtin_amdgcn_rcpf(1.0f + __expf(-g)) * up; }
                u32x4 w; w.x = cvt_pk_bf16(h[0], h[1]); w.y = cvt_pk_bf16(h[2], h[3]); w.z = cvt_pk_bf16(h[4], h[5]); w.w = cvt_pk_bf16(h[6], h[7]);
                *(PG8_GAS u32x4*)(O + (size_t)row * ldc + col0) = w;
            }
    }
};
struct EpiScaleBf16 {
    static constexpr bool PERM = true, AFTER_DRAIN = false;
    bf16_t* O; int ldc; const float* ss; int npart;
    __device__ __forceinline__ void operator()(const f32x4 (&acc)[2][2][4][2], const Unit& u, int wr, int wc, int fr, int fq) const {
        const int row0 = u.pm * BM + wr * 64 + fr, col0 = u.pn * BM + wc * 32 + 8 * fq;
        float rsv[8]; row_rs8(rsv, ss, npart, row0, fq);
#pragma unroll
        for (int ai = 0; ai < 2; ++ai)
#pragma unroll
            for (int m = 0; m < 4; ++m) {
                const int row = row0 + ai * HALF + m * 16; const float rs = rsv[ai * 4 + m];
#pragma unroll
                for (int bj = 0; bj < 2; ++bj) { const f32x4 v0 = acc[ai][bj][m][0] * rs, v1 = acc[ai][bj][m][1] * rs;
                    u32x4 w; w.x = cvt_pk_bf16(v0[0], v0[1]); w.y = cvt_pk_bf16(v0[2], v0[3]); w.z = cvt_pk_bf16(v1[0], v1[1]); w.w = cvt_pk_bf16(v1[2], v1[3]);
                    *(PG8_GAS u32x4*)(O + (size_t)row * ldc + col0 + bj * HALF) = w; }
            }
    }
};
struct EpiResid {
    static constexpr bool PERM = false, AFTER_DRAIN = false;
    const float* base32; const bf16_t* baseb; bf16_t* xb; float* ssn; float scale;
    __device__ __forceinline__ void operator()(const f32x4 (&acc)[2][2][4][2], const Unit& u, int wr, int wc, int fr, int fq) const {
        const int col0 = u.pn * BM + wc * 32 + 4 * fq;
#pragma unroll
        for (int ai = 0; ai < 2; ++ai) {
            f32x4 b[4][2][2];
            if (base32) {
#pragma unroll
                for (int m = 0; m < 4; ++m) { const size_t off = (size_t)(u.pm * BM + ai * HALF + wr * 64 + m * 16 + fr) * 1024 + col0;
#pragma unroll
                    for (int bj = 0; bj < 2; ++bj)
#pragma unroll
                        for (int n = 0; n < 2; ++n) b[m][bj][n] = *(const PG8_GAS f32x4*)(base32 + off + bj * HALF + n * 16); }
            } else {
                u32x2 w[4][2][2];
#pragma unroll
                for (int m = 0; m < 4; ++m) { const size_t off = (size_t)(u.pm * BM + ai * HALF + wr * 64 + m * 16 + fr) * 1024 + col0;
#pragma unroll
                    for (int bj = 0; bj < 2; ++bj)
#pragma unroll
                        for (int n = 0; n < 2; ++n) w[m][bj][n] = *(const PG8_GAS u32x2*)(baseb + off + bj * HALF + n * 16); }
#pragma unroll
                for (int m = 0; m < 4; ++m)
#pragma unroll
                    for (int bj = 0; bj < 2; ++bj)
#pragma unroll
                        for (int n = 0; n < 2; ++n) { const u32x2 x = w[m][bj][n]; b[m][bj][n] = (f32x4){__uint_as_float(x.x << 16), __uint_as_float(x.x & 0xffff0000u), __uint_as_float(x.y << 16), __uint_as_float(x.y & 0xffff0000u)}; }
            }
#pragma unroll
            for (int m = 0; m < 4; ++m) {
                const int row = u.pm * BM + ai * HALF + wr * 64 + m * 16 + fr; const size_t off = (size_t)row * 1024 + col0; float s = 0.f;
#pragma unroll
                for (int bj = 0; bj < 2; ++bj)
#pragma unroll
                    for (int n = 0; n < 2; ++n) { const f32x4 v = b[m][bj][n] + acc[ai][bj][m][n] * scale; s += (v[0] * v[0] + v[1] * v[1]) + (v[2] * v[2] + v[3] * v[3]);
                        u32x2 w2; w2.x = cvt_pk_bf16(v[0], v[1]); w2.y = cvt_pk_bf16(v[2], v[3]); *(PG8_GAS u32x2*)(xb + off + bj * HALF + n * 16) = w2; }
                s += __shfl_xor(s, 16); s += __shfl_xor(s, 32);
                if (fq == 0) ((PG8_GAS float*)ssn)[(size_t)(u.pn * 4 + wc) * SS_ROWS + row] = s;
            }
        }
    }
};
}
#define GAS __attribute__((address_space(1)))
#define LAS __attribute__((address_space(3)))
typedef unsigned short bf16;
typedef unsigned v4u __attribute__((ext_vector_type(4)));
typedef float f32x4 __attribute__((ext_vector_type(4)));
typedef short bf16x8 __attribute__((ext_vector_type(8)));
typedef GAS unsigned gu32;
typedef GAS unsigned long long gu64;
#define RLX_AGENT __ATOMIC_RELAXED, __HIP_MEMORY_SCOPE_AGENT
#define LDS_WAIT() asm volatile("s_waitcnt lgkmcnt(0)" ::: "memory")
#define VM_WAIT() asm volatile("s_waitcnt vmcnt(0)" ::: "memory")
__device__ __forceinline__ unsigned long long rt() { return __builtin_amdgcn_s_memrealtime(); }
__device__ __forceinline__ unsigned f2bf(float f) { unsigned u = __builtin_bit_cast(unsigned, f); return (u + 0x7fffu + ((u >> 16) & 1u)) >> 16; }
__device__ __forceinline__ unsigned pk2(float lo, float hi) { return f2bf(lo) | (f2bf(hi) << 16); }

#define XB_TMO      128
#define XB_XCNT(j)  (256  + 64 * (j))
#define XB_XSUB(j)  (1280 + 64 * (j))
#define XB_XGEN(j)  (2304 + 64 * (j))
#define XB_TOP      3328
#define XB_TOPGEN   3392
#define XCD_BAR_WORDS 3456
#define XB_SPIN_CAP (1u << 18)

__device__ __forceinline__ unsigned xb_ld(unsigned* p)              { return __hip_atomic_load(p, __ATOMIC_RELAXED, __HIP_MEMORY_SCOPE_AGENT); }
__device__ __forceinline__ unsigned xb_add(unsigned* p, unsigned v) { return __hip_atomic_fetch_add(p, v, __ATOMIC_RELAXED, __HIP_MEMORY_SCOPE_AGENT); }
__device__ __forceinline__ unsigned xb_xcc_id() { return (unsigned)__builtin_amdgcn_s_getreg((3 << 11) | 20) & 0xFu; }
#define XB_SPIN(cond, bar) do { unsigned _sp = 0; while (cond) { __builtin_amdgcn_s_sleep(1); \
    if ((++_sp & 255u) == 0u) { if (xb_ld(&(bar)[XB_TMO])) break; if (_sp > XB_SPIN_CAP) { atomicAdd(&(bar)[XB_TMO], 1u); break; } } } } while (0)

struct XcdBarrier {
    unsigned* bar; unsigned x; bool w0;
    volatile LAS unsigned* st;
};

__device__ __forceinline__ XcdBarrier xcd_barrier_post(unsigned* bar, volatile LAS unsigned* st, int wave_s) {
    XcdBarrier b; b.bar = bar; b.x = xb_xcc_id(); b.st = st; b.w0 = wave_s == 0;
    if (wave_s == 0 && MK_LANE() == 0) (void)xb_add(&bar[XB_XCNT(b.x)], 1u);
    return b;
}
__device__ __forceinline__ void xcd_barrier_complete(unsigned* bar, unsigned x, unsigned& nloc, unsigned& nx) {
    const unsigned G = gridDim.x * gridDim.y * gridDim.z;
    unsigned sum, cnt, mine, sp = 0u;
    for (;;) {
        sum = 0u; cnt = 0u; mine = 0u;
#pragma unroll
        for (unsigned j = 0; j < 16; ++j) { const unsigned c = xb_ld(&bar[XB_XCNT(j)]); sum += c; cnt += (c > 0u) ? 1u : 0u; mine = (j == x) ? c : mine; }
        if (sum == G) break;
        __builtin_amdgcn_s_sleep(1);
        if ((++sp & 255u) == 0u) { if (xb_ld(&bar[XB_TMO])) break; if (sp > XB_SPIN_CAP) { atomicAdd(&bar[XB_TMO], 1u); break; } }
    }
    nloc = mine > 0u ? mine : 1u; nx = cnt > 0u ? cnt : 1u;
}

__device__ __forceinline__ void xcd_barrier(const XcdBarrier& b) {
    asm volatile("s_waitcnt vmcnt(0)" ::: "memory");
    __syncthreads();
    if (b.w0 && MK_LANE() == 0) {
        unsigned* bar = b.bar;
        __builtin_amdgcn_s_waitcnt(0);
        unsigned nloc = b.st[0], nx = b.st[1];
        if (nloc == 0u) { xcd_barrier_complete(bar, b.x, nloc, nx); b.st[0] = nloc; b.st[1] = nx; }
        const unsigned old = xb_add(&bar[XB_XSUB(b.x)], 1u);
        const unsigned gen = old / nloc;
        if (old + 1u == (gen + 1u) * nloc) {
            __builtin_amdgcn_fence(__ATOMIC_RELEASE, "agent");
            asm volatile("s_waitcnt vmcnt(0)" ::: "memory");
            const unsigned og = xb_add(&bar[XB_TOP], 1u);
            const unsigned tg = og / nx;
            if (og + 1u == (tg + 1u) * nx) xb_add(&bar[XB_TOPGEN], 1u);
            else XB_SPIN(xb_ld(&bar[XB_TOPGEN]) == tg, bar);
            __builtin_amdgcn_fence(__ATOMIC_ACQUIRE, "agent");
            xb_add(&bar[XB_XGEN(b.x)], 1u);
            asm volatile("s_waitcnt vmcnt(0)" ::: "memory");
        } else {
            XB_SPIN(xb_ld(&bar[XB_XGEN(b.x)]) == gen, bar);
            __builtin_amdgcn_fence(__ATOMIC_ACQUIRE, "agent");
            asm volatile("s_waitcnt vmcnt(0)" ::: "memory");
        }
    }
    __syncthreads();
}
constexpr int NWAVES = 8;
constexpr int BATCH = 2, SEQ = 8192, D = 1024, M = BATCH * SEQ, FF = 2816, HD = 64, HYB = 3584, SBW = 3072;
constexpr size_t MiB = 1u << 20;
constexpr size_t WS_CTL = 0, CTL_ZERO_BYTES = 1 * MiB;
constexpr size_t WS_W = 1 * MiB;
constexpr size_t WS_XBA = 43 * MiB, WS_XBB = 75 * MiB;
constexpr size_t WS_BIG = 107 * MiB;
constexpr size_t WS_KV = 219 * MiB;
constexpr size_t WS_ST = 235 * MiB;
constexpr size_t WS_TAB = 243 * MiB;
constexpr size_t WS_SS = 246 * MiB;
constexpr size_t WS_LSE = 247 * MiB;
constexpr size_t WS_SSP = 248 * MiB;
constexpr size_t WO_F1IN = 0, WO_F1OUT = 5767168, WO_MIXIN = 8650752, WO_MIXOUT = 12320768, WO_F2IN = 13369344, WO_F2OUT = 19136512;
constexpr int CW_BAR = 4096;
constexpr int RING_OFF = 0, RING_BYTES = 131072, LDSCTL_OFF = RING_BYTES, MISC_OFF = LDSCTL_OFF + 320, LDS_BYTES = 147456;

__device__ __forceinline__ float wave_sum(float v) {
#pragma unroll
    for (int o = 1; o < 64; o <<= 1) v += __shfl_xor(v, o);
    return v;
}
__device__ __forceinline__ float bf2f(bf16 v) { return __uint_as_float(((unsigned)v) << 16); }

__device__ __forceinline__ void transpose_item(const float* W, const float* gain, int K, int N, bf16* WT, int dest_row0, int k0, int n0, LAS float* scr, int lane) {
    float wv[32];
#pragma unroll
    for (int i = 0; i < 32; ++i) wv[i] = ((const GAS float*)W)[(size_t)(k0 + 2 * i + (lane >> 5)) * N + n0 + (lane & 31)];
#pragma unroll
    for (int i = 0; i < 32; ++i) { const int kk = 2 * i + (lane >> 5); const float gk = gain ? gain[k0 + kk] : 1.0f; scr[kk * 33 + (lane & 31)] = wv[i] * gk; }
    LDS_WAIT(); asm volatile("" ::: "memory");
    const int c = lane & 7;
#pragma unroll
    for (int j = 0; j < 4; ++j) { const int n = (lane >> 3) + 8 * j; const LAS float* s = scr + (8 * c) * 33 + n;
        v4u o; o.x = pk2(s[0 * 33], s[1 * 33]); o.y = pk2(s[2 * 33], s[3 * 33]); o.z = pk2(s[4 * 33], s[5 * 33]); o.w = pk2(s[6 * 33], s[7 * 33]);
        *(GAS v4u*)(WT + (size_t)(dest_row0 + n) * K + k0 + 8 * c) = o; }
    LDS_WAIT(); asm volatile("" ::: "memory");
}
struct Args { const float* in[14]; float* out; unsigned char* ws; int ph_lo, ph_hi, li, mask; };

__device__ __forceinline__ void convert_layer(const Args& a, int l, LAS float* scr, int gw, int NGW, int lane) {
    bf16* Wb = (bf16*)(a.ws + WS_W);
    const int mixN = l == 0 ? HYB : SBW;
    const int I_IN = (D / 64) * (2 * FF / 32), I_OUT = (FF / 64) * (D / 32), I_MI = (D / 64) * (mixN / 32), I_MO = (D / 64) * (D / 32);
    const int NITEMS = 2 * I_IN + 2 * I_OUT + I_MI + I_MO;
    for (int it = gw; it < NITEMS; it += NGW) {
        int r = it; const float* W; const float* gain = nullptr; int K, N; bf16* WT; bool swi = false;
        if (r < I_IN) { W = a.in[2] + (size_t)l * D * 2 * FF; gain = a.in[1] + l * D; K = D; N = 2 * FF; WT = Wb + WO_F1IN; swi = true; }
        else if ((r -= I_IN) < I_IN) { W = a.in[6] + (size_t)l * D * 2 * FF; gain = a.in[5] + l * D; K = D; N = 2 * FF; WT = Wb + WO_F2IN; swi = true; }
        else if ((r -= I_IN) < I_OUT) { W = a.in[3] + (size_t)l * FF * D; K = FF; N = D; WT = Wb + WO_F1OUT; }
        else if ((r -= I_OUT) < I_OUT) { W = a.in[7] + (size_t)l * FF * D; K = FF; N = D; WT = Wb + WO_F2OUT; }
        else if ((r -= I_OUT) < I_MI) { W = l == 0 ? a.in[8] : a.in[11]; gain = a.in[4] + l * D; K = D; N = mixN; WT = Wb + WO_MIXIN; }
        else { r -= I_MI; W = l == 0 ? a.in[10] : a.in[12]; K = D; N = D; WT = Wb + WO_MIXOUT; }
        const int nblk = N / 32, kb = r / nblk, nb = r % nblk, n0 = 32 * nb; int dest = n0;
        if (swi) { const int up = n0 >= FF ? 1 : 0, j0 = n0 - up * FF; dest = (j0 / 128) * 256 + up * 128 + (j0 % 128); }
        transpose_item(W, gain, K, N, WT, dest, 64 * kb, n0, scr, lane);
    }
}
namespace mix {
typedef short bfx8 __attribute__((ext_vector_type(8)));
typedef unsigned u32x2v __attribute__((ext_vector_type(2)));
typedef unsigned short u16;
#define MFMA16(a, b, c) __builtin_amdgcn_mfma_f32_16x16x32_bf16(a, b, c, 0, 0, 0)
constexpr int QP = 72;
constexpr int OFF_Q = 0, OFF_K = 18432, OFF_V = 55296, OFF_FLAG = 90112;
constexpr int VP1 = 140, VP2 = 268;
constexpr float LOG2E = 1.4426950408889634f, LN2 = 0.6931471805599453f;

__device__ __forceinline__ float bfe(const v4u& a, int e) { return __uint_as_float((e & 1) ? (a[e >> 1] & 0xffff0000u) : (a[e >> 1] << 16)); }
typedef float f32x2_t __attribute__((ext_vector_type(2))); typedef __bf16 bf16x2_t __attribute__((ext_vector_type(2)));
__device__ __forceinline__ unsigned pkbf(float lo, float hi) { const f32x2_t v = {lo, hi}; const bf16x2_t b = __builtin_convertvector(v, bf16x2_t); return __builtin_bit_cast(unsigned, b); }
__device__ __forceinline__ bfx8 pack8(const f32x4& p0, const f32x4& p1) { v4u w; w.x = pkbf(p0[0], p0[1]); w.y = pkbf(p0[2], p0[3]); w.z = pkbf(p1[0], p1[1]); w.w = pkbf(p1[2], p1[3]); return __builtin_bit_cast(bfx8, w); }

template <int MODE>
__device__ __forceinline__ void stage_rows(LAS bf16* dst, const bf16* src, size_t rowStride, int nrows, int pos0, int posStride, const float* ctab, const float* stab, int tid) {
    for (int it = tid; it < nrows * 4; it += 512) {
        const int row = it >> 2, c = it & 3; const bf16* p = src + (size_t)row * rowStride;
        v4u a = *(const GAS v4u*)(p + 8 * c), b = *(const GAS v4u*)(p + 32 + 8 * c);
        if (MODE == 1) {
            const int pos = pos0 + row * posStride; const GAS f32x4* ct = (const GAS f32x4*)(ctab + pos * 32 + 8 * c); const GAS f32x4* sn = (const GAS f32x4*)(stab + pos * 32 + 8 * c);
            const f32x4 c0 = ct[0], c1 = ct[1], s0 = sn[0], s1 = sn[1]; float y1[8], y2[8];
#pragma unroll
            for (int e = 0; e < 8; ++e) { const float cs = e < 4 ? c0[e & 3] : c1[e & 3], si = e < 4 ? s0[e & 3] : s1[e & 3]; const float x1 = bfe(a, e), x2 = bfe(b, e); y1[e] = x1 * cs - x2 * si; y2[e] = x2 * cs + x1 * si; }
            a.x = pkbf(y1[0], y1[1]); a.y = pkbf(y1[2], y1[3]); a.z = pkbf(y1[4], y1[5]); a.w = pkbf(y1[6], y1[7]);
            b.x = pkbf(y2[0], y2[1]); b.y = pkbf(y2[2], y2[3]); b.z = pkbf(y2[4], y2[5]); b.w = pkbf(y2[6], y2[7]);
        }
        if (MODE == 2) {
            v4u o; o.x = __shfl_xor(a.x, 1); o.y = __shfl_xor(a.y, 1); o.z = __shfl_xor(a.z, 1); o.w = __shfl_xor(a.w, 1);
            if (c < 2) {
                const int pos = pos0 + row * posStride; const GAS f32x4* ct = (const GAS f32x4*)(ctab + pos * 8); const GAS f32x4* sn = (const GAS f32x4*)(stab + pos * 8);
                const f32x4 c0 = ct[0], c1 = ct[1], s0 = sn[0], s1 = sn[1]; float y[8];
#pragma unroll
                for (int e = 0; e < 8; ++e) { const float cs = e < 4 ? c0[e & 3] : c1[e & 3], si = e < 4 ? s0[e & 3] : s1[e & 3]; const float xo = bfe(a, e), xp = bfe(o, e); y[e] = c == 0 ? (xo * cs - xp * si) : (xo * cs + xp * si); }
                a.x = pkbf(y[0], y[1]); a.y = pkbf(y[2], y[3]); a.z = pkbf(y[4], y[5]); a.w = pkbf(y[6], y[7]);
            }
        }
        *(LAS v4u*)(dst + row * QP + 8 * c) = a; *(LAS v4u*)(dst + row * QP + 32 + 8 * c) = b;
    }
}
__device__ __forceinline__ void stage_vt(LAS bf16* dst, int pitch, int key_off, const bf16* src, size_t rowStride, int tid) {
    for (int it = tid; it < 128 * 8; it += 512) {
        const int key = it & 127, c = it >> 7; const v4u a = *(const GAS v4u*)(src + (size_t)key * rowStride + 8 * c);
#pragma unroll
        for (int e = 0; e < 8; ++e) dst[(8 * c + e) * pitch + key_off + key] = (bf16)((e & 1) ? (a[e >> 1] >> 16) : (a[e >> 1] & 0xffffu));
    }
}
struct RR { v4u a, b; };
struct TT { f32x4 c0, c1, s0, s1; };
struct VV { v4u v0, v1; };
__device__ __forceinline__ void ld_rows(RR& r, const bf16* src, size_t rowStride, int tid) { const bf16* p = src + (size_t)(tid >> 2) * rowStride + 8 * (tid & 3); r.a = *(const GAS v4u*)p; r.b = *(const GAS v4u*)(p + 32); }
__device__ __forceinline__ void st_rows(LAS bf16* dst, const RR& r, int tid) { LAS bf16* q = dst + (tid >> 2) * QP + 8 * (tid & 3); *(LAS v4u*)q = r.a; *(LAS v4u*)(q + 32) = r.b; }
__device__ __forceinline__ void ld_tab(TT& t, const float* ctab, const float* stab, int idx) { const GAS f32x4* ct = (const GAS f32x4*)(ctab + idx); const GAS f32x4* sn = (const GAS f32x4*)(stab + idx); t.c0 = ct[0]; t.c1 = ct[1]; t.s0 = sn[0]; t.s1 = sn[1]; }
__device__ __forceinline__ void rot1(RR& r, const TT& t) {
    float y1[8], y2[8];
#pragma unroll
    for (int e = 0; e < 8; ++e) { const float cs = e < 4 ? t.c0[e & 3] : t.c1[e & 3], si = e < 4 ? t.s0[e & 3] : t.s1[e & 3]; const float x1 = bfe(r.a, e), x2 = bfe(r.b, e); y1[e] = x1 * cs - x2 * si; y2[e] = x2 * cs + x1 * si; }
    r.a.x = pkbf(y1[0], y1[1]); r.a.y = pkbf(y1[2], y1[3]); r.a.z = pkbf(y1[4], y1[5]); r.a.w = pkbf(y1[6], y1[7]);
    r.b.x = pkbf(y2[0], y2[1]); r.b.y = pkbf(y2[2], y2[3]); r.b.z = pkbf(y2[4], y2[5]); r.b.w = pkbf(y2[6], y2[7]);
}
__device__ __forceinline__ void rot2(RR& r, const TT& t, int c) {
    v4u o; o.x = __shfl_xor(r.a.x, 1); o.y = __shfl_xor(r.a.y, 1); o.z = __shfl_xor(r.a.z, 1); o.w = __shfl_xor(r.a.w, 1);
    if (c < 2) { float y[8];
#pragma unroll
        for (int e = 0; e < 8; ++e) { const float cs = e < 4 ? t.c0[e & 3] : t.c1[e & 3], si = e < 4 ? t.s0[e & 3] : t.s1[e & 3]; const float xo = bfe(r.a, e), xp = bfe(o, e); y[e] = c == 0 ? (xo * cs - xp * si) : (xo * cs + xp * si); }
        r.a.x = pkbf(y[0], y[1]); r.a.y = pkbf(y[2], y[3]); r.a.z = pkbf(y[4], y[5]); r.a.w = pkbf(y[6], y[7]); }
}
__device__ __forceinline__ void ld_vt(VV& v, const bf16* src, size_t rowStride, int tid) { const int kp = (tid >> 2) & 63, c = ((tid >> 8) << 2) | (tid & 3); const bf16* p = src + (size_t)(2 * kp) * rowStride + 8 * c; v.v0 = *(const GAS v4u*)p; v.v1 = *(const GAS v4u*)(p + rowStride); }
__device__ __forceinline__ void st_vt(LAS bf16* dst, int pitch, int key_off, const VV& v, int tid) { const int kp = (tid >> 2) & 63, c = ((tid >> 8) << 2) | (tid & 3);
#pragma unroll
    for (int e = 0; e < 8; ++e) { const unsigned a = v.v0[e >> 1], b2 = v.v1[e >> 1]; const unsigned wd = (e & 1) ? ((a >> 16) | (b2 & 0xffff0000u)) : ((a & 0xffffu) | (b2 << 16));
        *(LAS unsigned*)(dst + (8 * c + e) * pitch + key_off + 2 * kp) = wd; }
}
__device__ __forceinline__ void stage_kt_ret(LAS bf16* dst, const bf16* src, size_t rowStride, int pos0, const float* ctab, const float* stab, float log2g, int tid) {
    { const int it = tid; const int key = it & 127, c = it >> 7; const bf16* p = src + (size_t)key * rowStride;
        const v4u a = *(const GAS v4u*)(p + 8 * c), b = *(const GAS v4u*)(p + 32 + 8 * c);
        const int pos = pos0 + key; const GAS f32x4* ct = (const GAS f32x4*)(ctab + pos * 32 + 8 * c); const GAS f32x4* sn = (const GAS f32x4*)(stab + pos * 32 + 8 * c);
        const f32x4 c0 = ct[0], c1 = ct[1], s0 = sn[0], s1 = sn[1]; const float kd = 0.125f * exp2f((float)(127 - key) * log2g);
#pragma unroll
        for (int e = 0; e < 8; ++e) { const float cs = e < 4 ? c0[e & 3] : c1[e & 3], si = e < 4 ? s0[e & 3] : s1[e & 3]; const float x1 = bfe(a, e), x2 = bfe(b, e);
            dst[(8 * c + e) * 136 + key] = (bf16)f2bf((x1 * cs - x2 * si) * kd); dst[(32 + 8 * c + e) * 136 + key] = (bf16)f2bf((x2 * cs + x1 * si) * kd); }
    }
}
__device__ __forceinline__ f32x4 st_tile(const LAS bf16* Ks, int T, const bfx8 (&qf)[2], int c16, int g) {
    f32x4 acc = (f32x4){0.f, 0.f, 0.f, 0.f};
#pragma unroll
    for (int ks = 0; ks < 2; ++ks) { const bfx8 a = *(const LAS bfx8*)(Ks + (16 * T + c16) * QP + 32 * ks + 8 * g); acc = MFMA16(a, qf[ks], acc); }
    return acc;
}
__device__ __forceinline__ void st_tiles8(const LAS bf16* Ks, int T0, const bfx8 (&qf)[2], int c16, int g, f32x4 (&out)[8]) {
    bfx8 a[8][2];
#pragma unroll
    for (int T = 0; T < 8; ++T)
#pragma unroll
        for (int ks = 0; ks < 2; ++ks) a[T][ks] = *(const LAS bfx8*)(Ks + (16 * (T0 + T) + c16) * QP + 32 * ks + 8 * g);
#pragma unroll
    for (int T = 0; T < 8; ++T) { f32x4 acc = (f32x4){0.f, 0.f, 0.f, 0.f};
#pragma unroll
        for (int ks = 0; ks < 2; ++ks) acc = MFMA16(a[T][ks], qf[ks], acc);
        out[T] = acc; }
}
__device__ __forceinline__ void pv_pair(f32x4 (&o)[4], const LAS bf16* Vs, int vp, int t0, int t1, const f32x4& p0, const f32x4& p1, int c16, int g) {
    const bfx8 pb = pack8(p0, p1); u32x2v lo[4], hi[4];
#pragma unroll
    for (int dt = 0; dt < 4; ++dt) { lo[dt] = *(const LAS u32x2v*)(Vs + (16 * dt + c16) * vp + 16 * t0 + 4 * g); hi[dt] = *(const LAS u32x2v*)(Vs + (16 * dt + c16) * vp + 16 * t1 + 4 * g); }
#pragma unroll
    for (int dt = 0; dt < 4; ++dt) { v4u av; av.x = lo[dt].x; av.y = lo[dt].y; av.z = hi[dt].x; av.w = hi[dt].y; o[dt] = MFMA16(__builtin_bit_cast(bfx8, av), pb, o[dt]); }
}

__device__ __forceinline__ void ret_kv_unit(int u, const bf16* proj, const float* rc, const float* rs, float* kv, LAS unsigned char* lds, int tid) {
    const int n = u & 63, bh = u >> 6, h = bh & 7, b = bh >> 3; const int lane = tid & 63, w = __builtin_amdgcn_readfirstlane(tid >> 6), c16 = lane & 15, g = lane >> 4;
    const float log2g = log2f(1.0f - exp2f(-5.0f - (float)h));
    const bf16* rowp = proj + (size_t)(b * SEQ + n * 128) * HYB + h * 64;
    LAS bf16* Kt = (LAS bf16*)(lds + OFF_Q); LAS bf16* Vt = (LAS bf16*)(lds + OFF_V);
    { const int key = tid & 127, c = tid >> 7; const bf16* p = rowp + 512 + (size_t)key * HYB;
        const v4u a = *(const GAS v4u*)(p + 8 * c), b2 = *(const GAS v4u*)(p + 32 + 8 * c); TT t; ld_tab(t, rc, rs, (n * 128 + key) * 32 + 8 * c); VV vv; ld_vt(vv, rowp + 1024, HYB, tid);
        const float kd = 0.125f * __builtin_amdgcn_exp2f((float)(127 - key) * log2g);
#pragma unroll
        for (int e = 0; e < 8; ++e) { const float cs = e < 4 ? t.c0[e & 3] : t.c1[e & 3], si = e < 4 ? t.s0[e & 3] : t.s1[e & 3]; const float x1 = bfe(a, e), x2 = bfe(b2, e);
            Kt[(8 * c + e) * 136 + key] = (bf16)f2bf((x1 * cs - x2 * si) * kd); Kt[(32 + 8 * c + e) * 136 + key] = (bf16)f2bf((x2 * cs + x1 * si) * kd); }
        st_vt(Vt, 136, 0, vv, tid); }
    __syncthreads();
    const int dvt = w >> 1;
#pragma unroll
    for (int i = 0; i < 2; ++i) { const int dkt = 2 * (w & 1) + i; f32x4 acc = (f32x4){0.f, 0.f, 0.f, 0.f};
#pragma unroll
        for (int ks = 0; ks < 4; ++ks) { const bfx8 a = *(const LAS bfx8*)(Vt + (16 * dvt + c16) * 136 + 32 * ks + 8 * g), bb = *(const LAS bfx8*)(Kt + (16 * dkt + c16) * 136 + 32 * ks + 8 * g); acc = MFMA16(a, bb, acc); }
        float* o = kv + ((size_t)n * 16 + bh) * 4096;
#pragma unroll
        for (int r = 0; r < 4; ++r) o[(16 * dvt + 4 * g + r) * 64 + 16 * dkt + c16] = acc[r]; }
    __syncthreads();
}
__device__ __forceinline__ void ret_scan(int chain, const float* kv, bf16* St) {
    const int h = (chain >> 12) & 7; const float cd = exp2f(128.0f * log2f(1.0f - exp2f(-5.0f - (float)h)));
    float state = 0.f; const GAS float* kvp = (const GAS float*)kv + chain; GAS bf16* stp = (GAS bf16*)St + chain;
#pragma unroll
    for (int n0 = 0; n0 < 64; n0 += 32) {
        float v[32];
#pragma unroll
        for (int i = 0; i < 32; ++i) v[i] = kvp[(size_t)(n0 + i) * 65536];
#pragma unroll
        for (int i = 0; i < 32; ++i) { stp[(size_t)(n0 + i) * 65536] = (bf16)f2bf(state); state = state * cd + v[i]; }
    }
}
__device__ __forceinline__ void ret_out_unit(int u, const bf16* proj, const float* rc, const float* rs, const bf16* St, const float* gn, bf16* cat, LAS unsigned char* lds, int tid) {
    const int n = u & 63, bh = u >> 6, h = bh & 7, b = bh >> 3; const int lane = tid & 63, w = __builtin_amdgcn_readfirstlane(tid >> 6), c16 = lane & 15, g = lane >> 4;
    const float log2g = log2f(1.0f - exp2f(-5.0f - (float)h));
    const size_t row0 = (size_t)(b * SEQ + n * 128); const bf16* rowp = proj + row0 * HYB + h * 64;
    LAS bf16* Qs = (LAS bf16*)(lds + OFF_Q); LAS bf16* Ks = (LAS bf16*)(lds + OFF_K); LAS bf16* Vs = (LAS bf16*)(lds + OFF_V);
    { RR rq, rk, rst; TT t; VV vv;
        ld_rows(rq, rowp, HYB, tid); ld_rows(rk, rowp + 512, HYB, tid); ld_tab(t, rc, rs, (n * 128 + (tid >> 2)) * 32 + 8 * (tid & 3)); ld_vt(vv, rowp + 1024, HYB, tid);
        if (tid < 256) ld_rows(rst, St + ((size_t)n * 16 + bh) * 4096, 64, tid);
        rot1(rq, t); rot1(rk, t); st_rows(Qs, rq, tid); st_rows(Ks, rk, tid); st_vt(Vs, VP1, 0, vv, tid);
        if (tid < 256) st_rows(Ks + 128 * QP, rst, tid); }
    __syncthreads();
    bfx8 qf[2];
#pragma unroll
    for (int ks = 0; ks < 2; ++ks) qf[ks] = *(const LAS bfx8*)(Qs + (16 * w + c16) * QP + 32 * ks + 8 * g);
    const int qi = 16 * w + c16;
    f32x4 o[4], cr[4];
#pragma unroll
    for (int dt = 0; dt < 4; ++dt) { o[dt] = (f32x4){0.f, 0.f, 0.f, 0.f}; cr[dt] = (f32x4){0.f, 0.f, 0.f, 0.f}; }
#pragma unroll
    for (int tp = 0; tp < 4; ++tp) {
        f32x4 p[2];
#pragma unroll
        for (int i = 0; i < 2; ++i) { const int T = 2 * tp + i; const f32x4 s = st_tile(Ks, T, qf, c16, g);
#pragma unroll
            for (int r = 0; r < 4; ++r) { const int kj = 16 * T + 4 * g + r; const int dd = qi - kj; p[i][r] = dd >= 0 ? s[r] * 0.125f * __builtin_amdgcn_exp2f((float)dd * log2g) : 0.f; } }
        pv_pair(o, Vs, VP1, 2 * tp, 2 * tp + 1, p[0], p[1], c16, g);
    }
#pragma unroll
    for (int dt = 0; dt < 4; ++dt) cr[dt] = st_tile(Ks, 8 + dt, qf, c16, g);
    const float qd = exp2f((float)(qi + 1) * log2g);
    float sum = 0.f;
#pragma unroll
    for (int dt = 0; dt < 4; ++dt) { o[dt] = o[dt] + cr[dt] * qd; sum += (o[dt][0] + o[dt][1]) + (o[dt][2] + o[dt][3]); }
    sum += __shfl_xor(sum, 16); sum += __shfl_xor(sum, 32);
    const float mu = sum * (1.0f / 64.0f); float var = 0.f;
#pragma unroll
    for (int dt = 0; dt < 4; ++dt) { o[dt] = o[dt] - mu; var += (o[dt][0] * o[dt][0] + o[dt][1] * o[dt][1]) + (o[dt][2] * o[dt][2] + o[dt][3] * o[dt][3]); }
    var += __shfl_xor(var, 16); var += __shfl_xor(var, 32);
    const float rstd = rsqrtf(var * (1.0f / 64.0f) + 1e-5f);
    const size_t tok = row0 + qi;
    f32x4 ggv[4]; u32x2v rgv[4];
#pragma unroll
    for (int dt = 0; dt < 4; ++dt) { const int d0 = 16 * dt + 4 * g; ggv[dt] = *(const GAS f32x4*)(gn + h * 64 + d0); rgv[dt] = *(const GAS u32x2v*)(proj + tok * HYB + 1536 + h * 64 + d0); }
#pragma unroll
    for (int dt = 0; dt < 4; ++dt) { const int d0 = 16 * dt + 4 * g; const f32x4 gg = ggv[dt]; const u32x2v rgw = rgv[dt];
        float y[4];
#pragma unroll
        for (int r = 0; r < 4; ++r) { const float gate = __uint_as_float((r & 1) ? (rgw[r >> 1] & 0xffff0000u) : (rgw[r >> 1] << 16)); y[r] = o[dt][r] * rstd * gg[r] * (gate * __builtin_amdgcn_rcpf(1.0f + __expf(-gate))); }
        u32x2v wv; wv.x = pkbf(y[0], y[1]); wv.y = pkbf(y[2], y[3]); *(GAS u32x2v*)(cat + tok * D + h * 64 + d0) = wv; }
    __syncthreads();
}

__device__ __forceinline__ void dil_unit(int u, const bf16* proj, const float* dc, const float* ds, bf16* part, float* lsep, bf16* cat, LAS unsigned char* lds, int tid) {
    const int idx = u & 63, h = (u >> 6) & 7, b = (u >> 9) & 1, p = u >> 10; const int dil = p == 0 ? 1 : (p == 1 ? 4 : 16), nper = 64 / dil, r = idx / nper, nbi = idx % nper;
    const int lane = tid & 63, w = __builtin_amdgcn_readfirstlane(tid >> 6), c16 = lane & 15, g = lane >> 4;
    const bf16* bp = proj + (size_t)b * SEQ * HYB + h * 64; const int t0 = (128 * nbi) * dil + r;
    LAS bf16* Qs = (LAS bf16*)(lds + OFF_Q); LAS bf16* Ks = (LAS bf16*)(lds + OFF_K); LAS bf16* Vs = (LAS bf16*)(lds + OFF_V);
    const size_t rstr = (size_t)dil * HYB;
    { RR rq, rk, rkp; TT t, tp_; VV vv, vvp; const int tp = t0 - 128 * dil, srow = tid >> 2, sc = tid & 3;
        ld_rows(rq, bp + (size_t)t0 * HYB + 2048, rstr, tid); ld_rows(rk, bp + (size_t)t0 * HYB + 2560, rstr, tid); ld_tab(t, dc, ds, (t0 + srow * dil) * 8); ld_vt(vv, bp + (size_t)t0 * HYB + 3072, rstr, tid);
        if (nbi > 0) { ld_rows(rkp, bp + (size_t)tp * HYB + 2560, rstr, tid); ld_tab(tp_, dc, ds, (tp + srow * dil) * 8); ld_vt(vvp, bp + (size_t)tp * HYB + 3072, rstr, tid); }
        rot2(rq, t, sc); rot2(rk, t, sc); st_rows(Qs, rq, tid); st_rows(Ks + 128 * QP, rk, tid); st_vt(Vs, VP2, 128, vv, tid);
        if (nbi > 0) { rot2(rkp, tp_, sc); st_rows(Ks, rkp, tid); st_vt(Vs, VP2, 0, vvp, tid); } }
    __syncthreads();
    bfx8 qf[2];
#pragma unroll
    for (int ks = 0; ks < 2; ++ks) qf[ks] = *(const LAS bfx8*)(Qs + (16 * w + c16) * QP + 32 * ks + 8 * g);
    const int qi = 16 * w + c16; const int Tlo = nbi > 0 ? w : 8, Thi = 8 + w;
    f32x4 s[16]; float m = -INFINITY;
#pragma unroll
    for (int T = 0; T < 16; ++T) { s[T] = (f32x4){-INFINITY, -INFINITY, -INFINITY, -INFINITY};
        if (T >= Tlo && T <= Thi) { const f32x4 a = st_tile(Ks, T, qf, c16, g);
#pragma unroll
            for (int rr = 0; rr < 4; ++rr) { const int kj = 16 * (T & 7) + 4 * g + rr; const bool ok = T < 8 ? (kj >= qi) : (kj <= qi); s[T][rr] = ok ? a[rr] * 0.125f : -INFINITY; m = fmaxf(m, s[T][rr]); } } }
    m = fmaxf(m, __shfl_xor(m, 16)); m = fmaxf(m, __shfl_xor(m, 32));
    float l = 0.f;
#pragma unroll
    for (int T = 0; T < 16; ++T) {
        if (T >= Tlo && T <= Thi) {
#pragma unroll
            for (int rr = 0; rr < 4; ++rr) { const float e = __builtin_amdgcn_exp2f((s[T][rr] - m) * LOG2E); s[T][rr] = e; l += e; }
        } else s[T] = (f32x4){0.f, 0.f, 0.f, 0.f};
    }
    l += __shfl_xor(l, 16); l += __shfl_xor(l, 32);
    f32x4 o[4];
#pragma unroll
    for (int dt = 0; dt < 4; ++dt) o[dt] = (f32x4){0.f, 0.f, 0.f, 0.f};
#pragma unroll
    for (int tp = 0; tp < 8; ++tp) if (2 * tp + 1 >= Tlo && 2 * tp <= Thi) {
        const int ta = 2 * tp, tb = 2 * tp + 1;
        const int ra = ta >= Tlo ? ta : tb, rb = tb <= Thi ? tb : ta;
        pv_pair(o, Vs, VP2, ra, rb, s[ta], s[tb], c16, g);
    }
    const float rl = 1.0f / l, lse = m + __logf(l);
    const size_t tok = (size_t)b * SEQ + t0 + (size_t)qi * dil;
    if (p < 2) {
        if (g == 0) lsep[(size_t)p * M * 8 + tok * 8 + h] = lse;
#pragma unroll
        for (int dt = 0; dt < 4; ++dt) { u32x2v wv; wv.x = pkbf(o[dt][0] * rl, o[dt][1] * rl); wv.y = pkbf(o[dt][2] * rl, o[dt][3] * rl); *(GAS u32x2v*)(part + (size_t)p * M * 512 + tok * 512 + h * 64 + 16 * dt + 4 * g) = wv; }
    } else {
        const float l0 = ((const GAS float*)lsep)[tok * 8 + h], l1 = ((const GAS float*)lsep)[(size_t)M * 8 + tok * 8 + h];
        u32x2v x0v[4], x1v[4];
#pragma unroll
        for (int dt = 0; dt < 4; ++dt) { const int d0 = h * 64 + 16 * dt + 4 * g; x0v[dt] = *(const GAS u32x2v*)(part + tok * 512 + d0); x1v[dt] = *(const GAS u32x2v*)(part + (size_t)M * 512 + tok * 512 + d0); }
        const float mm = fmaxf(lse, fmaxf(l0, l1));
        const float w0 = __expf(l0 - mm), w1 = __expf(l1 - mm), w2 = __expf(lse - mm); const float inv = 1.0f / (w0 + w1 + w2); const float a0 = w0 * inv, a1 = w1 * inv, a2 = w2 * inv * rl;
#pragma unroll
        for (int dt = 0; dt < 4; ++dt) { const int d0 = h * 64 + 16 * dt + 4 * g; const u32x2v x0 = x0v[dt], x1 = x1v[dt]; float y[4];
#pragma unroll
            for (int rr = 0; rr < 4; ++rr) { const float v0 = __uint_as_float((rr & 1) ? (x0[rr >> 1] & 0xffff0000u) : (x0[rr >> 1] << 16)), v1 = __uint_as_float((rr & 1) ? (x1[rr >> 1] & 0xffff0000u) : (x1[rr >> 1] << 16)); y[rr] = a0 * v0 + a1 * v1 + a2 * o[dt][rr]; }
            u32x2v wv; wv.x = pkbf(y[0], y[1]); wv.y = pkbf(y[2], y[3]); *(GAS u32x2v*)(cat + tok * D + 512 + d0) = wv; }
    }
    __syncthreads();
}
}
namespace mix {
__device__ __forceinline__ void sb_unit(int u, const bf16* qkv, bf16* cat, LAS unsigned char* lds, int tid) {
    const int qb = 63 - (u & 63), h = (u >> 6) & 15, b = u >> 10; const int lane = tid & 63, w = __builtin_amdgcn_readfirstlane(tid >> 6), c16 = lane & 15, g = lane >> 4;
    const bf16* bp = qkv + (size_t)b * SEQ * SBW + h * 64;
    LAS bf16* Qs = (LAS bf16*)(lds + OFF_Q); LAS bf16* Ks = (LAS bf16*)(lds + OFF_K); LAS bf16* Vs = (LAS bf16*)(lds + OFF_V); volatile LAS int* flags = (volatile LAS int*)(lds + OFF_FLAG);
    const int qi = 16 * w + c16;
    v4u onesw, tri0w, tri1w;
    {
        unsigned t0e[8], t1e[8];
#pragma unroll
        for (int j = 0; j < 8; ++j) { t0e[j] = j < 4 ? ((4 * g + j > c16) ? 0x3F80u : 0u) : 0x3F80u; t1e[j] = j < 4 ? 0u : ((4 * g + (j - 4) > c16) ? 0x3F80u : 0u); }
        onesw = (v4u){0x3F803F80u, 0x3F803F80u, 0x3F803F80u, 0x3F803F80u};
        tri0w = (v4u){t0e[0] | (t0e[1] << 16), t0e[2] | (t0e[3] << 16), t0e[4] | (t0e[5] << 16), t0e[6] | (t0e[7] << 16)};
        tri1w = (v4u){t1e[0] | (t1e[1] << 16), t1e[2] | (t1e[3] << 16), t1e[4] | (t1e[5] << 16), t1e[6] | (t1e[7] << 16)};
    }
    const bfx8 ones = __builtin_bit_cast(bfx8, onesw), tri0 = __builtin_bit_cast(bfx8, tri0w), tri1 = __builtin_bit_cast(bfx8, tri1w);
    f32x4 o[4];
#pragma unroll
    for (int dt = 0; dt < 4; ++dt) o[dt] = (f32x4){0.f, 0.f, 0.f, 0.f};
    float carry = 0.f;
    bfx8 qf[2];
    const int krow = tid >> 2, kc = tid & 3, vkp = (tid >> 2) & 63, vc = ((tid >> 8) << 2) | (tid & 3);
    v4u ka, kb2, va0, va1;
#define SB_LOAD(blk) do { const bf16* kp_ = bp + (size_t)((blk) * 128 + krow) * SBW + 1024; ka = *(const GAS v4u*)(kp_ + 8 * kc); kb2 = *(const GAS v4u*)(kp_ + 32 + 8 * kc); \
        const bf16* vp_ = bp + (size_t)((blk) * 128 + 2 * vkp) * SBW + 2048 + 8 * vc; va0 = *(const GAS v4u*)vp_; va1 = *(const GAS v4u*)(vp_ + SBW); } while (0)
    SB_LOAD(qb);
    { RR rq; ld_rows(rq, bp + (size_t)(qb * 128) * SBW, SBW, tid); st_rows(Qs, rq, tid); }
    for (int kb = qb; kb >= 0; --kb) {
        *(LAS v4u*)(Ks + krow * QP + 8 * kc) = ka; *(LAS v4u*)(Ks + krow * QP + 32 + 8 * kc) = kb2;
#pragma unroll
        for (int e = 0; e < 8; ++e) { const unsigned a_ = va0[e >> 1], b_ = va1[e >> 1]; *(LAS unsigned*)(Vs + (8 * vc + e) * VP1 + 2 * vkp) = (e & 1) ? ((a_ >> 16) | (b_ & 0xffff0000u)) : ((a_ & 0xffffu) | (b_ << 16)); }
        __syncthreads();
        if (kb > 0) SB_LOAD(kb - 1);
        if (kb == qb) {
#pragma unroll
            for (int ks = 0; ks < 2; ++ks) qf[ks] = *(const LAS bfx8*)(Qs + (16 * w + c16) * QP + 32 * ks + 8 * g);
        }
        const bool diag = kb == qb;
        if (__any(carry >= -104.0f)) {
        f32x4 ls[8], lg[8];
        f32x4 zt[8]; st_tiles8(Ks, 0, qf, c16, g, zt);
#pragma unroll
        for (int T = 0; T < 8; ++T) { const f32x4 a = zt[T];
#pragma unroll
            for (int r = 0; r < 4; ++r) { const int kj = 16 * T + 4 * g + r; const bool ok = !diag || kj < qi; const float z = a[r] * 0.125f;
                const float sp = fmaxf(z, 0.f) + __log2f(1.0f + __builtin_amdgcn_exp2f(-fabsf(z) * LOG2E)) * LN2;
                ls[T][r] = ok ? -sp : 0.f; lg[T][r] = ok ? z - sp : -INFINITY; } }
        float tot[4]; f32x4 later[8];
#pragma unroll
        for (int s = 0; s < 4; ++s) {
            f32x4 hi0, hi1, lo0, lo1;
#pragma unroll
            for (int r = 0; r < 4; ++r) { hi0[r] = __uint_as_float(__float_as_uint(ls[2 * s][r]) & 0xffff0000u); lo0[r] = ls[2 * s][r] - hi0[r]; hi1[r] = __uint_as_float(__float_as_uint(ls[2 * s + 1][r]) & 0xffff0000u); lo1[r] = ls[2 * s + 1][r] - hi1[r]; }
            const bfx8 bh = pack8(hi0, hi1), bl = pack8(lo0, lo1);
            f32x4 t = (f32x4){0.f, 0.f, 0.f, 0.f}; t = MFMA16(ones, bh, t); t = MFMA16(ones, bl, t); tot[s] = t[0];
            f32x4 a0 = (f32x4){0.f, 0.f, 0.f, 0.f}, a1 = (f32x4){0.f, 0.f, 0.f, 0.f};
            a0 = MFMA16(tri0, bh, a0); a0 = MFMA16(tri0, bl, a0); a1 = MFMA16(tri1, bh, a1); a1 = MFMA16(tri1, bl, a1);
            later[2 * s] = a0; later[2 * s + 1] = a1;
        }
        float suf = carry;
#pragma unroll
        for (int s = 3; s >= 0; --s) {
            f32x4 p0, p1;
#pragma unroll
            for (int r = 0; r < 4; ++r) { p0[r] = __builtin_amdgcn_exp2f((lg[2 * s][r] + later[2 * s][r] + suf) * LOG2E); p1[r] = __builtin_amdgcn_exp2f((lg[2 * s + 1][r] + later[2 * s + 1][r] + suf) * LOG2E); }
            pv_pair(o, Vs, VP1, 2 * s, 2 * s + 1, p0, p1, c16, g);
            suf += tot[s];
        }
        carry = suf;
        }
        const int alive = __any(carry >= -104.0f) ? 1 : 0;
        if (lane == 0) flags[w] = alive;
        __syncthreads();
        int any = 0;
#pragma unroll
        for (int i = 0; i < 8; ++i) any |= flags[i];
        if (!any) break;
    }
#undef SB_LOAD
    const size_t tok = (size_t)b * SEQ + qb * 128 + qi;
#pragma unroll
    for (int dt = 0; dt < 4; ++dt) { u32x2v wv; wv.x = pkbf(o[dt][0], o[dt][1]); wv.y = pkbf(o[dt][2], o[dt][3]); *(GAS u32x2v*)(cat + tok * D + h * 64 + 16 * dt + 4 * g) = wv; }
    __syncthreads();
}
}
__global__ void __launch_bounds__(NWAVES * 64, 2) mega(Args args) {
    extern __shared__ __attribute__((aligned(16))) unsigned char lds_raw[];
    LAS unsigned char* lds = (LAS unsigned char*)lds_raw;
    volatile LAS unsigned* MISC = (volatile LAS unsigned*)(lds + MISC_OFF);
    const int G = gridDim.x; const int bx = blockIdx.x;
    const int wave_s = __builtin_amdgcn_readfirstlane((int)threadIdx.x >> 6);
    for (int u = wave_s * 64 + MK_LANE(); u < (LDS_BYTES - LDSCTL_OFF) / 4; u += NWAVES * 64) ((LAS unsigned*)(lds + LDSCTL_OFF))[u] = 0u;
    __syncthreads();
    XcdBarrier bar = xcd_barrier_post((unsigned*)((gu32*)(args.ws + WS_CTL) + CW_BAR) + args.li * XCD_BAR_WORDS, MISC + 8, wave_s);

    for (int ph = args.ph_lo; ph < args.ph_hi; ++ph) {
        int tid = wave_s * 64 + MK_LANE(); asm volatile("" : "+v"(tid));
        unsigned char* ws = args.ws; asm volatile("" : "+s"(ws));
        const int lane = tid & 63, wave = __builtin_amdgcn_readfirstlane(tid >> 6);
        const int vcu = (G % 8 == 0) ? (bx % 8) * (G / 8) + bx / 8 : bx;
        const int gw = vcu * NWAVES + wave, NGW = G * NWAVES;
        bf16* Wb = (bf16*)(ws + WS_W); bf16* xbA = (bf16*)(ws + WS_XBA); bf16* xbB = (bf16*)(ws + WS_XBB); bf16* big = (bf16*)(ws + WS_BIG);
        float* SS = (float*)(ws + WS_SS); float* out = args.out;
        const int l = ph >= 11 ? 1 : 0, s = (ph >= 1 && ph <= 9) ? ph : (ph >= 11 && ph <= 19 ? ph - 10 : 0);
        if (l == 1 && (s == 5 || s == 6)) continue;
        if (ph == 0) {
            LAS float* scr = (LAS float*)(lds + RING_OFF + wave * 16384);
            float* rc = (float*)(ws + WS_TAB); float* rs = rc + SEQ * 32; float* dc = rs + SEQ * 32; float* ds = dc + SEQ * 8;
            for (int idx = gw * 64 + lane; idx < SEQ * 32; idx += NGW * 64) {
                { const int pos = idx / 32, i = idx % 32; const float inv = 1.0f / powf(10000.0f, (float)i / 32.0f); const float ang = (float)pos * inv; rc[idx] = cosf(ang); rs[idx] = sinf(ang); }
                if (idx < SEQ * 8) { const int pos = idx / 8, i = idx % 8; const float inv = 1.0f / powf(500000.0f, (float)i / 8.0f); const float ang = (float)pos * inv; dc[idx] = cosf(ang); ds[idx] = sinf(ang); }
            }
            for (int m0 = gw; m0 < M; m0 += 2 * NGW) {
                f32x4 v[2][4];
#pragma unroll
                for (int r = 0; r < 2; ++r) { const int m = m0 + r * NGW < M ? m0 + r * NGW : m0; const GAS f32x4* xr = (const GAS f32x4*)(args.in[0] + (size_t)m * D) + lane;
#pragma unroll
                    for (int j = 0; j < 4; ++j) v[r][j] = xr[64 * j]; }
#pragma unroll
                for (int r = 0; r < 2; ++r) { const int m = m0 + r * NGW; if (m < M) { float sq = 0.f;
#pragma unroll
                    for (int j = 0; j < 4; ++j) sq += (v[r][j].x * v[r][j].x + v[r][j].y * v[r][j].y) + (v[r][j].z * v[r][j].z + v[r][j].w * v[r][j].w);
                    sq = wave_sum(sq); if (lane == 0) SS[m] = sq;
                    GAS unsigned long long* o8 = (GAS unsigned long long*)(xbA + (size_t)m * D) + lane;
#pragma unroll
                    for (int j = 0; j < 4; ++j) o8[64 * j] = (unsigned long long)pk2(v[r][j].x, v[r][j].y) | ((unsigned long long)pk2(v[r][j].z, v[r][j].w) << 32); } }
            }
            convert_layer(args, 0, scr, gw, NGW, lane);
        } else if (ph == 10) {
            LAS float* scr = (LAS float*)(lds + RING_OFF + wave * 16384);
            convert_layer(args, 1, scr, gw, NGW, lane);
        } else if (ph == 20) {
            const float* ssf = (const float*)(ws + WS_SSP) + (size_t)5 * 16 * M; const float* g = args.in[13];
            for (int m0 = gw; m0 < M; m0 += 4 * NGW) {
                float part[4]; unsigned long long wv[4][4];
#pragma unroll
                for (int r = 0; r < 4; ++r) { const int m = m0 + r * NGW; part[r] = (lane < 16 && m < M) ? ((const GAS float*)ssf)[(size_t)lane * M + m] : 0.f;
                    const GAS unsigned long long* xi = (const GAS unsigned long long*)(xbA + (size_t)(m < M ? m : 0) * D) + lane;
#pragma unroll
                    for (int j = 0; j < 4; ++j) wv[r][j] = xi[64 * j]; }
#pragma unroll
                for (int r = 0; r < 4; ++r) { const int m = m0 + r * NGW; const float rs = rsqrtf(wave_sum(part[r]) * (1.0f / 1024.0f) + 1e-6f);
                    if (m < M) { GAS f32x4* xr = (GAS f32x4*)(out + (size_t)m * D) + lane; const GAS f32x4* gr = (const GAS f32x4*)g + lane;
#pragma unroll
                        for (int j = 0; j < 4; ++j) { const unsigned lo = (unsigned)wv[r][j], hi = (unsigned)(wv[r][j] >> 32);
                            f32x4 v = (f32x4){__uint_as_float(lo << 16), __uint_as_float(lo & 0xffff0000u), __uint_as_float(hi << 16), __uint_as_float(hi & 0xffff0000u)}; v = v * rs * gr[64 * j]; xr[64 * j] = v; } } }
            }
        } else if (s == 1 || s == 8) {
            pg8::Gemm g{s == 1 ? xbA : xbB, Wb + (s == 1 ? WO_F1IN : WO_F2IN), M, 2 * FF, D};
            pg8::StaticOrder S; S.init(M, 2 * FF, G, bx);
            const int kss = 3 * l + (s == 1 ? 0 : 2);
            pg8::EpiSwiGLU E{big, FF, kss == 0 ? (const float*)SS : (const float*)(ws + WS_SSP) + (size_t)(kss - 1) * 16 * M, kss == 0 ? 1 : 16};
            pg8::gemm_phase<pg8::EpiSwiGLU, pg8::StaticOrder, PG8_ALIGN, PG8_SP2>(lds + RING_OFF, g, S, E, wave_s);
        } else if (s == 3) {
            const int N = l == 0 ? HYB : SBW;
            pg8::Gemm g{xbB, Wb + WO_MIXIN, M, N, D};
            pg8::StaticOrder S; S.init(M, N, G, bx);
            pg8::EpiScaleBf16 E{big, N, (const float*)(ws + WS_SSP) + (size_t)(3 * l) * 16 * M, 16};
            pg8::gemm_phase<pg8::EpiScaleBf16, pg8::StaticOrder, PG8_ALIGN, PG8_SP2>(lds + RING_OFF, g, S, E, wave_s);
        } else if (s == 2 || s == 7 || s == 9) {
            const bf16* A = s == 7 ? xbA : big; const int K = s == 7 ? D : FF;
            const bf16* Bt = Wb + (s == 2 ? WO_F1OUT : s == 7 ? WO_MIXOUT : WO_F2OUT);
            const float* base32 = (l == 0 && s == 2) ? args.in[0] : nullptr; const bf16* baseb = s == 2 ? xbA : xbB;
            bf16* xbo = s == 9 ? xbA : xbB; float* ssn = (float*)(ws + WS_SSP) + (size_t)(3 * l + (s == 2 ? 0 : s == 7 ? 1 : 2)) * 16 * M;
            pg8::Gemm g{A, Bt, M, D, K};
            pg8::StaticOrder S; S.init(M, D, G, bx);
            pg8::EpiResid E{base32, baseb, xbo, ssn, s == 7 ? 1.0f : 0.5f};
            pg8::gemm_phase<pg8::EpiResid, pg8::StaticOrder, PG8_ALIGN, PG8_SP2>(lds + RING_OFF, g, S, E, wave_s);
        } else if (l == 0) {
            const float* rc = (const float*)(ws + WS_TAB); const float* rs = rc + SEQ * 32; const float* dc = rs + SEQ * 32; const float* ds = dc + SEQ * 8;
            float* kv = (float*)(ws + WS_KV); bf16* St = (bf16*)(ws + WS_ST); bf16* part = (bf16*)out;     float* lsep = (float*)(ws + WS_LSE);
            if (s == 4) { for (int u = bx; u < 1024; u += G) mix::ret_kv_unit(u, big, rc, rs, kv, lds, tid); }
            else if (s == 5) {
                for (int chain = bx * 512 + tid; chain < 65536; chain += G * 512) mix::ret_scan(chain, kv, St);
                for (int u = bx; u < 2048; u += G) mix::dil_unit(u, big, dc, ds, part, lsep, xbA, lds, tid);
            } else {
                for (int v = bx; v < 2048; v += G) { if (v < 1024) mix::ret_out_unit(v, big, rc, rs, St, args.in[9], xbA, lds, tid); else mix::dil_unit(v + 1024, big, dc, ds, part, lsep, xbA, lds, tid); }
            }
        } else {
            for (int u = bx; u < 2048; u += G) mix::sb_unit(u, big, xbA, lds, tid);
        }
        if (ph + 1 < args.ph_hi) { if (args.li != 0) cooperative_groups::this_grid().sync(); else xcd_barrier(bar); }
    }
}
extern "C" void kernel_launch(void* const* d_in, const int* in_sizes, int n_in, void* d_out, int out_size, void* d_ws, size_t ws_size, hipStream_t stream) {
    static int grid = 0;
    if (grid == 0) {
        int dev = 0, cus = 0, per_cu = 0;
        hipGetDevice(&dev); hipDeviceGetAttribute(&cus, hipDeviceAttributeMultiprocessorCount, dev);
        if (hipFuncSetAttribute((const void*)mega, hipFuncAttributeMaxDynamicSharedMemorySize, LDS_BYTES) != hipSuccess) { fprintf(stderr, "kernel_launch: hipFuncSetAttribute failed\n"); grid = -1; return; }
        if (hipOccupancyMaxActiveBlocksPerMultiprocessor(&per_cu, (const void*)mega, NWAVES * 64, LDS_BYTES) != hipSuccess || per_cu < 1) per_cu = 1;
        (void)hipGetLastError();
        grid = (cus > 0 ? cus : 256) * 1;
    }
    if (grid < 0) return;
    hipMemsetAsync((char*)d_ws + WS_CTL, 0, CTL_ZERO_BYTES, stream);
    Args a{};
    for (int i = 0; i < 14; ++i) a.in[i] = (const float*)d_in[i];
    a.out = (float*)d_out; a.ws = (unsigned char*)d_ws; a.ph_lo = 0; a.ph_hi = 21; a.li = 0; a.mask = 0;
    void* kargs[] = {&a};
    hipError_t e = hipLaunchCooperativeKernel((const void*)mega, dim3(grid), dim3(NWAVES * 64), kargs, LDS_BYTES, stream);
    if (e != hipSuccess) fprintf(stderr, "kernel_launch: cooperative launch failed: %s (grid %d)\n", hipGetErrorString(e), grid);
}
```

```cpp
#include <hip/hip_runtime.h>
#include <hip/hip_cooperative_groups.h>
#include <cstdio>
#include <cstdint>
__device__ __forceinline__ int mk_lane() { int z = 0; asm volatile("" : "+s"(z)); return (int)__builtin_amdgcn_mbcnt_hi(~0u, __builtin_amdgcn_mbcnt_lo(~0u, (unsigned)z)); }
#define MK_LANE() mk_lane()
namespace pg8 {
#define PG8_LAS __attribute__((address_space(3)))
typedef unsigned short bf16_t;
typedef short bf16x8 __attribute__((ext_vector_type(8)));
typedef float f32x4 __attribute__((ext_vector_type(4)));
typedef unsigned u32x4 __attribute__((ext_vector_type(4)));
constexpr int BM = 256, BK = 64, HALF = 128, HTB = HALF * BK * 2  , STAGE_BYTES = 8 * HTB, NXCD = 8, WGM = 8;

__host__ __device__ __forceinline__ int lds_byte(int r, int c) { const int st = (r >> 4) * 2 + (c >> 5), rr = r & 15, cc = c & 31, ob = rr * 64 + cc * 2; return st * 1024 + (ob ^ (((ob >> 9) & 1) << 5)); }
__host__ __device__ __forceinline__ void stage_rc(int b, int& R, int& C) { const int st = b / 1024, sb = b % 1024, swz = sb ^ (((sb >> 9) & 1) << 5); R = (st >> 1) * 16 + swz / 64; C = (st & 1) * 32 + (swz % 64) / 2; }
__host__ __device__ __forceinline__ int perm32(int rho) { const int n = rho >> 4, i = rho & 15; return 8 * (i >> 2) + 4 * n + (i & 3); }

struct Unit { int pm, pn; };
struct Gemm { const bf16_t* A; const bf16_t* Bt; int M, N, K; };

struct StaticOrder {
    int nM, nN, nwg, G, c;
    __host__ __device__ void init(int M, int N, int G_, int c_) { nM = M / BM; nN = N / BM; nwg = nM * nN; G = G_; c = c_; }
    __host__ __device__ bool next(int i, Unit& u) const {
        const long L = (long)i * G + c; if (L >= nwg) return false;
        int wgid = (int)L; { const int q = nwg / NXCD, r = nwg % NXCD, xcd = wgid % NXCD, off = wgid / NXCD; wgid = (xcd < r ? xcd * (q + 1) : r * (q + 1) + (xcd - r) * q) + off; }
        const int nig = WGM * nN, gid = wgid / nig, fm = gid * WGM, gsz = (nM - fm) < WGM ? (nM - fm) : WGM;
        u.pm = fm + ((wgid % nig) % gsz); u.pn = (wgid % nig) / gsz; return true;
    }
    __device__ __forceinline__ void a_ready(const Unit&) const {}
    __device__ __forceinline__ void done(const Unit&) const {}
};

__device__ __forceinline__ unsigned cvt_pk_bf16(float lo, float hi) { unsigned r; asm volatile("v_cvt_pk_bf16_f32 %0, %1, %2" : "=v"(r) : "v"(lo), "v"(hi)); return r; }
typedef float f32x2 __attribute__((ext_vector_type(2)));
__device__ __forceinline__ f32x2 gelu_pk(f32x2 v) {
    const f32x2 av = __builtin_elementwise_abs(v), d = av * 0.2316418882f + 1.0f;
    f32x2 t; t.x = __builtin_amdgcn_rcpf(d.x); t.y = __builtin_amdgcn_rcpf(d.y);
    f32x2 q = t * 0.5307027145f + (-0.7265760135f); q = q * t + 0.7107068705f; q = q * t + (-0.142248368f); q = q * t + 0.127414796f; q = q * t;
    const f32x2 s = (v * v) * (-0.72134752044f);
    f32x2 e; e.x = __builtin_amdgcn_exp2f(s.x); e.y = __builtin_amdgcn_exp2f(s.y);
    const f32x2 m = v * (q * e), r = v - m;
    f32x2 o; o.x = v.x < 0.f ? m.x : r.x; o.y = v.y < 0.f ? m.y : r.y; return o;
}

template <int ACT  > struct EpiBf16 {
    static constexpr bool PERM = true, AFTER_DRAIN = false; static_assert(ACT == 0 || ACT == 1, "EpiBf16: ACT is 0 (none) or 1 (gelu_pk)");
    bf16_t* O; int ldc; const float* bias; int split_cols; size_t split_stride; float scale0;
    __device__ __forceinline__ void operator()(const f32x4 (&acc)[2][2][4][2], const Unit& u, int wr, int wc, int fr, int fq) const {
        const int row0 = u.pm * BM + wr * 64 + fr; int colt = u.pn * BM; bf16_t* base = O;
        float sc = 1.f; if (split_cols) { const int t = colt / split_cols; base += (size_t)t * split_stride; colt -= t * split_cols; if (t == 0) sc = scale0; }
        const int col0 = colt + wc * 32 + 8 * fq, bcol0 = u.pn * BM + wc * 32 + 8 * fq;
        f32x4 bv[2][2];
#pragma unroll
        for (int bj = 0; bj < 2; ++bj)
#pragma unroll
            for (int n = 0; n < 2; ++n) bv[bj][n] = bias ? *(const f32x4*)(bias + bcol0 + bj * HALF + 4 * n) : (f32x4){0.f, 0.f, 0.f, 0.f};
#pragma unroll
        for (int ai = 0; ai < 2; ++ai)
#pragma unroll
            for (int m = 0; m < 4; ++m) { bf16_t* rowp = base + (size_t)(row0 + ai * HALF + m * 16) * ldc + col0;
#pragma unroll
                for (int bj = 0; bj < 2; ++bj) { f32x4 v0 = acc[ai][bj][m][0] + bv[bj][0], v1 = acc[ai][bj][m][1] + bv[bj][1];
                    if (ACT == 1) { f32x2 a = gelu_pk((f32x2){v0[0], v0[1]}), b = gelu_pk((f32x2){v0[2], v0[3]}), c = gelu_pk((f32x2){v1[0], v1[1]}), d = gelu_pk((f32x2){v1[2], v1[3]});
                        v0 = (f32x4){a.x, a.y, b.x, b.y}; v1 = (f32x4){c.x, c.y, d.x, d.y}; }
                    v0 = v0 * sc; v1 = v1 * sc; u32x4 w; w.x = cvt_pk_bf16(v0[0], v0[1]); w.y = cvt_pk_bf16(v0[2], v0[3]); w.z = cvt_pk_bf16(v1[0], v1[1]); w.w = cvt_pk_bf16(v1[2], v1[3]);
                    *(u32x4*)(rowp + bj * HALF) = w; } }
    }
};

struct PanelStats {
    unsigned* xbuf;
    unsigned* cnt;
    unsigned* tmo;
    int ntn; float eps;
    unsigned code;
    __device__ __forceinline__ bool run(const f32x4 (&v)[2][2][4][2], const Unit& u, int wr, int wc, int fr, int fq, PG8_LAS unsigned char* lds, int wid, int lane) const {
        typedef float f32x2v __attribute__((ext_vector_type(2)));
        PG8_LAS f32x2v* P = (PG8_LAS f32x2v*)lds;
        PG8_LAS f32x2v* S = (PG8_LAS f32x2v*)(lds + 8192);
        PG8_LAS unsigned* flag = (PG8_LAS unsigned*)(lds + 8192 + 2048);
#pragma unroll
        for (int ai = 0; ai < 2; ++ai)
#pragma unroll
            for (int m = 0; m < 4; ++m) {
                float s = 0.f;
#pragma unroll
                for (int bj = 0; bj < 2; ++bj)
#pragma unroll
                    for (int n = 0; n < 2; ++n) { const f32x4 x = v[ai][bj][m][n]; s += (x[0] + x[1]) + (x[2] + x[3]); }
                s += __shfl_xor(s, 16); s += __shfl_xor(s, 32);
                const float mw = s * (1.0f / 64.0f); float q = 0.f;
#pragma unroll
                for (int bj = 0; bj < 2; ++bj)
#pragma unroll
                    for (int n = 0; n < 2; ++n) { const f32x4 d = v[ai][bj][m][n] - mw; q += (d[0] * d[0] + d[1] * d[1]) + (d[2] * d[2] + d[3] * d[3]); }
                q += __shfl_xor(q, 16); q += __shfl_xor(q, 32);
                if (fq == 0) P[(ai * HALF + wr * 64 + m * 16 + fr) * 4 + wc] = (f32x2v){mw, q};
            }
        asm volatile("s_waitcnt lgkmcnt(0)" ::: "memory"); __builtin_amdgcn_s_barrier(); asm volatile("" ::: "memory");
#if defined(BROKEN_EXCHANGE_NO_WAIT)
#warning BROKEN CONTROL BUILD: the row-statistics exchange does not wait; results are wrong by design
        if (blockIdx.x >= 64) { const long long t0_ = clock64(); while (clock64() - t0_ < 60000) __builtin_amdgcn_s_sleep(8); }
#endif
        const int row = wid * 32 + (lane & 31);
        if (lane < 32) {
            const f32x2v a = P[row * 4 + 0], b = P[row * 4 + 1], c = P[row * 4 + 2], d = P[row * 4 + 3];
            const float mt = (a.x + b.x + c.x + d.x) * 0.25f;
            const float da = a.x - mt, db = b.x - mt, dc = c.x - mt, dd = d.x - mt;
            const float m2 = (a.y + b.y) + (c.y + d.y) + 64.0f * ((da * da + db * db) + (dc * dc + dd * dd));
            unsigned long long* slot = (unsigned long long*)xbuf + ((size_t)(u.pm * BM + row) * 4 + u.pn);
            __hip_atomic_store(slot, ((unsigned long long)__float_as_uint(m2) << 32) | __float_as_uint(mt), __ATOMIC_RELAXED, __HIP_MEMORY_SCOPE_AGENT);
        }
        asm volatile("s_waitcnt vmcnt(0)" ::: "memory");
        if (lane == 0) __hip_atomic_fetch_add(cnt + 64 * u.pm, 1u, __ATOMIC_RELAXED, __HIP_MEMORY_SCOPE_AGENT);
        if (wid == 0) {
            bool dead = false; const unsigned long long t0 = __builtin_amdgcn_s_memrealtime(); const unsigned want = 8u * (unsigned)ntn;
            for (;;) {
#if defined(BROKEN_EXCHANGE_NO_WAIT)
                break;
#endif
                if ((unsigned)__builtin_amdgcn_readfirstlane(__hip_atomic_load(cnt + 64 * u.pm, __ATOMIC_RELAXED, __HIP_MEMORY_SCOPE_AGENT)) >= want) break;
                if (__builtin_amdgcn_s_memrealtime() - t0 > 2000000ull) {
                    if (lane == 0) { unsigned expect = 0u; __hip_atomic_compare_exchange_strong(tmo + 1, &expect, code | (unsigned)(u.pm & 0xff), __ATOMIC_RELAXED, __ATOMIC_RELAXED, __HIP_MEMORY_SCOPE_AGENT);
                                     __hip_atomic_store(tmo, 1u, __ATOMIC_RELAXED, __HIP_MEMORY_SCOPE_AGENT); }
                    dead = true; break; }
                __builtin_amdgcn_s_sleep(2);
            }
            __builtin_amdgcn_fence(__ATOMIC_ACQUIRE, "agent");
            if (lane == 0) flag[0] = dead ? 1u : 0u;
        }
        asm volatile("s_waitcnt vmcnt(0) lgkmcnt(0)" ::: "memory"); __builtin_amdgcn_s_barrier(); asm volatile("" ::: "memory");
        const bool bad = flag[0] != 0u;
        if (lane < 32) {
            const unsigned long long* slot = (const unsigned long long*)xbuf + (size_t)(u.pm * BM + row) * 4; float mt[4], m2[4]; float ms = 0.f;
#pragma unroll
            for (int t = 0; t < 4; ++t) { if (t < ntn) { const unsigned long long w = __hip_atomic_load(slot + t, __ATOMIC_RELAXED, __HIP_MEMORY_SCOPE_AGENT); mt[t] = __uint_as_float((unsigned)w); m2[t] = __uint_as_float((unsigned)(w >> 32)); } else { mt[t] = 0.f; m2[t] = 0.f; } ms += mt[t]; }
            const float mean = ms / (float)ntn; float q = 0.f;
#pragma unroll
            for (int t = 0; t < 4; ++t) if (t < ntn) { const float dm = mt[t] - mean; q += m2[t] + 256.0f * dm * dm; }
            S[row] = (f32x2v){mean, 1.0f / sqrtf(q / (256.0f * (float)ntn) + eps)};
        }
        asm volatile("s_waitcnt lgkmcnt(0)" ::: "memory"); __builtin_amdgcn_s_barrier(); asm volatile("" ::: "memory");
        return bad;
    }
};
struct EpiLnRes {
    static constexpr bool PERM = false, AFTER_DRAIN = true;
    const float* base; float* out; int ldc; const float* bias; PanelStats st; unsigned poison;
    __device__ __forceinline__ void fused(f32x4 (&acc)[2][2][4][2], const Unit& u, int wr, int wc, int fr, int fq, PG8_LAS unsigned char* lds, int wid, int lane) const {
        typedef float f32x2v __attribute__((ext_vector_type(2)));
        const PG8_LAS f32x2v* S = (const PG8_LAS f32x2v*)(lds + 8192);
        const int col0 = u.pn * BM + wc * 32 + 4 * fq;
#pragma unroll
        for (int bj = 0; bj < 2; ++bj)
#pragma unroll
            for (int n = 0; n < 2; ++n) { const f32x4 bv = bias ? *(const f32x4*)(bias + col0 + bj * HALF + n * 16) : (f32x4){0.f, 0.f, 0.f, 0.f};
#pragma unroll
                for (int ai = 0; ai < 2; ++ai)
#pragma unroll
                    for (int m = 0; m < 4; ++m) acc[ai][bj][m][n] += bv; }
        f32x4 pre[4][2][2];
#pragma unroll
        for (int m = 0; m < 4; ++m) { const size_t off = (size_t)(u.pm * BM + wr * 64 + m * 16 + fr) * ldc + col0;
#pragma unroll
            for (int bj = 0; bj < 2; ++bj)
#pragma unroll
                for (int n = 0; n < 2; ++n) pre[m][bj][n] = *(const f32x4*)(base + off + bj * HALF + n * 16); }
        const bool bad = st.run(acc, u, wr, wc, fr, fq, lds, wid, lane) || poison != 0u;
        const float qnan = __builtin_nanf("");
#pragma unroll
        for (int ai = 0; ai < 2; ++ai)
#pragma unroll
            for (int m = 0; m < 4; ++m) { const int r = ai * HALF + wr * 64 + m * 16 + fr; const f32x2v sr = S[r]; const size_t off = (size_t)(u.pm * BM + r) * ldc + col0;
#pragma unroll
                for (int bj = 0; bj < 2; ++bj)
#pragma unroll
                    for (int n = 0; n < 2; ++n) { const f32x4 bs = ai == 0 ? pre[m][bj][n] : *(const f32x4*)(base + off + bj * HALF + n * 16); f32x4 o = bs + (acc[ai][bj][m][n] - sr.x) * sr.y;
                        if (bad) o = (f32x4){qnan, qnan, qnan, qnan}; *(f32x4*)(out + off + bj * HALF + n * 16) = o; }
                if (m & 1) asm volatile("" ::: "memory"); }
    }
};
struct EpiLnResLn {
    static constexpr bool PERM = false, AFTER_DRAIN = true;
    const float* base; float* out; bf16_t* xn; int ldc; const float* bias; PanelStats st1, st2; unsigned poison;
    __device__ __forceinline__ void fused(f32x4 (&acc)[2][2][4][2], const Unit& u, int wr, int wc, int fr, int fq, PG8_LAS unsigned char* lds, int wid, int lane) const {
        typedef float f32x2v __attribute__((ext_vector_type(2))); typedef unsigned u32x2v __attribute__((ext_vector_type(2)));
        const PG8_LAS f32x2v* S = (const PG8_LAS f32x2v*)(lds + 8192);
        const int col0 = u.pn * BM + wc * 32 + 4 * fq;
#pragma unroll
        for (int bj = 0; bj < 2; ++bj)
#pragma unroll
            for (int n = 0; n < 2; ++n) { const f32x4 bv = bias ? *(const f32x4*)(bias + col0 + bj * HALF + n * 16) : (f32x4){0.f, 0.f, 0.f, 0.f};
#pragma unroll
                for (int ai = 0; ai < 2; ++ai)
#pragma unroll
                    for (int m = 0; m < 4; ++m) acc[ai][bj][m][n] += bv; }
        bool bad = st1.run(acc, u, wr, wc, fr, fq, lds, wid, lane) || poison != 0u;
        const float qnan = __builtin_nanf("");
#pragma unroll
        for (int ai = 0; ai < 2; ++ai)
#pragma unroll
            for (int m = 0; m < 4; ++m) { const int r = ai * HALF + wr * 64 + m * 16 + fr; const f32x2v sr = S[r]; const size_t off = (size_t)(u.pm * BM + r) * ldc + col0;
#pragma unroll
                for (int bj = 0; bj < 2; ++bj)
#pragma unroll
                    for (int n = 0; n < 2; ++n) { const f32x4 bs = *(const f32x4*)(base + off + bj * HALF + n * 16); acc[ai][bj][m][n] = bs + (acc[ai][bj][m][n] - sr.x) * sr.y; }
                asm volatile("" : "+v"(acc[ai][0][m][0]), "+v"(acc[ai][0][m][1]), "+v"(acc[ai][1][m][0]), "+v"(acc[ai][1][m][1]));
                if (m & 1) asm volatile("" ::: "memory"); }
        const bool bad1 = bad;
        bad = st2.run(acc, u, wr, wc, fr, fq, lds, wid, lane) || bad;
#pragma unroll
        for (int ai = 0; ai < 2; ++ai)
#pragma unroll
            for (int m = 0; m < 4; ++m) { const int r = ai * HALF + wr * 64 + m * 16 + fr; const f32x2v sr = S[r]; const size_t off = (size_t)(u.pm * BM + r) * ldc + col0;
#pragma unroll
                for (int bj = 0; bj < 2; ++bj)
#pragma unroll
                    for (int n = 0; n < 2; ++n) { const f32x4 x1 = acc[ai][bj][m][n]; *(f32x4*)(out + off + bj * HALF + n * 16) = bad1 ? (f32x4){qnan, qnan, qnan, qnan} : x1;
                        const f32x4 o = (x1 - sr.x) * sr.y; u32x2v w; w.x = cvt_pk_bf16(o[0], o[1]); w.y = cvt_pk_bf16(o[2], o[3]);
                        if (bad) { w.x = 0x7fc07fc0u; w.y = 0x7fc07fc0u; } *(u32x2v*)(xn + off + bj * HALF + n * 16) = w; }
                asm volatile("" ::: "memory"); }
    }
};

template <class Epi, class Sched, bool ALIGN_EPI = false, bool SP2 = false>
__device__ __forceinline__ void gemm_phase(PG8_LAS unsigned char* lds, const Gemm g, const Sched& S, const Epi& E, const int wave_s  ) {
    int tid_ = wave_s * 64 + MK_LANE(); asm volatile("" : "+v"(tid_));
    const int tid = tid_, wid = __builtin_amdgcn_readfirstlane(tid >> 6), lane = tid & 63, wr = wid >> 2, wc = wid & 3, fr = lane & 15, fq = lane >> 4;
    const int K = g.K, nt = K / BK;
    unsigned voffA[2], voffB[2];
#pragma unroll
    for (int i = 0; i < 2; ++i) { int R, C; stage_rc(tid * 16 + i * 8192, R, C); const int Rb = Epi::PERM ? ((R & ~31) + perm32(R & 31)) : R;
        voffA[i] = (unsigned)(R * K + C) * 2u; voffB[i] = (unsigned)(Rb * K + C) * 2u; }
    const size_t kstep = (size_t)(BK * 2);
    const size_t hstep = (size_t)HALF * K * 2;
    const size_t tstep = 2 * hstep;
    const unsigned ldsw = (unsigned)wid * 1024u;
    const int aoff = lds_byte(wr * 64 + fr, fq * 8), boff = lds_byte(wc * 32 + fr, fq * 8);
#define PG8_SA(b, h) (((b) * 2 + (h)) * HTB)
#define PG8_SB(b, h) ((4 + (b) * 2 + (h)) * HTB)
#define PG8_STAGE(bufoff, gbase, voff) do { _Pragma("unroll") for (int _i = 0; _i < 2; ++_i) \
        __builtin_amdgcn_global_load_lds((const unsigned*)((const char*)(gbase) + (voff)[_i]), (PG8_LAS unsigned*)(lds + (bufoff) + ldsw + _i * 8192), 16, 0, 0); } while (0)
#define PG8_LDA(dst, b, h) do { _Pragma("unroll") for (int m = 0; m < 4; ++m) _Pragma("unroll") for (int k = 0; k < 2; ++k) dst[m][k] = *(const PG8_LAS bf16x8*)(lds + PG8_SA(b, h) + aoff + m * 2048 + k * 1024); } while (0)
#define PG8_LDB(dst, b, h) do { _Pragma("unroll") for (int n = 0; n < 2; ++n) _Pragma("unroll") for (int k = 0; k < 2; ++k) dst[n][k] = *(const PG8_LAS bf16x8*)(lds + PG8_SB(b, h) + boff + n * 2048 + k * 1024); } while (0)
#define PG8_MMA(ai, bj, At, Bt) do { __builtin_amdgcn_s_setprio(1); _Pragma("unroll") for (int m = 0; m < 4; ++m) _Pragma("unroll") for (int n = 0; n < 2; ++n) _Pragma("unroll") for (int k = 0; k < 2; ++k) \
        acc[ai][bj][m][n] = __builtin_amdgcn_mfma_f32_16x16x32_bf16(Bt[n][k], At[m][k], acc[ai][bj][m][n], 0, 0, 0); __builtin_amdgcn_s_setprio(0); } while (0)
#define PG8_WAIT_V(n) asm volatile("s_waitcnt vmcnt(" #n ")" ::: "memory")
#define PG8_WAIT_L(n) asm volatile("s_waitcnt lgkmcnt(" #n ")" ::: "memory")
#define PG8_BAR __builtin_amdgcn_s_barrier()
#define PG8_SCHED __builtin_amdgcn_sched_barrier(0)
    Unit cur, nxt; int ui = 0;
    if (!S.next(0, cur)) return;
    f32x4 acc[2][2][4][2];
#pragma unroll
    for (int a = 0; a < 2; ++a)
#pragma unroll
        for (int b = 0; b < 2; ++b)
#pragma unroll
            for (int m = 0; m < 4; ++m)
#pragma unroll
                for (int n = 0; n < 2; ++n) acc[a][b][m][n] = (f32x4){0.f, 0.f, 0.f, 0.f};
    bf16x8 At[4][2], B0[2][2], B1[2][2];
    const char* cA = (const char*)g.A + (size_t)cur.pm * tstep; const char* cB = (const char*)g.Bt + (size_t)cur.pn * tstep;
    S.a_ready(cur);
    if constexpr (SP2) {
        PG8_STAGE(PG8_SB(0, 0), cB, voffB); PG8_STAGE(PG8_SB(0, 1), cB + hstep, voffB); PG8_STAGE(PG8_SA(0, 0), cA, voffA); PG8_STAGE(PG8_SA(0, 1), cA + hstep, voffA);
        if (wr == 1) PG8_BAR;
        PG8_WAIT_V(2); PG8_BAR;
        PG8_STAGE(PG8_SB(1, 0), cB + kstep, voffB); PG8_STAGE(PG8_SA(1, 0), cA + kstep, voffA); PG8_STAGE(PG8_SB(1, 1), cB + hstep + kstep, voffB);
        PG8_WAIT_V(6); PG8_BAR;
    } else {
        PG8_STAGE(PG8_SB(0, 0), cB, voffB); PG8_STAGE(PG8_SA(0, 0), cA, voffA); PG8_STAGE(PG8_SB(0, 1), cB + hstep, voffB); PG8_STAGE(PG8_SA(0, 1), cA + hstep, voffA);
        if (wr == 1) PG8_BAR;
        PG8_WAIT_V(4); PG8_BAR;
        PG8_STAGE(PG8_SB(1, 0), cB + kstep, voffB); PG8_STAGE(PG8_SA(1, 0), cA + kstep, voffA); PG8_STAGE(PG8_SB(1, 1), cB + hstep + kstep, voffB);
        PG8_WAIT_V(6); PG8_BAR;
    }
    for (;;) {
        const bool has_next = S.next(ui + 1, nxt);
        const char* nA = has_next ? (const char*)g.A + (size_t)nxt.pm * tstep : cA; const char* nB = has_next ? (const char*)g.Bt + (size_t)nxt.pn * tstep : cB;
        for (int t = 0; t < nt; t += 2) {
            const bool last = (t == nt - 2);
            const char* a1 = cA + (size_t)(t + 1) * kstep;
            const char* a2 = last ? nA : cA + (size_t)(t + 2) * kstep; const char* b2 = last ? nB : cB + (size_t)(t + 2) * kstep;
            const char* a3 = a2 + kstep; const char* b3 = b2 + kstep;
            if (last && has_next) S.a_ready(nxt);
            if constexpr (SP2) {
            PG8_LDB(B0, 0, 0); PG8_LDB(B1, 0, 1); PG8_SCHED; PG8_LDA(At, 0, 0); PG8_STAGE(PG8_SA(1, 1), a1 + hstep, voffA);
            PG8_WAIT_V(8); PG8_WAIT_L(0); PG8_BAR; PG8_MMA(0, 0, At, B0); PG8_MMA(0, 1, At, B1); PG8_BAR; PG8_SCHED;
            PG8_LDA(At, 0, 1); PG8_STAGE(PG8_SB(0, 0), b2, voffB); PG8_STAGE(PG8_SB(0, 1), b2 + hstep, voffB); PG8_STAGE(PG8_SA(0, 0), a2, voffA);
            PG8_WAIT_V(8); PG8_WAIT_L(0); PG8_BAR; PG8_MMA(1, 0, At, B0); PG8_MMA(1, 1, At, B1); PG8_BAR; PG8_SCHED;
            PG8_LDB(B0, 1, 0); PG8_LDB(B1, 1, 1); PG8_SCHED; PG8_LDA(At, 1, 0); PG8_STAGE(PG8_SA(0, 1), a2 + hstep, voffA);
            PG8_WAIT_V(8); PG8_WAIT_L(0); PG8_BAR; PG8_MMA(0, 0, At, B0); PG8_MMA(0, 1, At, B1); PG8_BAR; PG8_SCHED;
            PG8_LDA(At, 1, 1); PG8_STAGE(PG8_SB(1, 0), b3, voffB); PG8_STAGE(PG8_SB(1, 1), b3 + hstep, voffB); PG8_STAGE(PG8_SA(1, 0), a3, voffA);
            PG8_WAIT_V(8); PG8_WAIT_L(0); PG8_BAR; PG8_MMA(1, 0, At, B0); PG8_MMA(1, 1, At, B1); PG8_BAR; PG8_SCHED;
            } else {
            PG8_LDB(B0, 0, 0); PG8_SCHED; PG8_LDA(At, 0, 0); PG8_STAGE(PG8_SA(1, 1), a1 + hstep, voffA);
            PG8_WAIT_L(8); PG8_BAR; PG8_WAIT_L(0); PG8_MMA(0, 0, At, B0); PG8_BAR; PG8_SCHED;
            PG8_LDB(B1, 0, 1); PG8_STAGE(PG8_SB(0, 0), b2, voffB);
            PG8_BAR; PG8_WAIT_L(0); PG8_MMA(0, 1, At, B1); PG8_BAR;
            PG8_LDA(At, 0, 1); PG8_STAGE(PG8_SA(0, 0), a2, voffA);
            PG8_BAR; PG8_WAIT_L(0); PG8_MMA(1, 0, At, B0); PG8_BAR; PG8_SCHED;
            PG8_STAGE(PG8_SB(0, 1), b2 + hstep, voffB);
            PG8_WAIT_V(6); PG8_BAR; PG8_MMA(1, 1, At, B1); PG8_BAR;
            PG8_LDB(B0, 1, 0); PG8_SCHED; PG8_LDA(At, 1, 0); PG8_STAGE(PG8_SA(0, 1), a2 + hstep, voffA);
            PG8_WAIT_L(8); PG8_BAR; PG8_WAIT_L(0); PG8_MMA(0, 0, At, B0); PG8_BAR; PG8_SCHED;
            PG8_LDB(B1, 1, 1); PG8_STAGE(PG8_SB(1, 0), b3, voffB);
            PG8_BAR; PG8_WAIT_L(0); PG8_MMA(0, 1, At, B1); PG8_BAR;
            PG8_LDA(At, 1, 1); PG8_STAGE(PG8_SA(1, 0), a3, voffA);
            PG8_BAR; PG8_WAIT_L(0); PG8_MMA(1, 0, At, B0); PG8_BAR; PG8_SCHED;
            PG8_STAGE(PG8_SB(1, 1), b3 + hstep, voffB);
            PG8_WAIT_V(6); PG8_BAR; PG8_MMA(1, 1, At, B1); PG8_BAR;
            }
        }
        if constexpr (ALIGN_EPI) { if (wr == 0) PG8_BAR; }
        if constexpr (!Epi::AFTER_DRAIN) { E(acc, cur, wr, wc, fr, fq); S.done(cur); }
        if (!has_next) break;
#pragma unroll
        for (int a = 0; a < 2; ++a)
#pragma unroll
            for (int b = 0; b < 2; ++b)
#pragma unroll
                for (int m = 0; m < 4; ++m)
#pragma unroll
                    for (int n = 0; n < 2; ++n) acc[a][b][m][n] = (f32x4){0.f, 0.f, 0.f, 0.f};
        cur = nxt; cA = nA; cB = nB; ++ui;
        if constexpr (ALIGN_EPI) { if (wr == 1) PG8_BAR; }
    }
    PG8_WAIT_V(0);
    if constexpr (!ALIGN_EPI) { if (wr == 0) PG8_BAR; }
    PG8_BAR;
    if constexpr (Epi::AFTER_DRAIN) { E.fused(acc, cur, wr, wc, fr, fq, lds, wid, lane); S.done(cur); }
#undef PG8_SA
#undef PG8_SB
#undef PG8_STAGE
#undef PG8_LDA
#undef PG8_LDB
#undef PG8_MMA
#undef PG8_WAIT_V
#undef PG8_WAIT_L
#undef PG8_BAR
#undef PG8_SCHED
}
}

#ifndef PG8_SP2
#define PG8_SP2 true
#endif
#ifndef PG8_ALIGN
#define PG8_ALIGN true
#endif
namespace pg8 {
typedef unsigned u32x2 __attribute__((ext_vector_type(2)));
#define PG8_GAS __attribute__((address_space(1)))
constexpr float RMS_EPS = 1e-6f;
constexpr int SS_ROWS = 16384;
__device__ __forceinline__ void row_rs8(float (&rs)[8], const float* ssp, int npart, int row0, int fq) {
    const PG8_GAS float* sp = (const PG8_GAS float*)ssp; float pr[8][4];
#pragma unroll
    for (int r = 0; r < 8; ++r)
#pragma unroll
        for (int i = 0; i < 4; ++i) { const int j = fq * 4 + i; pr[r][i] = sp[(size_t)(j < npart ? j : 0) * SS_ROWS + row0 + (r >> 2) * HALF + (r & 3) * 16]; }
#pragma unroll
    for (int r = 0; r < 8; ++r) { float s = 0.f;
#pragma unroll
        for (int i = 0; i < 4; ++i) s += (fq * 4 + i < npart) ? pr[r][i] : 0.f;
        s += __shfl_xor(s, 16); s += __shfl_xor(s, 32);
        rs[r] = rsqrtf(s * (1.0f / 1024.0f) + RMS_EPS); }
}
struct EpiSwiGLU {
    static constexpr bool PERM = true, AFTER_DRAIN = false;
    bf16_t* O; int ldc; const float* ss; int npart;
    __device__ __forceinline__ void operator()(const f32x4 (&acc)[2][2][4][2], const Unit& u, int wr, int wc, int fr, int fq) const {
        const int row0 = u.pm * BM + wr * 64 + fr, col0 = u.pn * HALF + wc * 32 + 8 * fq;
        float rsv[8]; row_rs8(rsv, ss, npart, row0, fq);
#pragma unroll
        for (int ai = 0; ai < 2; ++ai)
#pragma unroll
            for (int m = 0; m < 4; ++m) {
                const int row = row0 + ai * HALF + m * 16; const float rs = rsv[ai * 4 + m];
                float h[8];
#pragma unroll
                for (int n = 0; n < 2; ++n)
#pragma unroll
                    for (int i = 0; i < 4; ++i) { const float g = acc[ai][0][m][n][i] * rs, up = acc[ai][1][m][n][i] * rs; h[n * 4 + i] = g * __builtin_amdgcn_rcpf(1.0f + __expf(-g)) * up; }
                u32x4 w; w.x = cvt_pk_bf16(h[0], h[1]); w.y = cvt_pk_bf16(h[2], h[3]); w.z = cvt_pk_bf16(h[4], h[5]); w.w = cvt_pk_bf16(h[6], h[7]);
                *(PG8_GAS u32x4*)(O + (size_t)row * ldc + col0) = w;
            }
    }
};
struct EpiScaleBf16 {
    static constexpr bool PERM = true, AFTER_DRAIN = false;
    bf16_t* O; int ldc; const float* ss; int npart;
    __device__ __forceinline__ void operator()(const f32x4 (&acc)[2][2][4][2], const Unit& u, int wr, int wc, int fr, int fq) const {
        const int row0 = u.pm * BM + wr * 64 + fr, col0 = u.pn * BM + wc * 32 + 8 * fq;
        float rsv[8]; row_rs8(rsv, ss, npart, row0, fq);
#pragma unroll
        for (int ai = 0; ai < 2; ++ai)
#pragma unroll
            for (int m = 0; m < 4; ++m) {
                const int row = row0 + ai * HALF + m * 16; const float rs = rsv[ai * 4 + m];
#pragma unroll
                for (int bj = 0; bj < 2; ++bj) { const f32x4 v0 = acc[ai][bj][m][0] * rs, v1 = acc[ai][bj][m][1] * rs;
                    u32x4 w; w.x = cvt_pk_bf16(v0[0], v0[1]); w.y = cvt_pk_bf16(v0[2], v0[3]); w.z = cvt_pk_bf16(v1[0], v1[1]); w.w = cvt_pk_bf16(v1[2], v1[3]);
                    *(PG8_GAS u32x4*)(O + (size_t)row * ldc + col0 + bj * HALF) = w; }
            }
    }
};
struct EpiResid {
    static constexpr bool PERM = false, AFTER_DRAIN = false;
    const float* base32; const bf16_t* baseb; bf16_t* xb; float* ssn; float scale;
    __device__ __forceinline__ void operator()(const f32x4 (&acc)[2][2][4][2], const Unit& u, int wr, int wc, int fr, int fq) const {
        const int col0 = u.pn * BM + wc * 32 + 4 * fq;
#pragma unroll
        for (int ai = 0; ai < 2; ++ai) {
            f32x4 b[4][2][2];
            if (base32) {
#pragma unroll
                for (int m = 0; m < 4; ++m) { const size_t off = (size_t)(u.pm * BM + ai * HALF + wr * 64 + m * 16 + fr) * 1024 + col0;
#pragma unroll
                    for (int bj = 0; bj < 2; ++bj)
#pragma unroll
                        for (int n = 0; n < 2; ++n) b[m][bj][n] = *(const PG8_GAS f32x4*)(base32 + off + bj * HALF + n * 16); }
            } else {
                u32x2 w[4][2][2];
#pragma unroll
                for (int m = 0; m < 4; ++m) { const size_t off = (size_t)(u.pm * BM + ai * HALF + wr * 64 + m * 16 + fr) * 1024 + col0;
#pragma unroll
                    for (int bj = 0; bj < 2; ++bj)
#pragma unroll
                        for (int n = 0; n < 2; ++n) w[m][bj][n] = *(const PG8_GAS u32x2*)(baseb + off + bj * HALF + n * 16); }
#pragma unroll
                for (int m = 0; m < 4; ++m)
#pragma unroll
                    for (int bj = 0; bj < 2; ++bj)
#pragma unroll
                        for (int n = 0; n < 2; ++n) { const u32x2 x = w[m][bj][n]; b[m][bj][n] = (f32x4){__uint_as_float(x.x << 16), __uint_as_float(x.x & 0xffff0000u), __uint_as_float(x.y << 16), __uint_as_float(x.y & 0xffff0000u)}; }
            }
#pragma unroll
            for (int m = 0; m < 4; ++m) {
                const int row = u.pm * BM + ai * HALF + wr * 64 + m * 16 + fr; const size_t off = (size_t)row * 1024 + col0; float s = 0.f;
#pragma unroll
                for (int bj = 0; bj < 2; ++bj)
#pragma unroll
                    for (int n = 0; n < 2; ++n) { const f32x4 v = b[m][bj][n] + acc[ai][bj][m][n] * scale; s += (v[0] * v[0] + v[1] * v[1]) + (v[2] * v[2] + v[3] * v[3]);
                        u32x2 w2; w2.x = cvt_pk_bf16(v[0], v[1]); w2.y = cvt_pk_bf16(v[2], v[3]); *(PG8_GAS u32x2*)(xb + off + bj * HALF + n * 16) = w2; }
                s += __shfl_xor(s, 16); s += __shfl_xor(s, 32);
                if (fq == 0) ((PG8_GAS float*)ssn)[(size_t)(u.pn * 4 + wc) * SS_ROWS + row] = s;
            }
        }
    }
};
}
#define GAS __attribute__((address_space(1)))
#define LAS __attribute__((address_space(3)))
typedef unsigned short bf16;
typedef unsigned v4u __attribute__((ext_vector_type(4)));
typedef float f32x4 __attribute__((ext_vector_type(4)));
typedef short bf16x8 __attribute__((ext_vector_type(8)));
typedef GAS unsigned gu32;
typedef GAS unsigned long long gu64;
#define RLX_AGENT __ATOMIC_RELAXED, __HIP_MEMORY_SCOPE_AGENT
#define LDS_WAIT() asm volatile("s_waitcnt lgkmcnt(0)" ::: "memory")
#define VM_WAIT() asm volatile("s_waitcnt vmcnt(0)" ::: "memory")
__device__ __forceinline__ unsigned long long rt() { return __builtin_amdgcn_s_memrealtime(); }
__device__ __forceinline__ unsigned f2bf(float f) { unsigned u = __builtin_bit_cast(unsigned, f); return (u + 0x7fffu + ((u >> 16) & 1u)) >> 16; }
__device__ __forceinline__ unsigned pk2(float lo, float hi) { return f2bf(lo) | (f2bf(hi) << 16); }

#define XB_TMO      128
#define XB_XCNT(j)  (256  + 64 * (j))
#define XB_XSUB(j)  (1280 + 64 * (j))
#define XB_XGEN(j)  (2304 + 64 * (j))
#define XB_TOP      3328
#define XB_TOPGEN   3392
#define XCD_BAR_WORDS 3456
#define XB_SPIN_CAP (1u << 18)

__device__ __forceinline__ unsigned xb_ld(unsigned* p)              { return __hip_atomic_load(p, __ATOMIC_RELAXED, __HIP_MEMORY_SCOPE_AGENT); }
__device__ __forceinline__ unsigned xb_add(unsigned* p, unsigned v) { return __hip_atomic_fetch_add(p, v, __ATOMIC_RELAXED, __HIP_MEMORY_SCOPE_AGENT); }
__device__ __forceinline__ unsigned xb_xcc_id() { return (unsigned)__builtin_amdgcn_s_getreg((3 << 11) | 20) & 0xFu; }
#define XB_SPIN(cond, bar) do { unsigned _sp = 0; while (cond) { __builtin_amdgcn_s_sleep(1); \
    if ((++_sp & 255u) == 0u) { if (xb_ld(&(bar)[XB_TMO])) break; if (_sp > XB_SPIN_CAP) { atomicAdd(&(bar)[XB_TMO], 1u); break; } } } } while (0)

struct XcdBarrier {
    unsigned* bar; unsigned x; bool w0;
    volatile LAS unsigned* st;
};

__device__ __forceinline__ XcdBarrier xcd_barrier_post(unsigned* bar, volatile LAS unsigned* st, int wave_s) {
    XcdBarrier b; b.bar = bar; b.x = xb_xcc_id(); b.st = st; b.w0 = wave_s == 0;
    if (wave_s == 0 && MK_LANE() == 0) (void)xb_add(&bar[XB_XCNT(b.x)], 1u);
    return b;
}
__device__ __forceinline__ void xcd_barrier_complete(unsigned* bar, unsigned x, unsigned& nloc, unsigned& nx) {
    const unsigned G = gridDim.x * gridDim.y * gridDim.z;
    unsigned sum, cnt, mine, sp = 0u;
    for (;;) {
        sum = 0u; cnt = 0u; mine = 0u;
#pragma unroll
        for (unsigned j = 0; j < 16; ++j) { const unsigned c = xb_ld(&bar[XB_XCNT(j)]); sum += c; cnt += (c > 0u) ? 1u : 0u; mine = (j == x) ? c : mine; }
        if (sum == G) break;
        __builtin_amdgcn_s_sleep(1);
        if ((++sp & 255u) == 0u) { if (xb_ld(&bar[XB_TMO])) break; if (sp > XB_SPIN_CAP) { atomicAdd(&bar[XB_TMO], 1u); break; } }
    }
    nloc = mine > 0u ? mine : 1u; nx = cnt > 0u ? cnt : 1u;
}

__device__ __forceinline__ void xcd_barrier(const XcdBarrier& b) {
    asm volatile("s_waitcnt vmcnt(0)" ::: "memory");
    __syncthreads();
    if (b.w0 && MK_LANE() == 0) {
        unsigned* bar = b.bar;
        __builtin_amdgcn_s_waitcnt(0);
        unsigned nloc = b.st[0], nx = b.st[1];
        if (nloc == 0u) { xcd_barrier_complete(bar, b.x, nloc, nx); b.st[0] = nloc; b.st[1] = nx; }
        const unsigned old = xb_add(&bar[XB_XSUB(b.x)], 1u);
        const unsigned gen = old / nloc;
        if (old + 1u == (gen + 1u) * nloc) {
            __builtin_amdgcn_fence(__ATOMIC_RELEASE, "agent");
            asm volatile("s_waitcnt vmcnt(0)" ::: "memory");
            const unsigned og = xb_add(&bar[XB_TOP], 1u);
            const unsigned tg = og / nx;
            if (og + 1u == (tg + 1u) * nx) xb_add(&bar[XB_TOPGEN], 1u);
            else XB_SPIN(xb_ld(&bar[XB_TOPGEN]) == tg, bar);
            __builtin_amdgcn_fence(__ATOMIC_ACQUIRE, "agent");
            xb_add(&bar[XB_XGEN(b.x)], 1u);
            asm volatile("s_waitcnt vmcnt(0)" ::: "memory");
        } else {
            XB_SPIN(xb_ld(&bar[XB_XGEN(b.x)]) == gen, bar);
            __builtin_amdgcn_fence(__ATOMIC_ACQUIRE, "agent");
            asm volatile("s_waitcnt vmcnt(0)" ::: "memory");
        }
    }
    __syncthreads();
}
constexpr int NWAVES = 8;
constexpr int BATCH = 2, SEQ = 8192, D = 1024, M = BATCH * SEQ, FF = 2816, HD = 64, HYB = 3584, SBW = 3072;
constexpr size_t MiB = 1u << 20;
constexpr size_t WS_CTL = 0, CTL_ZERO_BYTES = 1 * MiB;
constexpr size_t WS_W = 1 * MiB;
constexpr size_t WS_XBA = 43 * MiB, WS_XBB = 75 * MiB;
constexpr size_t WS_BIG = 107 * MiB;
constexpr size_t WS_KV = 219 * MiB;
constexpr size_t WS_ST = 235 * MiB;
constexpr size_t WS_TAB = 243 * MiB;
constexpr size_t WS_SS = 246 * MiB;
constexpr size_t WS_LSE = 247 * MiB;
constexpr size_t WS_SSP = 248 * MiB;
constexpr size_t WO_F1IN = 0, WO_F1OUT = 5767168, WO_MIXIN = 8650752, WO_MIXOUT = 12320768, WO_F2IN = 13369344, WO_F2OUT = 19136512;
constexpr int CW_BAR = 4096;
constexpr int RING_OFF = 0, RING_BYTES = 131072, LDSCTL_OFF = RING_BYTES, MISC_OFF = LDSCTL_OFF + 320, LDS_BYTES = 147456;

__device__ __forceinline__ float wave_sum(float v) {
#pragma unroll
    for (int o = 1; o < 64; o <<= 1) v += __shfl_xor(v, o);
    return v;
}
__device__ __forceinline__ float bf2f(bf16 v) { return __uint_as_float(((unsigned)v) << 16); }

__device__ __forceinline__ void transpose_item(const float* W, const float* gain, int K, int N, bf16* WT, int dest_row0, int k0, int n0, LAS float* scr, int lane) {
    float wv[32];
#pragma unroll
    for (int i = 0; i < 32; ++i) wv[i] = ((const GAS float*)W)[(size_t)(k0 + 2 * i + (lane >> 5)) * N + n0 + (lane & 31)];
    float gk[32];
    if (gain) {
#pragma unroll
        for (int i = 0; i < 32; ++i) gk[i] = ((const GAS float*)gain)[k0 + 2 * i + (lane >> 5)];
    } else {
#pragma unroll
        for (int i = 0; i < 32; ++i) gk[i] = 1.0f;
    }
#pragma unroll
    for (int i = 0; i < 32; ++i) { const int kk = 2 * i + (lane >> 5); scr[kk * 33 + (lane & 31)] = wv[i] * gk[i]; }
    LDS_WAIT(); asm volatile("" ::: "memory");
    const int c = lane & 7;
#pragma unroll
    for (int j = 0; j < 4; ++j) { const int n = (lane >> 3) + 8 * j; const LAS float* s = scr + (8 * c) * 33 + n;
        v4u o; o.x = pk2(s[0 * 33], s[1 * 33]); o.y = pk2(s[2 * 33], s[3 * 33]); o.z = pk2(s[4 * 33], s[5 * 33]); o.w = pk2(s[6 * 33], s[7 * 33]);
        *(GAS v4u*)(WT + (size_t)(dest_row0 + n) * K + k0 + 8 * c) = o; }
    LDS_WAIT(); asm volatile("" ::: "memory");
}
struct Args { const float* in[14]; float* out; unsigned char* ws; int ph_lo, ph_hi, li, mask; };

__device__ __forceinline__ void convert_layer(const Args& a, int l, int sel, LAS float* scr, int gw, int NGW, int lane) {
    bf16* Wb = (bf16*)(a.ws + WS_W);
    const int mixN = l == 0 ? HYB : SBW;
    const int I_IN = (D / 64) * (2 * FF / 32), I_OUT = (FF / 64) * (D / 32), I_MI = (D / 64) * (mixN / 32), I_MO = (D / 64) * (D / 32);
    const int NITEMS = sel == 0 ? 2 * I_IN + 2 * I_OUT + I_MI + I_MO : (sel == 3 ? I_MI + I_MO : I_IN + I_OUT);
    for (int it = gw; it < NITEMS; it += NGW) {
        int r = it, mat;
        if (sel == 0) { if (r < I_IN) mat = 0; else if ((r -= I_IN) < I_IN) mat = 1; else if ((r -= I_IN) < I_OUT) mat = 2; else if ((r -= I_OUT) < I_OUT) mat = 3; else if ((r -= I_OUT) < I_MI) mat = 4; else { r -= I_MI; mat = 5; } }
        else if (sel == 3) { if (r < I_MI) mat = 4; else { r -= I_MI; mat = 5; } }
        else { if (r < I_IN) mat = sel == 1 ? 0 : 1; else { r -= I_IN; mat = sel == 1 ? 2 : 3; } }
        const float* W; const float* gain = nullptr; int K, N; bf16* WT; bool swi = false;
        if (mat == 0) { W = a.in[2] + (size_t)l * D * 2 * FF; gain = a.in[1] + l * D; K = D; N = 2 * FF; WT = Wb + WO_F1IN; swi = true; }
        else if (mat == 1) { W = a.in[6] + (size_t)l * D * 2 * FF; gain = a.in[5] + l * D; K = D; N = 2 * FF; WT = Wb + WO_F2IN; swi = true; }
        else if (mat == 2) { W = a.in[3] + (size_t)l * FF * D; K = FF; N = D; WT = Wb + WO_F1OUT; }
        else if (mat == 3) { W = a.in[7] + (size_t)l * FF * D; K = FF; N = D; WT = Wb + WO_F2OUT; }
        else if (mat == 4) { W = l == 0 ? a.in[8] : a.in[11]; gain = a.in[4] + l * D; K = D; N = mixN; WT = Wb + WO_MIXIN; }
        else { W = l == 0 ? a.in[10] : a.in[12]; K = D; N = D; WT = Wb + WO_MIXOUT; }
        const int nblk = N / 32, kb = r / nblk, nb = r % nblk, n0 = 32 * nb; int dest = n0;
        if (swi) { const int up = n0 >= FF ? 1 : 0, j0 = n0 - up * FF; dest = (j0 / 128) * 256 + up * 128 + (j0 % 128); }
        transpose_item(W, gain, K, N, WT, dest, 64 * kb, n0, scr, lane);
    }
}
namespace mix {
typedef short bfx8 __attribute__((ext_vector_type(8)));
typedef unsigned u32x2v __attribute__((ext_vector_type(2)));
typedef unsigned short u16;
#define MFMA16(a, b, c) __builtin_amdgcn_mfma_f32_16x16x32_bf16(a, b, c, 0, 0, 0)
constexpr int QP = 72;
constexpr int OFF_Q = 0, OFF_K = 18432, OFF_V = 55296, OFF_FLAG = 90112;
constexpr int VP1 = 140, VP2 = 268;
constexpr float LOG2E = 1.4426950408889634f, LN2 = 0.6931471805599453f;

__device__ __forceinline__ float bfe(const v4u& a, int e) { return __uint_as_float((e & 1) ? (a[e >> 1] & 0xffff0000u) : (a[e >> 1] << 16)); }
typedef float f32x2_t __attribute__((ext_vector_type(2))); typedef __bf16 bf16x2_t __attribute__((ext_vector_type(2)));
__device__ __forceinline__ unsigned pkbf(float lo, float hi) { const f32x2_t v = {lo, hi}; const bf16x2_t b = __builtin_convertvector(v, bf16x2_t); return __builtin_bit_cast(unsigned, b); }
__device__ __forceinline__ bfx8 pack8(const f32x4& p0, const f32x4& p1) { v4u w; w.x = pkbf(p0[0], p0[1]); w.y = pkbf(p0[2], p0[3]); w.z = pkbf(p1[0], p1[1]); w.w = pkbf(p1[2], p1[3]); return __builtin_bit_cast(bfx8, w); }

template <int MODE>
__device__ __forceinline__ void stage_rows(LAS bf16* dst, const bf16* src, size_t rowStride, int nrows, int pos0, int posStride, const float* ctab, const float* stab, int tid) {
    for (int it = tid; it < nrows * 4; it += 512) {
        const int row = it >> 2, c = it & 3; const bf16* p = src + (size_t)row * rowStride;
        v4u a = *(const GAS v4u*)(p + 8 * c), b = *(const GAS v4u*)(p + 32 + 8 * c);
        if (MODE == 1) {
            const int pos = pos0 + row * posStride; const GAS f32x4* ct = (const GAS f32x4*)(ctab + pos * 32 + 8 * c); const GAS f32x4* sn = (const GAS f32x4*)(stab + pos * 32 + 8 * c);
            const f32x4 c0 = ct[0], c1 = ct[1], s0 = sn[0], s1 = sn[1]; float y1[8], y2[8];
#pragma unroll
            for (int e = 0; e < 8; ++e) { const float cs = e < 4 ? c0[e & 3] : c1[e & 3], si = e < 4 ? s0[e & 3] : s1[e & 3]; const float x1 = bfe(a, e), x2 = bfe(b, e); y1[e] = x1 * cs - x2 * si; y2[e] = x2 * cs + x1 * si; }
            a.x = pkbf(y1[0], y1[1]); a.y = pkbf(y1[2], y1[3]); a.z = pkbf(y1[4], y1[5]); a.w = pkbf(y1[6], y1[7]);
            b.x = pkbf(y2[0], y2[1]); b.y = pkbf(y2[2], y2[3]); b.z = pkbf(y2[4], y2[5]); b.w = pkbf(y2[6], y2[7]);
        }
        if (MODE == 2) {
            v4u o; o.x = __shfl_xor(a.x, 1); o.y = __shfl_xor(a.y, 1); o.z = __shfl_xor(a.z, 1); o.w = __shfl_xor(a.w, 1);
            if (c < 2) {
                const int pos = pos0 + row * posStride; const GAS f32x4* ct = (const GAS f32x4*)(ctab + pos * 8); const GAS f32x4* sn = (const GAS f32x4*)(stab + pos * 8);
                const f32x4 c0 = ct[0], c1 = ct[1], s0 = sn[0], s1 = sn[1]; float y[8];
#pragma unroll
                for (int e = 0; e < 8; ++e) { const float cs = e < 4 ? c0[e & 3] : c1[e & 3], si = e < 4 ? s0[e & 3] : s1[e & 3]; const float xo = bfe(a, e), xp = bfe(o, e); y[e] = c == 0 ? (xo * cs - xp * si) : (xo * cs + xp * si); }
                a.x = pkbf(y[0], y[1]); a.y = pkbf(y[2], y[3]); a.z = pkbf(y[4], y[5]); a.w = pkbf(y[6], y[7]);
            }
        }
        *(LAS v4u*)(dst + row * QP + 8 * c) = a; *(LAS v4u*)(dst + row * QP + 32 + 8 * c) = b;
    }
}
__device__ __forceinline__ void stage_vt(LAS bf16* dst, int pitch, int key_off, const bf16* src, size_t rowStride, int tid) {
    for (int it = tid; it < 128 * 8; it += 512) {
        const int key = it & 127, c = it >> 7; const v4u a = *(const GAS v4u*)(src + (size_t)key * rowStride + 8 * c);
#pragma unroll
        for (int e = 0; e < 8; ++e) dst[(8 * c + e) * pitch + key_off + key] = (bf16)((e & 1) ? (a[e >> 1] >> 16) : (a[e >> 1] & 0xffffu));
    }
}
struct RR { v4u a, b; };
struct TT { f32x4 c0, c1, s0, s1; };
struct VV { v4u v0, v1; };
__device__ __forceinline__ void ld_rows(RR& r, const bf16* src, size_t rowStride, int tid) { const bf16* p = src + (size_t)(tid >> 2) * rowStride + 8 * (tid & 3); r.a = *(const GAS v4u*)p; r.b = *(const GAS v4u*)(p + 32); }
__device__ __forceinline__ void st_rows(LAS bf16* dst, const RR& r, int tid) { LAS bf16* q = dst + (tid >> 2) * QP + 8 * (tid & 3); *(LAS v4u*)q = r.a; *(LAS v4u*)(q + 32) = r.b; }
__device__ __forceinline__ void ld_tab(TT& t, const float* ctab, const float* stab, int idx) { const GAS f32x4* ct = (const GAS f32x4*)(ctab + idx); const GAS f32x4* sn = (const GAS f32x4*)(stab + idx); t.c0 = ct[0]; t.c1 = ct[1]; t.s0 = sn[0]; t.s1 = sn[1]; }
__device__ __forceinline__ void rot1(RR& r, const TT& t) {
    float y1[8], y2[8];
#pragma unroll
    for (int e = 0; e < 8; ++e) { const float cs = e < 4 ? t.c0[e & 3] : t.c1[e & 3], si = e < 4 ? t.s0[e & 3] : t.s1[e & 3]; const float x1 = bfe(r.a, e), x2 = bfe(r.b, e); y1[e] = x1 * cs - x2 * si; y2[e] = x2 * cs + x1 * si; }
    r.a.x = pkbf(y1[0], y1[1]); r.a.y = pkbf(y1[2], y1[3]); r.a.z = pkbf(y1[4], y1[5]); r.a.w = pkbf(y1[6], y1[7]);
    r.b.x = pkbf(y2[0], y2[1]); r.b.y = pkbf(y2[2], y2[3]); r.b.z = pkbf(y2[4], y2[5]); r.b.w = pkbf(y2[6], y2[7]);
}
__device__ __forceinline__ void rot2(RR& r, const TT& t, int c) {
    v4u o; o.x = __shfl_xor(r.a.x, 1); o.y = __shfl_xor(r.a.y, 1); o.z = __shfl_xor(r.a.z, 1); o.w = __shfl_xor(r.a.w, 1);
    if (c < 2) { float y[8];
#pragma unroll
        for (int e = 0; e < 8; ++e) { const float cs = e < 4 ? t.c0[e & 3] : t.c1[e & 3], si = e < 4 ? t.s0[e & 3] : t.s1[e & 3]; const float xo = bfe(r.a, e), xp = bfe(o, e); y[e] = c == 0 ? (xo * cs - xp * si) : (xo * cs + xp * si); }
        r.a.x = pkbf(y[0], y[1]); r.a.y = pkbf(y[2], y[3]); r.a.z = pkbf(y[4], y[5]); r.a.w = pkbf(y[6], y[7]); }
}
__device__ __forceinline__ void ld_vt(VV& v, const bf16* src, size_t rowStride, int tid) { const int kp = (tid >> 2) & 63, c = ((tid >> 8) << 2) | (tid & 3); const bf16* p = src + (size_t)(2 * kp) * rowStride + 8 * c; v.v0 = *(const GAS v4u*)p; v.v1 = *(const GAS v4u*)(p + rowStride); }
__device__ __forceinline__ void st_vt(LAS bf16* dst, int pitch, int key_off, const VV& v, int tid) { const int kp = (tid >> 2) & 63, c = ((tid >> 8) << 2) | (tid & 3);
#pragma unroll
    for (int e = 0; e < 8; ++e) { const unsigned a = v.v0[e >> 1], b2 = v.v1[e >> 1]; const unsigned wd = (e & 1) ? ((a >> 16) | (b2 & 0xffff0000u)) : ((a & 0xffffu) | (b2 << 16));
        *(LAS unsigned*)(dst + (8 * c + e) * pitch + key_off + 2 * kp) = wd; }
}
__device__ __forceinline__ void stage_kt_ret(LAS bf16* dst, const bf16* src, size_t rowStride, int pos0, const float* ctab, const float* stab, float log2g, int tid) {
    { const int it = tid; const int key = it & 127, c = it >> 7; const bf16* p = src + (size_t)key * rowStride;
        const v4u a = *(const GAS v4u*)(p + 8 * c), b = *(const GAS v4u*)(p + 32 + 8 * c);
        const int pos = pos0 + key; const GAS f32x4* ct = (const GAS f32x4*)(ctab + pos * 32 + 8 * c); const GAS f32x4* sn = (const GAS f32x4*)(stab + pos * 32 + 8 * c);
        const f32x4 c0 = ct[0], c1 = ct[1], s0 = sn[0], s1 = sn[1]; const float kd = 0.125f * exp2f((float)(127 - key) * log2g);
#pragma unroll
        for (int e = 0; e < 8; ++e) { const float cs = e < 4 ? c0[e & 3] : c1[e & 3], si = e < 4 ? s0[e & 3] : s1[e & 3]; const float x1 = bfe(a, e), x2 = bfe(b, e);
            dst[(8 * c + e) * 136 + key] = (bf16)f2bf((x1 * cs - x2 * si) * kd); dst[(32 + 8 * c + e) * 136 + key] = (bf16)f2bf((x2 * cs + x1 * si) * kd); }
    }
}
__device__ __forceinline__ f32x4 st_tile(const LAS bf16* Ks, int T, const bfx8 (&qf)[2], int c16, int g) {
    f32x4 acc = (f32x4){0.f, 0.f, 0.f, 0.f};
#pragma unroll
    for (int ks = 0; ks < 2; ++ks) { const bfx8 a = *(const LAS bfx8*)(Ks + (16 * T + c16) * QP + 32 * ks + 8 * g); acc = MFMA16(a, qf[ks], acc); }
    return acc;
}
__device__ __forceinline__ void st_tiles8(const LAS bf16* Ks, int T0, const bfx8 (&qf)[2], int c16, int g, f32x4 (&out)[8]) {
    bfx8 a[8][2];
#pragma unroll
    for (int T = 0; T < 8; ++T)
#pragma unroll
        for (int ks = 0; ks < 2; ++ks) a[T][ks] = *(const LAS bfx8*)(Ks + (16 * (T0 + T) + c16) * QP + 32 * ks + 8 * g);
#pragma unroll
    for (int T = 0; T < 8; ++T) { f32x4 acc = (f32x4){0.f, 0.f, 0.f, 0.f};
#pragma unroll
        for (int ks = 0; ks < 2; ++ks) acc = MFMA16(a[T][ks], qf[ks], acc);
        out[T] = acc; }
}
__device__ __forceinline__ void pv_pair(f32x4 (&o)[4], const LAS bf16* Vs, int vp, int t0, int t1, const f32x4& p0, const f32x4& p1, int c16, int g) {
    const bfx8 pb = pack8(p0, p1); u32x2v lo[4], hi[4];
#pragma unroll
    for (int dt = 0; dt < 4; ++dt) { lo[dt] = *(const LAS u32x2v*)(Vs + (16 * dt + c16) * vp + 16 * t0 + 4 * g); hi[dt] = *(const LAS u32x2v*)(Vs + (16 * dt + c16) * vp + 16 * t1 + 4 * g); }
#pragma unroll
    for (int dt = 0; dt < 4; ++dt) { v4u av; av.x = lo[dt].x; av.y = lo[dt].y; av.z = hi[dt].x; av.w = hi[dt].y; o[dt] = MFMA16(__builtin_bit_cast(bfx8, av), pb, o[dt]); }
}

__device__ __forceinline__ void ret_kv_unit(int u, const bf16* proj, const float* rc, const float* rs, float* kv, LAS unsigned char* lds, int tid) {
    const int n = u & 63, bh = u >> 6, h = bh & 7, b = bh >> 3; const int lane = tid & 63, w = __builtin_amdgcn_readfirstlane(tid >> 6), c16 = lane & 15, g = lane >> 4;
    const float log2g = log2f(1.0f - exp2f(-5.0f - (float)h));
    const bf16* rowp = proj + (size_t)(b * SEQ + n * 128) * HYB + h * 64;
    LAS bf16* Kt = (LAS bf16*)(lds + OFF_Q); LAS bf16* Vt = (LAS bf16*)(lds + OFF_V);
    { const int key = tid & 127, c = tid >> 7; const bf16* p = rowp + 512 + (size_t)key * HYB;
        const v4u a = *(const GAS v4u*)(p + 8 * c), b2 = *(const GAS v4u*)(p + 32 + 8 * c); TT t; ld_tab(t, rc, rs, (n * 128 + key) * 32 + 8 * c); VV vv; ld_vt(vv, rowp + 1024, HYB, tid);
        const float kd = 0.125f * __builtin_amdgcn_exp2f((float)(127 - key) * log2g);
#pragma unroll
        for (int e = 0; e < 8; ++e) { const float cs = e < 4 ? t.c0[e & 3] : t.c1[e & 3], si = e < 4 ? t.s0[e & 3] : t.s1[e & 3]; const float x1 = bfe(a, e), x2 = bfe(b2, e);
            Kt[(8 * c + e) * 136 + key] = (bf16)f2bf((x1 * cs - x2 * si) * kd); Kt[(32 + 8 * c + e) * 136 + key] = (bf16)f2bf((x2 * cs + x1 * si) * kd); }
        st_vt(Vt, 136, 0, vv, tid); }
    __syncthreads();
    const int dvt = w >> 1;
#pragma unroll
    for (int i = 0; i < 2; ++i) { const int dkt = 2 * (w & 1) + i; f32x4 acc = (f32x4){0.f, 0.f, 0.f, 0.f};
#pragma unroll
        for (int ks = 0; ks < 4; ++ks) { const bfx8 a = *(const LAS bfx8*)(Vt + (16 * dvt + c16) * 136 + 32 * ks + 8 * g), bb = *(const LAS bfx8*)(Kt + (16 * dkt + c16) * 136 + 32 * ks + 8 * g); acc = MFMA16(a, bb, acc); }
        float* o = kv + ((size_t)n * 16 + bh) * 4096;
#pragma unroll
        for (int r = 0; r < 4; ++r) o[(16 * dvt + 4 * g + r) * 64 + 16 * dkt + c16] = acc[r]; }
    __syncthreads();
}
__device__ __forceinline__ void ret_scan(int chain, const float* kv, bf16* St) {
    const int h = (chain >> 12) & 7; const float cd = exp2f(128.0f * log2f(1.0f - exp2f(-5.0f - (float)h)));
    float state = 0.f; const GAS float* kvp = (const GAS float*)kv + chain; GAS bf16* stp = (GAS bf16*)St + chain;
#pragma unroll
    for (int n0 = 0; n0 < 64; n0 += 32) {
        float v[32];
#pragma unroll
        for (int i = 0; i < 32; ++i) v[i] = kvp[(size_t)(n0 + i) * 65536];
#pragma unroll
        for (int i = 0; i < 32; ++i) { stp[(size_t)(n0 + i) * 65536] = (bf16)f2bf(state); state = state * cd + v[i]; }
    }
}
__device__ __forceinline__ void ret_out_unit(int u, const bf16* proj, const float* rc, const float* rs, const bf16* St, const float* gn, bf16* cat, LAS unsigned char* lds, int tid) {
    const int n = u & 63, bh = u >> 6, h = bh & 7, b = bh >> 3; const int lane = tid & 63, w = __builtin_amdgcn_readfirstlane(tid >> 6), c16 = lane & 15, g = lane >> 4;
    const float log2g = log2f(1.0f - exp2f(-5.0f - (float)h));
    const size_t row0 = (size_t)(b * SEQ + n * 128); const bf16* rowp = proj + row0 * HYB + h * 64;
    LAS bf16* Qs = (LAS bf16*)(lds + OFF_Q); LAS bf16* Ks = (LAS bf16*)(lds + OFF_K); LAS bf16* Vs = (LAS bf16*)(lds + OFF_V);
    { RR rq, rk, rst; TT t; VV vv;
        ld_rows(rq, rowp, HYB, tid); ld_rows(rk, rowp + 512, HYB, tid); ld_tab(t, rc, rs, (n * 128 + (tid >> 2)) * 32 + 8 * (tid & 3)); ld_vt(vv, rowp + 1024, HYB, tid);
        if (tid < 256) ld_rows(rst, St + ((size_t)n * 16 + bh) * 4096, 64, tid);
        rot1(rq, t); rot1(rk, t); st_rows(Qs, rq, tid); st_rows(Ks, rk, tid); st_vt(Vs, VP1, 0, vv, tid);
        if (tid < 256) st_rows(Ks + 128 * QP, rst, tid); }
    __syncthreads();
    bfx8 qf[2];
#pragma unroll
    for (int ks = 0; ks < 2; ++ks) qf[ks] = *(const LAS bfx8*)(Qs + (16 * w + c16) * QP + 32 * ks + 8 * g);
    const int qi = 16 * w + c16;
    f32x4 o[4], cr[4];
#pragma unroll
    for (int dt = 0; dt < 4; ++dt) { o[dt] = (f32x4){0.f, 0.f, 0.f, 0.f}; cr[dt] = (f32x4){0.f, 0.f, 0.f, 0.f}; }
#pragma unroll
    for (int tp = 0; tp < 4; ++tp) {
        f32x4 p[2];
#pragma unroll
        for (int i = 0; i < 2; ++i) { const int T = 2 * tp + i; const f32x4 s = st_tile(Ks, T, qf, c16, g);
#pragma unroll
            for (int r = 0; r < 4; ++r) { const int kj = 16 * T + 4 * g + r; const int dd = qi - kj; p[i][r] = dd >= 0 ? s[r] * 0.125f * __builtin_amdgcn_exp2f((float)dd * log2g) : 0.f; } }
        pv_pair(o, Vs, VP1, 2 * tp, 2 * tp + 1, p[0], p[1], c16, g);
    }
#pragma unroll
    for (int dt = 0; dt < 4; ++dt) cr[dt] = st_tile(Ks, 8 + dt, qf, c16, g);
    const float qd = exp2f((float)(qi + 1) * log2g);
    float sum = 0.f;
#pragma unroll
    for (int dt = 0; dt < 4; ++dt) { o[dt] = o[dt] + cr[dt] * qd; sum += (o[dt][0] + o[dt][1]) + (o[dt][2] + o[dt][3]); }
    sum += __shfl_xor(sum, 16); sum += __shfl_xor(sum, 32);
    const float mu = sum * (1.0f / 64.0f); float var = 0.f;
#pragma unroll
    for (int dt = 0; dt < 4; ++dt) { o[dt] = o[dt] - mu; var += (o[dt][0] * o[dt][0] + o[dt][1] * o[dt][1]) + (o[dt][2] * o[dt][2] + o[dt][3] * o[dt][3]); }
    var += __shfl_xor(var, 16); var += __shfl_xor(var, 32);
    const float rstd = rsqrtf(var * (1.0f / 64.0f) + 1e-5f);
    const size_t tok = row0 + qi;
    f32x4 ggv[4]; u32x2v rgv[4];
#pragma unroll
    for (int dt = 0; dt < 4; ++dt) { const int d0 = 16 * dt + 4 * g; ggv[dt] = *(const GAS f32x4*)(gn + h * 64 + d0); rgv[dt] = *(const GAS u32x2v*)(proj + tok * HYB + 1536 + h * 64 + d0); }
#pragma unroll
    for (int dt = 0; dt < 4; ++dt) { const int d0 = 16 * dt + 4 * g; const f32x4 gg = ggv[dt]; const u32x2v rgw = rgv[dt];
        float y[4];
#pragma unroll
        for (int r = 0; r < 4; ++r) { const float gate = __uint_as_float((r & 1) ? (rgw[r >> 1] & 0xffff0000u) : (rgw[r >> 1] << 16)); y[r] = o[dt][r] * rstd * gg[r] * (gate * __builtin_amdgcn_rcpf(1.0f + __expf(-gate))); }
        u32x2v wv; wv.x = pkbf(y[0], y[1]); wv.y = pkbf(y[2], y[3]); *(GAS u32x2v*)(cat + tok * D + h * 64 + d0) = wv; }
    __syncthreads();
}

__device__ __forceinline__ void dil_unit(int u, const bf16* proj, const float* dc, const float* ds, bf16* part, float* lsep, bf16* cat, LAS unsigned char* lds, int tid) {
    const int idx = u & 63, h = (u >> 6) & 7, b = (u >> 9) & 1, p = u >> 10; const int dil = p == 0 ? 1 : (p == 1 ? 4 : 16), nper = 64 / dil, r = idx / nper, nbi = idx % nper;
    const int lane = tid & 63, w = __builtin_amdgcn_readfirstlane(tid >> 6), c16 = lane & 15, g = lane >> 4;
    const bf16* bp = proj + (size_t)b * SEQ * HYB + h * 64; const int t0 = (128 * nbi) * dil + r;
    LAS bf16* Qs = (LAS bf16*)(lds + OFF_Q); LAS bf16* Ks = (LAS bf16*)(lds + OFF_K); LAS bf16* Vs = (LAS bf16*)(lds + OFF_V);
    const size_t rstr = (size_t)dil * HYB;
    { RR rq, rk, rkp; TT t, tp_; VV vv, vvp; const int tp = t0 - 128 * dil, srow = tid >> 2, sc = tid & 3;
        ld_rows(rq, bp + (size_t)t0 * HYB + 2048, rstr, tid); ld_rows(rk, bp + (size_t)t0 * HYB + 2560, rstr, tid); ld_tab(t, dc, ds, (t0 + srow * dil) * 8); ld_vt(vv, bp + (size_t)t0 * HYB + 3072, rstr, tid);
        if (nbi > 0) { ld_rows(rkp, bp + (size_t)tp * HYB + 2560, rstr, tid); ld_tab(tp_, dc, ds, (tp + srow * dil) * 8); ld_vt(vvp, bp + (size_t)tp * HYB + 3072, rstr, tid); }
        rot2(rq, t, sc); rot2(rk, t, sc); st_rows(Qs, rq, tid); st_rows(Ks + 128 * QP, rk, tid); st_vt(Vs, VP2, 128, vv, tid);
        if (nbi > 0) { rot2(rkp, tp_, sc); st_rows(Ks, rkp, tid); st_vt(Vs, VP2, 0, vvp, tid); } }
    __syncthreads();
    bfx8 qf[2];
#pragma unroll
    for (int ks = 0; ks < 2; ++ks) qf[ks] = *(const LAS bfx8*)(Qs + (16 * w + c16) * QP + 32 * ks + 8 * g);
    const int qi = 16 * w + c16; const int Tlo = nbi > 0 ? w : 8, Thi = 8 + w;
    f32x4 s[16]; float m = -INFINITY;
#pragma unroll
    for (int T = 0; T < 16; ++T) { s[T] = (f32x4){-INFINITY, -INFINITY, -INFINITY, -INFINITY};
        if (T >= Tlo && T <= Thi) { const f32x4 a = st_tile(Ks, T, qf, c16, g);
#pragma unroll
            for (int rr = 0; rr < 4; ++rr) { const int kj = 16 * (T & 7) + 4 * g + rr; const bool ok = T < 8 ? (kj >= qi) : (kj <= qi); s[T][rr] = ok ? a[rr] * 0.125f : -INFINITY; m = fmaxf(m, s[T][rr]); } } }
    m = fmaxf(m, __shfl_xor(m, 16)); m = fmaxf(m, __shfl_xor(m, 32));
    float l = 0.f;
#pragma unroll
    for (int T = 0; T < 16; ++T) {
        if (T >= Tlo && T <= Thi) {
#pragma unroll
            for (int rr = 0; rr < 4; ++rr) { const float e = __builtin_amdgcn_exp2f((s[T][rr] - m) * LOG2E); s[T][rr] = e; l += e; }
        } else s[T] = (f32x4){0.f, 0.f, 0.f, 0.f};
    }
    l += __shfl_xor(l, 16); l += __shfl_xor(l, 32);
    f32x4 o[4];
#pragma unroll
    for (int dt = 0; dt < 4; ++dt) o[dt] = (f32x4){0.f, 0.f, 0.f, 0.f};
#pragma unroll
    for (int tp = 0; tp < 8; ++tp) if (2 * tp + 1 >= Tlo && 2 * tp <= Thi) {
        const int ta = 2 * tp, tb = 2 * tp + 1;
        const int ra = ta >= Tlo ? ta : tb, rb = tb <= Thi ? tb : ta;
        pv_pair(o, Vs, VP2, ra, rb, s[ta], s[tb], c16, g);
    }
    const float rl = 1.0f / l, lse = m + __logf(l);
    const size_t tok = (size_t)b * SEQ + t0 + (size_t)qi * dil;
    if (p < 2) {
        if (g == 0) lsep[(size_t)p * M * 8 + tok * 8 + h] = lse;
#pragma unroll
        for (int dt = 0; dt < 4; ++dt) { u32x2v wv; wv.x = pkbf(o[dt][0] * rl, o[dt][1] * rl); wv.y = pkbf(o[dt][2] * rl, o[dt][3] * rl); *(GAS u32x2v*)(part + (size_t)p * M * 512 + tok * 512 + h * 64 + 16 * dt + 4 * g) = wv; }
    } else {
        const float l0 = ((const GAS float*)lsep)[tok * 8 + h], l1 = ((const GAS float*)lsep)[(size_t)M * 8 + tok * 8 + h];
        u32x2v x0v[4], x1v[4];
#pragma unroll
        for (int dt = 0; dt < 4; ++dt) { const int d0 = h * 64 + 16 * dt + 4 * g; x0v[dt] = *(const GAS u32x2v*)(part + tok * 512 + d0); x1v[dt] = *(const GAS u32x2v*)(part + (size_t)M * 512 + tok * 512 + d0); }
        const float mm = fmaxf(lse, fmaxf(l0, l1));
        const float w0 = __expf(l0 - mm), w1 = __expf(l1 - mm), w2 = __expf(lse - mm); const float inv = 1.0f / (w0 + w1 + w2); const float a0 = w0 * inv, a1 = w1 * inv, a2 = w2 * inv * rl;
#pragma unroll
        for (int dt = 0; dt < 4; ++dt) { const int d0 = h * 64 + 16 * dt + 4 * g; const u32x2v x0 = x0v[dt], x1 = x1v[dt]; float y[4];
#pragma unroll
            for (int rr = 0; rr < 4; ++rr) { const float v0 = __uint_as_float((rr & 1) ? (x0[rr >> 1] & 0xffff0000u) : (x0[rr >> 1] << 16)), v1 = __uint_as_float((rr & 1) ? (x1[rr >> 1] & 0xffff0000u) : (x1[rr >> 1] << 16)); y[rr] = a0 * v0 + a1 * v1 + a2 * o[dt][rr]; }
            u32x2v wv; wv.x = pkbf(y[0], y[1]); wv.y = pkbf(y[2], y[3]); *(GAS u32x2v*)(cat + tok * D + 512 + d0) = wv; }
    }
    __syncthreads();
}
}
namespace mix {
__device__ __forceinline__ void sb_unit(int u, const bf16* qkv, bf16* cat, LAS unsigned char* lds, int tid) {
    const int qb = 63 - (u & 63), h = (u >> 6) & 15, b = u >> 10; const int lane = tid & 63, w = __builtin_amdgcn_readfirstlane(tid >> 6), c16 = lane & 15, g = lane >> 4;
    const bf16* bp = qkv + (size_t)b * SEQ * SBW + h * 64;
    LAS bf16* Qs = (LAS bf16*)(lds + OFF_Q); LAS bf16* Ks = (LAS bf16*)(lds + OFF_K); LAS bf16* Vs = (LAS bf16*)(lds + OFF_V); volatile LAS int* flags = (volatile LAS int*)(lds + OFF_FLAG);
    const int qi = 16 * w + c16;
    v4u onesw, tri0w, tri1w;
    {
        unsigned t0e[8], t1e[8];
#pragma unroll
        for (int j = 0; j < 8; ++j) { t0e[j] = j < 4 ? ((4 * g + j > c16) ? 0x3F80u : 0u) : 0x3F80u; t1e[j] = j < 4 ? 0u : ((4 * g + (j - 4) > c16) ? 0x3F80u : 0u); }
        onesw = (v4u){0x3F803F80u, 0x3F803F80u, 0x3F803F80u, 0x3F803F80u};
        tri0w = (v4u){t0e[0] | (t0e[1] << 16), t0e[2] | (t0e[3] << 16), t0e[4] | (t0e[5] << 16), t0e[6] | (t0e[7] << 16)};
        tri1w = (v4u){t1e[0] | (t1e[1] << 16), t1e[2] | (t1e[3] << 16), t1e[4] | (t1e[5] << 16), t1e[6] | (t1e[7] << 16)};
    }
    const bfx8 ones = __builtin_bit_cast(bfx8, onesw), tri0 = __builtin_bit_cast(bfx8, tri0w), tri1 = __builtin_bit_cast(bfx8, tri1w);
    f32x4 o[4];
#pragma unroll
    for (int dt = 0; dt < 4; ++dt) o[dt] = (f32x4){0.f, 0.f, 0.f, 0.f};
    float carry = 0.f;
    bfx8 qf[2];
    const int krow = tid >> 2, kc = tid & 3, vkp = (tid >> 2) & 63, vc = ((tid >> 8) << 2) | (tid & 3);
    v4u ka, kb2, va0, va1;
#define SB_LOAD(blk) do { const bf16* kp_ = bp + (size_t)((blk) * 128 + krow) * SBW + 1024; ka = *(const GAS v4u*)(kp_ + 8 * kc); kb2 = *(const GAS v4u*)(kp_ + 32 + 8 * kc); \
        const bf16* vp_ = bp + (size_t)((blk) * 128 + 2 * vkp) * SBW + 2048 + 8 * vc; va0 = *(const GAS v4u*)vp_; va1 = *(const GAS v4u*)(vp_ + SBW); } while (0)
    SB_LOAD(qb);
    { RR rq; ld_rows(rq, bp + (size_t)(qb * 128) * SBW, SBW, tid); st_rows(Qs, rq, tid); }
    for (int kb = qb; kb >= 0; --kb) {
        *(LAS v4u*)(Ks + krow * QP + 8 * kc) = ka; *(LAS v4u*)(Ks + krow * QP + 32 + 8 * kc) = kb2;
#pragma unroll
        for (int e = 0; e < 8; ++e) { const unsigned a_ = va0[e >> 1], b_ = va1[e >> 1]; *(LAS unsigned*)(Vs + (8 * vc + e) * VP1 + 2 * vkp) = (e & 1) ? ((a_ >> 16) | (b_ & 0xffff0000u)) : ((a_ & 0xffffu) | (b_ << 16)); }
        __syncthreads();
        if (kb > 0) SB_LOAD(kb - 1);
        if (kb == qb) {
#pragma unroll
            for (int ks = 0; ks < 2; ++ks) qf[ks] = *(const LAS bfx8*)(Qs + (16 * w + c16) * QP + 32 * ks + 8 * g);
        }
        const bool diag = kb == qb;
        if (__any(carry >= -104.0f)) {
        f32x4 ls[8], lg[8];
        f32x4 zt[8]; st_tiles8(Ks, 0, qf, c16, g, zt);
#pragma unroll
        for (int T = 0; T < 8; ++T) { const f32x4 a = zt[T];
#pragma unroll
            for (int r = 0; r < 4; ++r) { const int kj = 16 * T + 4 * g + r; const bool ok = !diag || kj < qi; const float z = a[r] * 0.125f;
                const float sp = fmaxf(z, 0.f) + __log2f(1.0f + __builtin_amdgcn_exp2f(-fabsf(z) * LOG2E)) * LN2;
                ls[T][r] = ok ? -sp : 0.f; lg[T][r] = ok ? z - sp : -INFINITY; } }
        float tot[4]; f32x4 later[8];
#pragma unroll
        for (int s = 0; s < 4; ++s) {
            f32x4 hi0, hi1, lo0, lo1;
#pragma unroll
            for (int r = 0; r < 4; ++r) { hi0[r] = __uint_as_float(__float_as_uint(ls[2 * s][r]) & 0xffff0000u); lo0[r] = ls[2 * s][r] - hi0[r]; hi1[r] = __uint_as_float(__float_as_uint(ls[2 * s + 1][r]) & 0xffff0000u); lo1[r] = ls[2 * s + 1][r] - hi1[r]; }
            const bfx8 bh = pack8(hi0, hi1), bl = pack8(lo0, lo1);
            f32x4 t = (f32x4){0.f, 0.f, 0.f, 0.f}; t = MFMA16(ones, bh, t); t = MFMA16(ones, bl, t); tot[s] = t[0];
            f32x4 a0 = (f32x4){0.f, 0.f, 0.f, 0.f}, a1 = (f32x4){0.f, 0.f, 0.f, 0.f};
            a0 = MFMA16(tri0, bh, a0); a0 = MFMA16(tri0, bl, a0); a1 = MFMA16(tri1, bh, a1); a1 = MFMA16(tri1, bl, a1);
            later[2 * s] = a0; later[2 * s + 1] = a1;
        }
        float suf = carry;
#pragma unroll
        for (int s = 3; s >= 0; --s) {
            f32x4 p0, p1;
#pragma unroll
            for (int r = 0; r < 4; ++r) { p0[r] = __builtin_amdgcn_exp2f((lg[2 * s][r] + later[2 * s][r] + suf) * LOG2E); p1[r] = __builtin_amdgcn_exp2f((lg[2 * s + 1][r] + later[2 * s + 1][r] + suf) * LOG2E); }
            pv_pair(o, Vs, VP1, 2 * s, 2 * s + 1, p0, p1, c16, g);
            suf += tot[s];
        }
        carry = suf;
        }
        const int alive = __any(carry >= -104.0f) ? 1 : 0;
        if (lane == 0) flags[w] = alive;
        __syncthreads();
        int any = 0;
#pragma unroll
        for (int i = 0; i < 8; ++i) any |= flags[i];
        if (!any) break;
    }
#undef SB_LOAD
    const size_t tok = (size_t)b * SEQ + qb * 128 + qi;
#pragma unroll
    for (int dt = 0; dt < 4; ++dt) { u32x2v wv; wv.x = pkbf(o[dt][0], o[dt][1]); wv.y = pkbf(o[dt][2], o[dt][3]); *(GAS u32x2v*)(cat + tok * D + h * 64 + 16 * dt + 4 * g) = wv; }
    __syncthreads();
}
}
__global__ void __launch_bounds__(NWAVES * 64, 2) mega(Args args) {
    extern __shared__ __attribute__((aligned(16))) unsigned char lds_raw[];
    LAS unsigned char* lds = (LAS unsigned char*)lds_raw;
    volatile LAS unsigned* MISC = (volatile LAS unsigned*)(lds + MISC_OFF);
    const int G = gridDim.x; const int bx = blockIdx.x;
    const int wave_s = __builtin_amdgcn_readfirstlane((int)threadIdx.x >> 6);
    for (int u = wave_s * 64 + MK_LANE(); u < (LDS_BYTES - LDSCTL_OFF) / 4; u += NWAVES * 64) ((LAS unsigned*)(lds + LDSCTL_OFF))[u] = 0u;
    __syncthreads();
    XcdBarrier bar = xcd_barrier_post((unsigned*)((gu32*)(args.ws + WS_CTL) + CW_BAR) + args.li * XCD_BAR_WORDS, MISC + 8, wave_s);

    for (int ph = args.ph_lo; ph < args.ph_hi; ++ph) {
        int tid = wave_s * 64 + MK_LANE(); asm volatile("" : "+v"(tid));
        unsigned char* ws = args.ws; asm volatile("" : "+s"(ws));
        const int lane = tid & 63, wave = __builtin_amdgcn_readfirstlane(tid >> 6);
        const int vcu = (G % 8 == 0) ? (bx % 8) * (G / 8) + bx / 8 : bx;
        const int gw = vcu * NWAVES + wave, NGW = G * NWAVES;
        bf16* Wb = (bf16*)(ws + WS_W); bf16* xbA = (bf16*)(ws + WS_XBA); bf16* xbB = (bf16*)(ws + WS_XBB); bf16* big = (bf16*)(ws + WS_BIG);
        float* SS = (float*)(ws + WS_SS); float* out = args.out;
        const int l = ph >= 11 ? 1 : 0, s = (ph >= 1 && ph <= 9) ? ph : (ph >= 11 && ph <= 19 ? ph - 10 : 0);
        if (l == 1 && (s == 5 || s == 6)) continue;
        if (ph == 0) {
            LAS float* scr = (LAS float*)(lds + RING_OFF + wave * 16384);
            float* rc = (float*)(ws + WS_TAB); float* rs = rc + SEQ * 32; float* dc = rs + SEQ * 32; float* ds = dc + SEQ * 8;
            for (int idx = gw * 64 + lane; idx < SEQ * 32; idx += NGW * 64) {
                { const int pos = idx / 32, i = idx % 32; const float inv = 1.0f / powf(10000.0f, (float)i / 32.0f); const float ang = (float)pos * inv; rc[idx] = cosf(ang); rs[idx] = sinf(ang); }
                if (idx < SEQ * 8) { const int pos = idx / 8, i = idx % 8; const float inv = 1.0f / powf(500000.0f, (float)i / 8.0f); const float ang = (float)pos * inv; dc[idx] = cosf(ang); ds[idx] = sinf(ang); }
            }
            for (int m0 = gw; m0 < M; m0 += 2 * NGW) {
                f32x4 v[2][4];
#pragma unroll
                for (int r = 0; r < 2; ++r) { const int m = m0 + r * NGW < M ? m0 + r * NGW : m0; const GAS f32x4* xr = (const GAS f32x4*)(args.in[0] + (size_t)m * D) + lane;
#pragma unroll
                    for (int j = 0; j < 4; ++j) v[r][j] = xr[64 * j]; }
#pragma unroll
                for (int r = 0; r < 2; ++r) { const int m = m0 + r * NGW; if (m < M) { float sq = 0.f;
#pragma unroll
                    for (int j = 0; j < 4; ++j) sq += (v[r][j].x * v[r][j].x + v[r][j].y * v[r][j].y) + (v[r][j].z * v[r][j].z + v[r][j].w * v[r][j].w);
                    sq = wave_sum(sq); if (lane == 0) SS[m] = sq;
                    GAS unsigned long long* o8 = (GAS unsigned long long*)(xbA + (size_t)m * D) + lane;
#pragma unroll
                    for (int j = 0; j < 4; ++j) o8[64 * j] = (unsigned long long)pk2(v[r][j].x, v[r][j].y) | ((unsigned long long)pk2(v[r][j].z, v[r][j].w) << 32); } }
            }
            convert_layer(args, 0, 0, scr, gw, NGW, lane);
        } else if (ph == 10) {
            LAS float* scr = (LAS float*)(lds + RING_OFF + wave * 16384);
            if ((1408 % G) == 0) convert_layer(args, 1, 0, scr, gw, NGW, lane);
            else convert_layer(args, 1, 3, scr, gw, NGW, lane);
        } else if (ph == 20) {
            const float* ssf = (const float*)(ws + WS_SSP) + (size_t)5 * 16 * M; const float* g = args.in[13];
            f32x4 gv[4];
#pragma unroll
            for (int j = 0; j < 4; ++j) gv[j] = ((const GAS f32x4*)g + lane)[64 * j];
            for (int m0 = gw; m0 < M; m0 += 4 * NGW) {
                float part[4]; unsigned long long wv[4][4];
#pragma unroll
                for (int r = 0; r < 4; ++r) { const int m = m0 + r * NGW; part[r] = (lane < 16 && m < M) ? ((const GAS float*)ssf)[(size_t)lane * M + m] : 0.f;
                    const GAS unsigned long long* xi = (const GAS unsigned long long*)(xbA + (size_t)(m < M ? m : 0) * D) + lane;
#pragma unroll
                    for (int j = 0; j < 4; ++j) wv[r][j] = xi[64 * j]; }
#pragma unroll
                for (int r = 0; r < 4; ++r) { const int m = m0 + r * NGW; const float rs = rsqrtf(wave_sum(part[r]) * (1.0f / 1024.0f) + 1e-6f);
                    if (m < M) { GAS f32x4* xr = (GAS f32x4*)(out + (size_t)m * D) + lane;
#pragma unroll
                        for (int j = 0; j < 4; ++j) { const unsigned lo = (unsigned)wv[r][j], hi = (unsigned)(wv[r][j] >> 32);
                            f32x4 v = (f32x4){__uint_as_float(lo << 16), __uint_as_float(lo & 0xffff0000u), __uint_as_float(hi << 16), __uint_as_float(hi & 0xffff0000u)}; v = v * rs * gv[j]; xr[64 * j] = v; } } }
            }
        } else if (s == 1 || s == 8) {
            pg8::Gemm g{s == 1 ? xbA : xbB, Wb + (s == 1 ? WO_F1IN : WO_F2IN), M, 2 * FF, D};
            pg8::StaticOrder S; S.init(M, 2 * FF, G, bx);
            const int kss = 3 * l + (s == 1 ? 0 : 2);
            pg8::EpiSwiGLU E{big, FF, kss == 0 ? (const float*)SS : (const float*)(ws + WS_SSP) + (size_t)(kss - 1) * 16 * M, kss == 0 ? 1 : 16};
            pg8::gemm_phase<pg8::EpiSwiGLU, pg8::StaticOrder, PG8_ALIGN, PG8_SP2>(lds + RING_OFF, g, S, E, wave_s);
            {
                const int nwg = (M / 256) * (2 * FF / 256), rem = nwg % G;
                if (rem != 0 && bx >= rem && ((l == 0 && s == 8) || (l == 1 && s == 1))) {
                    LAS float* scr = (LAS float*)(lds + RING_OFF + wave * 16384);
                    convert_layer(args, 1, l == 0 ? 1 : 2, scr, (bx - rem) * NWAVES + wave, (G - rem) * NWAVES, lane);
                }
            }
        } else if (s == 3) {
            const int N = l == 0 ? HYB : SBW;
            pg8::Gemm g{xbB, Wb + WO_MIXIN, M, N, D};
            pg8::StaticOrder S; S.init(M, N, G, bx);
            pg8::EpiScaleBf16 E{big, N, (const float*)(ws + WS_SSP) + (size_t)(3 * l) * 16 * M, 16};
            pg8::gemm_phase<pg8::EpiScaleBf16, pg8::StaticOrder, PG8_ALIGN, PG8_SP2>(lds + RING_OFF, g, S, E, wave_s);
        } else if (s == 2 || s == 7 || s == 9) {
            const bf16* A = s == 7 ? xbA : big; const int K = s == 7 ? D : FF;
            const bf16* Bt = Wb + (s == 2 ? WO_F1OUT : s == 7 ? WO_MIXOUT : WO_F2OUT);
            const float* base32 = (l == 0 && s == 2) ? args.in[0] : nullptr; const bf16* baseb = s == 2 ? xbA : xbB;
            bf16* xbo = s == 9 ? xbA : xbB; float* ssn = (float*)(ws + WS_SSP) + (size_t)(3 * l + (s == 2 ? 0 : s == 7 ? 1 : 2)) * 16 * M;
            pg8::Gemm g{A, Bt, M, D, K};
            pg8::StaticOrder S; S.init(M, D, G, bx);
            pg8::EpiResid E{base32, baseb, xbo, ssn, s == 7 ? 1.0f : 0.5f};
            pg8::gemm_phase<pg8::EpiResid, pg8::StaticOrder, PG8_ALIGN, PG8_SP2>(lds + RING_OFF, g, S, E, wave_s);
        } else if (l == 0) {
            const float* rc = (const float*)(ws + WS_TAB); const float* rs = rc + SEQ * 32; const float* dc = rs + SEQ * 32; const float* ds = dc + SEQ * 8;
            float* kv = (float*)(ws + WS_KV); bf16* St = (bf16*)(ws + WS_ST); bf16* part = (bf16*)out;     float* lsep = (float*)(ws + WS_LSE);
            if (s == 4) { for (int u = bx; u < 1024; u += G) mix::ret_kv_unit(u, big, rc, rs, kv, lds, tid); }
            else if (s == 5) {
                for (int chain = bx * 512 + tid; chain < 65536; chain += G * 512) mix::ret_scan(chain, kv, St);
                for (int u = bx; u < 2048; u += G) mix::dil_unit(u, big, dc, ds, part, lsep, xbA, lds, tid);
            } else {
                for (int v = bx; v < 2048; v += G) { if (v < 1024) mix::ret_out_unit(v, big, rc, rs, St, args.in[9], xbA, lds, tid); else mix::dil_unit(v + 1024, big, dc, ds, part, lsep, xbA, lds, tid); }
            }
        } else {
            for (int u = bx; u < 2048; u += G) mix::sb_unit(u, big, xbA, lds, tid);
        }
        if (ph + 1 < args.ph_hi) { if (args.li != 0) cooperative_groups::this_grid().sync(); else xcd_barrier(bar); }
    }
}
extern "C" void kernel_launch(void* const* d_in, const int* in_sizes, int n_in, void* d_out, int out_size, void* d_ws, size_t ws_size, hipStream_t stream) {
    static int grid = 0;
    if (grid == 0) {
        int dev = 0, cus = 0, per_cu = 0;
        hipGetDevice(&dev); hipDeviceGetAttribute(&cus, hipDeviceAttributeMultiprocessorCount, dev);
        if (hipFuncSetAttribute((const void*)mega, hipFuncAttributeMaxDynamicSharedMemorySize, LDS_BYTES) != hipSuccess) { fprintf(stderr, "kernel_launch: hipFuncSetAttribute failed\n"); grid = -1; return; }
        if (hipOccupancyMaxActiveBlocksPerMultiprocessor(&per_cu, (const void*)mega, NWAVES * 64, LDS_BYTES) != hipSuccess || per_cu < 1) per_cu = 1;
        (void)hipGetLastError();
        grid = (cus > 0 ? cus : 256) * 1;
    }
    if (grid < 0) return;
    hipMemsetAsync((char*)d_ws + WS_CTL, 0, CTL_ZERO_BYTES, stream);
    Args a{};
    for (int i = 0; i < 14; ++i) a.in[i] = (const float*)d_in[i];
    a.out = (float*)d_out; a.ws = (unsigned char*)d_ws; a.ph_lo = 0; a.ph_hi = 21; a.li = 0; a.mask = 0;
    void* kargs[] = {&a};
    hipError_t e = hipLaunchCooperativeKernel((const void*)mega, dim3(grid), dim3(NWAVES * 64), kargs, LDS_BYTES, stream);
    if (e != hipSuccess) fprintf(stderr, "kernel_launch: cooperative launch failed: %s (grid %d)\n", hipGetErrorString(e), grid);
}
```

```cpp
#include <hip/hip_runtime.h>
#include <hip/hip_cooperative_groups.h>
#include <cstdio>
#include <cstdint>
__device__ __forceinline__ int mk_lane() { int z = 0; asm volatile("" : "+s"(z)); return (int)__builtin_amdgcn_mbcnt_hi(~0u, __builtin_amdgcn_mbcnt_lo(~0u, (unsigned)z)); }
#define MK_LANE() mk_lane()
namespace pg8 {
#define PG8_LAS __attribute__((address_space(3)))
typedef unsigned short bf16_t;
typedef short bf16x8 __attribute__((ext_vector_type(8)));
typedef float f32x4 __attribute__((ext_vector_type(4)));
typedef unsigned u32x4 __attribute__((ext_vector_type(4)));
constexpr int BM = 256, BK = 64, HALF = 128, HTB = HALF * BK * 2  , STAGE_BYTES = 8 * HTB, NXCD = 8, WGM = 8;

__host__ __device__ __forceinline__ int lds_byte(int r, int c) { const int st = (r >> 4) * 2 + (c >> 5), rr = r & 15, cc = c & 31, ob = rr * 64 + cc * 2; return st * 1024 + (ob ^ (((ob >> 9) & 1) << 5)); }
__host__ __device__ __forceinline__ void stage_rc(int b, int& R, int& C) { const int st = b / 1024, sb = b % 1024, swz = sb ^ (((sb >> 9) & 1) << 5); R = (st >> 1) * 16 + swz / 64; C = (st & 1) * 32 + (swz % 64) / 2; }
__host__ __device__ __forceinline__ int perm32(int rho) { const int n = rho >> 4, i = rho & 15; return 8 * (i >> 2) + 4 * n + (i & 3); }

struct Unit { int pm, pn; };
struct Gemm { const bf16_t* A; const bf16_t* Bt; int M, N, K; };

struct StaticOrder {
    int nM, nN, nwg, G, c;
    __host__ __device__ void init(int M, int N, int G_, int c_) { nM = M / BM; nN = N / BM; nwg = nM * nN; G = G_; c = c_; }
    __host__ __device__ bool next(int i, Unit& u) const {
        const long L = (long)i * G + c; if (L >= nwg) return false;
        int wgid = (int)L; { const int q = nwg / NXCD, r = nwg % NXCD, xcd = wgid % NXCD, off = wgid / NXCD; wgid = (xcd < r ? xcd * (q + 1) : r * (q + 1) + (xcd - r) * q) + off; }
        const int nig = WGM * nN, gid = wgid / nig, fm = gid * WGM, gsz = (nM - fm) < WGM ? (nM - fm) : WGM;
        u.pm = fm + ((wgid % nig) % gsz); u.pn = (wgid % nig) / gsz; return true;
    }
    __device__ __forceinline__ void a_ready(const Unit&) const {}
    __device__ __forceinline__ void done(const Unit&) const {}
};

__device__ __forceinline__ unsigned cvt_pk_bf16(float lo, float hi) { unsigned r; asm volatile("v_cvt_pk_bf16_f32 %0, %1, %2" : "=v"(r) : "v"(lo), "v"(hi)); return r; }
typedef float f32x2 __attribute__((ext_vector_type(2)));
__device__ __forceinline__ f32x2 gelu_pk(f32x2 v) {
    const f32x2 av = __builtin_elementwise_abs(v), d = av * 0.2316418882f + 1.0f;
    f32x2 t; t.x = __builtin_amdgcn_rcpf(d.x); t.y = __builtin_amdgcn_rcpf(d.y);
    f32x2 q = t * 0.5307027145f + (-0.7265760135f); q = q * t + 0.7107068705f; q = q * t + (-0.142248368f); q = q * t + 0.127414796f; q = q * t;
    const f32x2 s = (v * v) * (-0.72134752044f);
    f32x2 e; e.x = __builtin_amdgcn_exp2f(s.x); e.y = __builtin_amdgcn_exp2f(s.y);
    const f32x2 m = v * (q * e), r = v - m;
    f32x2 o; o.x = v.x < 0.f ? m.x : r.x; o.y = v.y < 0.f ? m.y : r.y; return o;
}

template <int ACT  > struct EpiBf16 {
    static constexpr bool PERM = true, AFTER_DRAIN = false; static_assert(ACT == 0 || ACT == 1, "EpiBf16: ACT is 0 (none) or 1 (gelu_pk)");
    bf16_t* O; int ldc; const float* bias; int split_cols; size_t split_stride; float scale0;
    __device__ __forceinline__ void operator()(const f32x4 (&acc)[2][2][4][2], const Unit& u, int wr, int wc, int fr, int fq) const {
        const int row0 = u.pm * BM + wr * 64 + fr; int colt = u.pn * BM; bf16_t* base = O;
        float sc = 1.f; if (split_cols) { const int t = colt / split_cols; base += (size_t)t * split_stride; colt -= t * split_cols; if (t == 0) sc = scale0; }
        const int col0 = colt + wc * 32 + 8 * fq, bcol0 = u.pn * BM + wc * 32 + 8 * fq;
        f32x4 bv[2][2];
#pragma unroll
        for (int bj = 0; bj < 2; ++bj)
#pragma unroll
            for (int n = 0; n < 2; ++n) bv[bj][n] = bias ? *(const f32x4*)(bias + bcol0 + bj * HALF + 4 * n) : (f32x4){0.f, 0.f, 0.f, 0.f};
#pragma unroll
        for (int ai = 0; ai < 2; ++ai)
#pragma unroll
            for (int m = 0; m < 4; ++m) { bf16_t* rowp = base + (size_t)(row0 + ai * HALF + m * 16) * ldc + col0;
#pragma unroll
                for (int bj = 0; bj < 2; ++bj) { f32x4 v0 = acc[ai][bj][m][0] + bv[bj][0], v1 = acc[ai][bj][m][1] + bv[bj][1];
                    if (ACT == 1) { f32x2 a = gelu_pk((f32x2){v0[0], v0[1]}), b = gelu_pk((f32x2){v0[2], v0[3]}), c = gelu_pk((f32x2){v1[0], v1[1]}), d = gelu_pk((f32x2){v1[2], v1[3]});
                        v0 = (f32x4){a.x, a.y, b.x, b.y}; v1 = (f32x4){c.x, c.y, d.x, d.y}; }
                    v0 = v0 * sc; v1 = v1 * sc; u32x4 w; w.x = cvt_pk_bf16(v0[0], v0[1]); w.y = cvt_pk_bf16(v0[2], v0[3]); w.z = cvt_pk_bf16(v1[0], v1[1]); w.w = cvt_pk_bf16(v1[2], v1[3]);
                    *(u32x4*)(rowp + bj * HALF) = w; } }
    }
};

struct PanelStats {
    unsigned* xbuf;
    unsigned* cnt;
    unsigned* tmo;
    int ntn; float eps;
    unsigned code;
    __device__ __forceinline__ bool run(const f32x4 (&v)[2][2][4][2], const Unit& u, int wr, int wc, int fr, int fq, PG8_LAS unsigned char* lds, int wid, int lane) const {
        typedef float f32x2v __attribute__((ext_vector_type(2)));
        PG8_LAS f32x2v* P = (PG8_LAS f32x2v*)lds;
        PG8_LAS f32x2v* S = (PG8_LAS f32x2v*)(lds + 8192);
        PG8_LAS unsigned* flag = (PG8_LAS unsigned*)(lds + 8192 + 2048);
#pragma unroll
        for (int ai = 0; ai < 2; ++ai)
#pragma unroll
            for (int m = 0; m < 4; ++m) {
                float s = 0.f;
#pragma unroll
                for (int bj = 0; bj < 2; ++bj)
#pragma unroll
                    for (int n = 0; n < 2; ++n) { const f32x4 x = v[ai][bj][m][n]; s += (x[0] + x[1]) + (x[2] + x[3]); }
                s += __shfl_xor(s, 16); s += __shfl_xor(s, 32);
                const float mw = s * (1.0f / 64.0f); float q = 0.f;
#pragma unroll
                for (int bj = 0; bj < 2; ++bj)
#pragma unroll
                    for (int n = 0; n < 2; ++n) { const f32x4 d = v[ai][bj][m][n] - mw; q += (d[0] * d[0] + d[1] * d[1]) + (d[2] * d[2] + d[3] * d[3]); }
                q += __shfl_xor(q, 16); q += __shfl_xor(q, 32);
                if (fq == 0) P[(ai * HALF + wr * 64 + m * 16 + fr) * 4 + wc] = (f32x2v){mw, q};
            }
        asm volatile("s_waitcnt lgkmcnt(0)" ::: "memory"); __builtin_amdgcn_s_barrier(); asm volatile("" ::: "memory");
#if defined(BROKEN_EXCHANGE_NO_WAIT)
#warning BROKEN CONTROL BUILD: the row-statistics exchange does not wait; results are wrong by design
        if (blockIdx.x >= 64) { const long long t0_ = clock64(); while (clock64() - t0_ < 60000) __builtin_amdgcn_s_sleep(8); }
#endif
        const int row = wid * 32 + (lane & 31);
        if (lane < 32) {
            const f32x2v a = P[row * 4 + 0], b = P[row * 4 + 1], c = P[row * 4 + 2], d = P[row * 4 + 3];
            const float mt = (a.x + b.x + c.x + d.x) * 0.25f;
            const float da = a.x - mt, db = b.x - mt, dc = c.x - mt, dd = d.x - mt;
            const float m2 = (a.y + b.y) + (c.y + d.y) + 64.0f * ((da * da + db * db) + (dc * dc + dd * dd));
            unsigned long long* slot = (unsigned long long*)xbuf + ((size_t)(u.pm * BM + row) * 4 + u.pn);
            __hip_atomic_store(slot, ((unsigned long long)__float_as_uint(m2) << 32) | __float_as_uint(mt), __ATOMIC_RELAXED, __HIP_MEMORY_SCOPE_AGENT);
        }
        asm volatile("s_waitcnt vmcnt(0)" ::: "memory");
        if (lane == 0) __hip_atomic_fetch_add(cnt + 64 * u.pm, 1u, __ATOMIC_RELAXED, __HIP_MEMORY_SCOPE_AGENT);
        if (wid == 0) {
            bool dead = false; const unsigned long long t0 = __builtin_amdgcn_s_memrealtime(); const unsigned want = 8u * (unsigned)ntn;
            for (;;) {
#if defined(BROKEN_EXCHANGE_NO_WAIT)
                break;
#endif
                if ((unsigned)__builtin_amdgcn_readfirstlane(__hip_atomic_load(cnt + 64 * u.pm, __ATOMIC_RELAXED, __HIP_MEMORY_SCOPE_AGENT)) >= want) break;
                if (__builtin_amdgcn_s_memrealtime() - t0 > 2000000ull) {
                    if (lane == 0) { unsigned expect = 0u; __hip_atomic_compare_exchange_strong(tmo + 1, &expect, code | (unsigned)(u.pm & 0xff), __ATOMIC_RELAXED, __ATOMIC_RELAXED, __HIP_MEMORY_SCOPE_AGENT);
                                     __hip_atomic_store(tmo, 1u, __ATOMIC_RELAXED, __HIP_MEMORY_SCOPE_AGENT); }
                    dead = true; break; }
                __builtin_amdgcn_s_sleep(2);
            }
            __builtin_amdgcn_fence(__ATOMIC_ACQUIRE, "agent");
            if (lane == 0) flag[0] = dead ? 1u : 0u;
        }
        asm volatile("s_waitcnt vmcnt(0) lgkmcnt(0)" ::: "memory"); __builtin_amdgcn_s_barrier(); asm volatile("" ::: "memory");
        const bool bad = flag[0] != 0u;
        if (lane < 32) {
            const unsigned long long* slot = (const unsigned long long*)xbuf + (size_t)(u.pm * BM + row) * 4; float mt[4], m2[4]; float ms = 0.f;
#pragma unroll
            for (int t = 0; t < 4; ++t) { if (t < ntn) { const unsigned long long w = __hip_atomic_load(slot + t, __ATOMIC_RELAXED, __HIP_MEMORY_SCOPE_AGENT); mt[t] = __uint_as_float((unsigned)w); m2[t] = __uint_as_float((unsigned)(w >> 32)); } else { mt[t] = 0.f; m2[t] = 0.f; } ms += mt[t]; }
            const float mean = ms / (float)ntn; float q = 0.f;
#pragma unroll
            for (int t = 0; t < 4; ++t) if (t < ntn) { const float dm = mt[t] - mean; q += m2[t] + 256.0f * dm * dm; }
            S[row] = (f32x2v){mean, 1.0f / sqrtf(q / (256.0f * (float)ntn) + eps)};
        }
        asm volatile("s_waitcnt lgkmcnt(0)" ::: "memory"); __builtin_amdgcn_s_barrier(); asm volatile("" ::: "memory");
        return bad;
    }
};
struct EpiLnRes {
    static constexpr bool PERM = false, AFTER_DRAIN = true;
    const float* base; float* out; int ldc; const float* bias; PanelStats st; unsigned poison;
    __device__ __forceinline__ void fused(f32x4 (&acc)[2][2][4][2], const Unit& u, int wr, int wc, int fr, int fq, PG8_LAS unsigned char* lds, int wid, int lane) const {
        typedef float f32x2v __attribute__((ext_vector_type(2)));
        const PG8_LAS f32x2v* S = (const PG8_LAS f32x2v*)(lds + 8192);
        const int col0 = u.pn * BM + wc * 32 + 4 * fq;
#pragma unroll
        for (int bj = 0; bj < 2; ++bj)
#pragma unroll
            for (int n = 0; n < 2; ++n) { const f32x4 bv = bias ? *(const f32x4*)(bias + col0 + bj * HALF + n * 16) : (f32x4){0.f, 0.f, 0.f, 0.f};
#pragma unroll
                for (int ai = 0; ai < 2; ++ai)
#pragma unroll
                    for (int m = 0; m < 4; ++m) acc[ai][bj][m][n] += bv; }
        f32x4 pre[4][2][2];
#pragma unroll
        for (int m = 0; m < 4; ++m) { const size_t off = (size_t)(u.pm * BM + wr * 64 + m * 16 + fr) * ldc + col0;
#pragma unroll
            for (int bj = 0; bj < 2; ++bj)
#pragma unroll
                for (int n = 0; n < 2; ++n) pre[m][bj][n] = *(const f32x4*)(base + off + bj * HALF + n * 16); }
        const bool bad = st.run(acc, u, wr, wc, fr, fq, lds, wid, lane) || poison != 0u;
        const float qnan = __builtin_nanf("");
#pragma unroll
        for (int ai = 0; ai < 2; ++ai)
#pragma unroll
            for (int m = 0; m < 4; ++m) { const int r = ai * HALF + wr * 64 + m * 16 + fr; const f32x2v sr = S[r]; const size_t off = (size_t)(u.pm * BM + r) * ldc + col0;
#pragma unroll
                for (int bj = 0; bj < 2; ++bj)
#pragma unroll
                    for (int n = 0; n < 2; ++n) { const f32x4 bs = ai == 0 ? pre[m][bj][n] : *(const f32x4*)(base + off + bj * HALF + n * 16); f32x4 o = bs + (acc[ai][bj][m][n] - sr.x) * sr.y;
                        if (bad) o = (f32x4){qnan, qnan, qnan, qnan}; *(f32x4*)(out + off + bj * HALF + n * 16) = o; }
                if (m & 1) asm volatile("" ::: "memory"); }
    }
};
struct EpiLnResLn {
    static constexpr bool PERM = false, AFTER_DRAIN = true;
    const float* base; float* out; bf16_t* xn; int ldc; const float* bias; PanelStats st1, st2; unsigned poison;
    __device__ __forceinline__ void fused(f32x4 (&acc)[2][2][4][2], const Unit& u, int wr, int wc, int fr, int fq, PG8_LAS unsigned char* lds, int wid, int lane) const {
        typedef float f32x2v __attribute__((ext_vector_type(2))); typedef unsigned u32x2v __attribute__((ext_vector_type(2)));
        const PG8_LAS f32x2v* S = (const PG8_LAS f32x2v*)(lds + 8192);
        const int col0 = u.pn * BM + wc * 32 + 4 * fq;
#pragma unroll
        for (int bj = 0; bj < 2; ++bj)
#pragma unroll
            for (int n = 0; n < 2; ++n) { const f32x4 bv = bias ? *(const f32x4*)(bias + col0 + bj * HALF + n * 16) : (f32x4){0.f, 0.f, 0.f, 0.f};
#pragma unroll
                for (int ai = 0; ai < 2; ++ai)
#pragma unroll
                    for (int m = 0; m < 4; ++m) acc[ai][bj][m][n] += bv; }
        bool bad = st1.run(acc, u, wr, wc, fr, fq, lds, wid, lane) || poison != 0u;
        const float qnan = __builtin_nanf("");
#pragma unroll
        for (int ai = 0; ai < 2; ++ai)
#pragma unroll
            for (int m = 0; m < 4; ++m) { const int r = ai * HALF + wr * 64 + m * 16 + fr; const f32x2v sr = S[r]; const size_t off = (size_t)(u.pm * BM + r) * ldc + col0;
#pragma unroll
                for (int bj = 0; bj < 2; ++bj)
#pragma unroll
                    for (int n = 0; n < 2; ++n) { const f32x4 bs = *(const f32x4*)(base + off + bj * HALF + n * 16); acc[ai][bj][m][n] = bs + (acc[ai][bj][m][n] - sr.x) * sr.y; }
                asm volatile("" : "+v"(acc[ai][0][m][0]), "+v"(acc[ai][0][m][1]), "+v"(acc[ai][1][m][0]), "+v"(acc[ai][1][m][1]));
                if (m & 1) asm volatile("" ::: "memory"); }
        const bool bad1 = bad;
        bad = st2.run(acc, u, wr, wc, fr, fq, lds, wid, lane) || bad;
#pragma unroll
        for (int ai = 0; ai < 2; ++ai)
#pragma unroll
            for (int m = 0; m < 4; ++m) { const int r = ai * HALF + wr * 64 + m * 16 + fr; const f32x2v sr = S[r]; const size_t off = (size_t)(u.pm * BM + r) * ldc + col0;
#pragma unroll
                for (int bj = 0; bj < 2; ++bj)
#pragma unroll
                    for (int n = 0; n < 2; ++n) { const f32x4 x1 = acc[ai][bj][m][n]; *(f32x4*)(out + off + bj * HALF + n * 16) = bad1 ? (f32x4){qnan, qnan, qnan, qnan} : x1;
                        const f32x4 o = (x1 - sr.x) * sr.y; u32x2v w; w.x = cvt_pk_bf16(o[0], o[1]); w.y = cvt_pk_bf16(o[2], o[3]);
                        if (bad) { w.x = 0x7fc07fc0u; w.y = 0x7fc07fc0u; } *(u32x2v*)(xn + off + bj * HALF + n * 16) = w; }
                asm volatile("" ::: "memory"); }
    }
};

template <class Epi, class Sched, bool ALIGN_EPI = false, bool SP2 = false>
__device__ __forceinline__ void gemm_phase(PG8_LAS unsigned char* lds, const Gemm g, const Sched& S, const Epi& E, const int wave_s  ) {
    int tid_ = wave_s * 64 + MK_LANE(); asm volatile("" : "+v"(tid_));
    const int tid = tid_, wid = __builtin_amdgcn_readfirstlane(tid >> 6), lane = tid & 63, wr = wid >> 2, wc = wid & 3, fr = lane & 15, fq = lane >> 4;
    const int K = g.K, nt = K / BK;
    unsigned voffA[2], voffB[2];
#pragma unroll
    for (int i = 0; i < 2; ++i) { int R, C; stage_rc(tid * 16 + i * 8192, R, C); const int Rb = Epi::PERM ? ((R & ~31) + perm32(R & 31)) : R;
        voffA[i] = (unsigned)(R * K + C) * 2u; voffB[i] = (unsigned)(Rb * K + C) * 2u; }
    const size_t kstep = (size_t)(BK * 2);
    const size_t hstep = (size_t)HALF * K * 2;
    const size_t tstep = 2 * hstep;
    const unsigned ldsw = (unsigned)wid * 1024u;
    const int aoff = lds_byte(wr * 64 + fr, fq * 8), boff = lds_byte(wc * 32 + fr, fq * 8);
#define PG8_SA(b, h) (((b) * 2 + (h)) * HTB)
#define PG8_SB(b, h) ((4 + (b) * 2 + (h)) * HTB)
#define PG8_STAGE(bufoff, gbase, voff) do { _Pragma("unroll") for (int _i = 0; _i < 2; ++_i) \
        __builtin_amdgcn_global_load_lds((const unsigned*)((const char*)(gbase) + (voff)[_i]), (PG8_LAS unsigned*)(lds + (bufoff) + ldsw + _i * 8192), 16, 0, 0); } while (0)
#define PG8_LDA(dst, b, h) do { _Pragma("unroll") for (int m = 0; m < 4; ++m) _Pragma("unroll") for (int k = 0; k < 2; ++k) dst[m][k] = *(const PG8_LAS bf16x8*)(lds + PG8_SA(b, h) + aoff + m * 2048 + k * 1024); } while (0)
#define PG8_LDB(dst, b, h) do { _Pragma("unroll") for (int n = 0; n < 2; ++n) _Pragma("unroll") for (int k = 0; k < 2; ++k) dst[n][k] = *(const PG8_LAS bf16x8*)(lds + PG8_SB(b, h) + boff + n * 2048 + k * 1024); } while (0)
#define PG8_MMA(ai, bj, At, Bt) do { __builtin_amdgcn_s_setprio(1); _Pragma("unroll") for (int m = 0; m < 4; ++m) _Pragma("unroll") for (int n = 0; n < 2; ++n) _Pragma("unroll") for (int k = 0; k < 2; ++k) \
        acc[ai][bj][m][n] = __builtin_amdgcn_mfma_f32_16x16x32_bf16(Bt[n][k], At[m][k], acc[ai][bj][m][n], 0, 0, 0); __builtin_amdgcn_s_setprio(0); } while (0)
#define PG8_WAIT_V(n) asm volatile("s_waitcnt vmcnt(" #n ")" ::: "memory")
#define PG8_WAIT_L(n) asm volatile("s_waitcnt lgkmcnt(" #n ")" ::: "memory")
#define PG8_BAR __builtin_amdgcn_s_barrier()
#define PG8_SCHED __builtin_amdgcn_sched_barrier(0)
    Unit cur, nxt; int ui = 0;
    if (!S.next(0, cur)) return;
    f32x4 acc[2][2][4][2];
#pragma unroll
    for (int a = 0; a < 2; ++a)
#pragma unroll
        for (int b = 0; b < 2; ++b)
#pragma unroll
            for (int m = 0; m < 4; ++m)
#pragma unroll
                for (int n = 0; n < 2; ++n) acc[a][b][m][n] = (f32x4){0.f, 0.f, 0.f, 0.f};
    bf16x8 At[4][2], B0[2][2], B1[2][2];
    const char* cA = (const char*)g.A + (size_t)cur.pm * tstep; const char* cB = (const char*)g.Bt + (size_t)cur.pn * tstep;
    S.a_ready(cur);
    if constexpr (SP2) {
        PG8_STAGE(PG8_SB(0, 0), cB, voffB); PG8_STAGE(PG8_SB(0, 1), cB + hstep, voffB); PG8_STAGE(PG8_SA(0, 0), cA, voffA); PG8_STAGE(PG8_SA(0, 1), cA + hstep, voffA);
        if (wr == 1) PG8_BAR;
        PG8_WAIT_V(2); PG8_BAR;
        PG8_STAGE(PG8_SB(1, 0), cB + kstep, voffB); PG8_STAGE(PG8_SA(1, 0), cA + kstep, voffA); PG8_STAGE(PG8_SB(1, 1), cB + hstep + kstep, voffB);
        PG8_WAIT_V(6); PG8_BAR;
    } else {
        PG8_STAGE(PG8_SB(0, 0), cB, voffB); PG8_STAGE(PG8_SA(0, 0), cA, voffA); PG8_STAGE(PG8_SB(0, 1), cB + hstep, voffB); PG8_STAGE(PG8_SA(0, 1), cA + hstep, voffA);
        if (wr == 1) PG8_BAR;
        PG8_WAIT_V(4); PG8_BAR;
        PG8_STAGE(PG8_SB(1, 0), cB + kstep, voffB); PG8_STAGE(PG8_SA(1, 0), cA + kstep, voffA); PG8_STAGE(PG8_SB(1, 1), cB + hstep + kstep, voffB);
        PG8_WAIT_V(6); PG8_BAR;
    }
    for (;;) {
        const bool has_next = S.next(ui + 1, nxt);
        const char* nA = has_next ? (const char*)g.A + (size_t)nxt.pm * tstep : cA; const char* nB = has_next ? (const char*)g.Bt + (size_t)nxt.pn * tstep : cB;
        for (int t = 0; t < nt; t += 2) {
            const bool last = (t == nt - 2);
            const char* a1 = cA + (size_t)(t + 1) * kstep;
            const char* a2 = last ? nA : cA + (size_t)(t + 2) * kstep; const char* b2 = last ? nB : cB + (size_t)(t + 2) * kstep;
            const char* a3 = a2 + kstep; const char* b3 = b2 + kstep;
            if (last && has_next) S.a_ready(nxt);
            if constexpr (SP2) {
            PG8_LDB(B0, 0, 0); PG8_LDB(B1, 0, 1); PG8_SCHED; PG8_LDA(At, 0, 0); PG8_STAGE(PG8_SA(1, 1), a1 + hstep, voffA);
            PG8_WAIT_V(8); PG8_WAIT_L(0); PG8_BAR; PG8_MMA(0, 0, At, B0); PG8_MMA(0, 1, At, B1); PG8_BAR; PG8_SCHED;
            PG8_LDA(At, 0, 1); PG8_STAGE(PG8_SB(0, 0), b2, voffB); PG8_STAGE(PG8_SB(0, 1), b2 + hstep, voffB); PG8_STAGE(PG8_SA(0, 0), a2, voffA);
            PG8_WAIT_V(8); PG8_WAIT_L(0); PG8_BAR; PG8_MMA(1, 0, At, B0); PG8_MMA(1, 1, At, B1); PG8_BAR; PG8_SCHED;
            PG8_LDB(B0, 1, 0); PG8_LDB(B1, 1, 1); PG8_SCHED; PG8_LDA(At, 1, 0); PG8_STAGE(PG8_SA(0, 1), a2 + hstep, voffA);
            PG8_WAIT_V(8); PG8_WAIT_L(0); PG8_BAR; PG8_MMA(0, 0, At, B0); PG8_MMA(0, 1, At, B1); PG8_BAR; PG8_SCHED;
            PG8_LDA(At, 1, 1); PG8_STAGE(PG8_SB(1, 0), b3, voffB); PG8_STAGE(PG8_SB(1, 1), b3 + hstep, voffB); PG8_STAGE(PG8_SA(1, 0), a3, voffA);
            PG8_WAIT_V(8); PG8_WAIT_L(0); PG8_BAR; PG8_MMA(1, 0, At, B0); PG8_MMA(1, 1, At, B1); PG8_BAR; PG8_SCHED;
            } else {
            PG8_LDB(B0, 0, 0); PG8_SCHED; PG8_LDA(At, 0, 0); PG8_STAGE(PG8_SA(1, 1), a1 + hstep, voffA);
            PG8_WAIT_L(8); PG8_BAR; PG8_WAIT_L(0); PG8_MMA(0, 0, At, B0); PG8_BAR; PG8_SCHED;
            PG8_LDB(B1, 0, 1); PG8_STAGE(PG8_SB(0, 0), b2, voffB);
            PG8_BAR; PG8_WAIT_L(0); PG8_MMA(0, 1, At, B1); PG8_BAR;
            PG8_LDA(At, 0, 1); PG8_STAGE(PG8_SA(0, 0), a2, voffA);
            PG8_BAR; PG8_WAIT_L(0); PG8_MMA(1, 0, At, B0); PG8_BAR; PG8_SCHED;
            PG8_STAGE(PG8_SB(0, 1), b2 + hstep, voffB);
            PG8_WAIT_V(6); PG8_BAR; PG8_MMA(1, 1, At, B1); PG8_BAR;
            PG8_LDB(B0, 1, 0); PG8_SCHED; PG8_LDA(At, 1, 0); PG8_STAGE(PG8_SA(0, 1), a2 + hstep, voffA);
            PG8_WAIT_L(8); PG8_BAR; PG8_WAIT_L(0); PG8_MMA(0, 0, At, B0); PG8_BAR; PG8_SCHED;
            PG8_LDB(B1, 1, 1); PG8_STAGE(PG8_SB(1, 0), b3, voffB);
            PG8_BAR; PG8_WAIT_L(0); PG8_MMA(0, 1, At, B1); PG8_BAR;
            PG8_LDA(At, 1, 1); PG8_STAGE(PG8_SA(1, 0), a3, voffA);
            PG8_BAR; PG8_WAIT_L(0); PG8_MMA(1, 0, At, B0); PG8_BAR; PG8_SCHED;
            PG8_STAGE(PG8_SB(1, 1), b3 + hstep, voffB);
            PG8_WAIT_V(6); PG8_BAR; PG8_MMA(1, 1, At, B1); PG8_BAR;
            }
        }
        if constexpr (ALIGN_EPI) { if (wr == 0) PG8_BAR; }
        if constexpr (!Epi::AFTER_DRAIN) { E(acc, cur, wr, wc, fr, fq); S.done(cur); }
        if (!has_next) break;
#pragma unroll
        for (int a = 0; a < 2; ++a)
#pragma unroll
            for (int b = 0; b < 2; ++b)
#pragma unroll
                for (int m = 0; m < 4; ++m)
#pragma unroll
                    for (int n = 0; n < 2; ++n) acc[a][b][m][n] = (f32x4){0.f, 0.f, 0.f, 0.f};
        cur = nxt; cA = nA; cB = nB; ++ui;
        if constexpr (ALIGN_EPI) { if (wr == 1) PG8_BAR; }
    }
    PG8_WAIT_V(0);
    if constexpr (!ALIGN_EPI) { if (wr == 0) PG8_BAR; }
    PG8_BAR;
    if constexpr (Epi::AFTER_DRAIN) { E.fused(acc, cur, wr, wc, fr, fq, lds, wid, lane); S.done(cur); }
#undef PG8_SA
#undef PG8_SB
#undef PG8_STAGE
#undef PG8_LDA
#undef PG8_LDB
#undef PG8_MMA
#undef PG8_WAIT_V
#undef PG8_WAIT_L
#undef PG8_BAR
#undef PG8_SCHED
}
}

#ifndef PG8_SP2
#define PG8_SP2 true
#endif
#ifndef PG8_ALIGN
#define PG8_ALIGN true
#endif
namespace pg8 {
typedef unsigned u32x2 __attribute__((ext_vector_type(2)));
#define PG8_GAS __attribute__((address_space(1)))
constexpr float RMS_EPS = 1e-6f;
constexpr int SS_ROWS = 16384;
__device__ __forceinline__ void row_rs8(float (&rs)[8], const float* ssp, int npart, int row0, int fq) {
    const PG8_GAS float* sp = (const PG8_GAS float*)ssp; float pr[8][4];
#pragma unroll
    for (int r = 0; r < 8; ++r)
#pragma unroll
        for (int i = 0; i < 4; ++i) { const int j = fq * 4 + i; pr[r][i] = sp[(size_t)(j < npart ? j : 0) * SS_ROWS + row0 + (r >> 2) * HALF + (r & 3) * 16]; }
#pragma unroll
    for (int r = 0; r < 8; ++r) { float s = 0.f;
#pragma unroll
        for (int i = 0; i < 4; ++i) s += (fq * 4 + i < npart) ? pr[r][i] : 0.f;
        s += __shfl_xor(s, 16); s += __shfl_xor(s, 32);
        rs[r] = rsqrtf(s * (1.0f / 1024.0f) + RMS_EPS); }
}
struct EpiSwiGLU {
    static constexpr bool PERM = true, AFTER_DRAIN = false;
    bf16_t* O; int ldc; const float* ss; int npart;
    __device__ __forceinline__ void operator()(const f32x4 (&acc)[2][2][4][2], const Unit& u, int wr, int wc, int fr, int fq) const {
        const int row0 = u.pm * BM + wr * 64 + fr, col0 = u.pn * HALF + wc * 32 + 8 * fq;
        float rsv[8]; row_rs8(rsv, ss, npart, row0, fq);
#pragma unroll
        for (int ai = 0; ai < 2; ++ai)
#pragma unroll
            for (int m = 0; m < 4; ++m) {
                const int row = row0 + ai * HALF + m * 16; const float rs = rsv[ai * 4 + m];
                float h[8];
#pragma unroll
                for (int n = 0; n < 2; ++n)
#pragma unroll
                    for (int i = 0; i < 4; ++i) { const float g = acc[ai][0][m][n][i] * rs, up = acc[ai][1][m][n][i] * rs; h[n * 4 + i] = g * __builtin_amdgcn_rcpf(1.0f + __expf(-g)) * up; }
                u32x4 w; w.x = cvt_pk_bf16(h[0], h[1]); w.y = cvt_pk_bf16(h[2], h[3]); w.z = cvt_pk_bf16(h[4], h[5]); w.w = cvt_pk_bf16(h[6], h[7]);
                *(PG8_GAS u32x4*)(O + (size_t)row * ldc + col0) = w;
            }
    }
};
struct EpiScaleBf16 {
    static constexpr bool PERM = true, AFTER_DRAIN = false;
    bf16_t* O; int ldc; const float* ss; int npart;
    __device__ __forceinline__ void operator()(const f32x4 (&acc)[2][2][4][2], const Unit& u, int wr, int wc, int fr, int fq) const {
        const int row0 = u.pm * BM + wr * 64 + fr, col0 = u.pn * BM + wc * 32 + 8 * fq;
        float rsv[8]; row_rs8(rsv, ss, npart, row0, fq);
#pragma unroll
        for (int ai = 0; ai < 2; ++ai)
#pragma unroll
            for (int m = 0; m < 4; ++m) {
                const int row = row0 + ai * HALF + m * 16; const float rs = rsv[ai * 4 + m];
#pragma unroll
                for (int bj = 0; bj < 2; ++bj) { const f32x4 v0 = acc[ai][bj][m][0] * rs, v1 = acc[ai][bj][m][1] * rs;
                    u32x4 w; w.x = cvt_pk_bf16(v0[0], v0[1]); w.y = cvt_pk_bf16(v0[2], v0[3]); w.z = cvt_pk_bf16(v1[0], v1[1]); w.w = cvt_pk_bf16(v1[2], v1[3]);
                    *(PG8_GAS u32x4*)(O + (size_t)row * ldc + col0 + bj * HALF) = w; }
            }
    }
};
struct EpiResid {
    static constexpr bool PERM = false, AFTER_DRAIN = false;
    const float* base32; const bf16_t* baseb; bf16_t* xb; float* ssn; float scale;
    __device__ __forceinline__ void operator()(const f32x4 (&acc)[2][2][4][2], const Unit& u, int wr, int wc, int fr, int fq) const {
        const int col0 = u.pn * BM + wc * 32 + 4 * fq;
#pragma unroll
        for (int ai = 0; ai < 2; ++ai) {
            f32x4 b[4][2][2];
            if (base32) {
#pragma unroll
                for (int m = 0; m < 4; ++m) { const size_t off = (size_t)(u.pm * BM + ai * HALF + wr * 64 + m * 16 + fr) * 1024 + col0;
#pragma unroll
                    for (int bj = 0; bj < 2; ++bj)
#pragma unroll
                        for (int n = 0; n < 2; ++n) b[m][bj][n] = *(const PG8_GAS f32x4*)(base32 + off + bj * HALF + n * 16); }
            } else {
                u32x2 w[4][2][2];
#pragma unroll
                for (int m = 0; m < 4; ++m) { const size_t off = (size_t)(u.pm * BM + ai * HALF + wr * 64 + m * 16 + fr) * 1024 + col0;
#pragma unroll
                    for (int bj = 0; bj < 2; ++bj)
#pragma unroll
                        for (int n = 0; n < 2; ++n) w[m][bj][n] = *(const PG8_GAS u32x2*)(baseb + off + bj * HALF + n * 16); }
#pragma unroll
                for (int m = 0; m < 4; ++m)
#pragma unroll
                    for (int bj = 0; bj < 2; ++bj)
#pragma unroll
                        for (int n = 0; n < 2; ++n) { const u32x2 x = w[m][bj][n]; b[m][bj][n] = (f32x4){__uint_as_float(x.x << 16), __uint_as_float(x.x & 0xffff0000u), __uint_as_float(x.y << 16), __uint_as_float(x.y & 0xffff0000u)}; }
            }
#pragma unroll
            for (int m = 0; m < 4; ++m) {
                const int row = u.pm * BM + ai * HALF + wr * 64 + m * 16 + fr; const size_t off = (size_t)row * 1024 + col0; float s = 0.f;
#pragma unroll
                for (int bj = 0; bj < 2; ++bj)
#pragma unroll
                    for (int n = 0; n < 2; ++n) { const f32x4 v = b[m][bj][n] + acc[ai][bj][m][n] * scale; s += (v[0] * v[0] + v[1] * v[1]) + (v[2] * v[2] + v[3] * v[3]);
                        u32x2 w2; w2.x = cvt_pk_bf16(v[0], v[1]); w2.y = cvt_pk_bf16(v[2], v[3]); *(PG8_GAS u32x2*)(xb + off + bj * HALF + n * 16) = w2; }
                s += __shfl_xor(s, 16); s += __shfl_xor(s, 32);
                if (fq == 0) ((PG8_GAS float*)ssn)[(size_t)(u.pn * 4 + wc) * SS_ROWS + row] = s;
            }
        }
    }
};
}
#define GAS __attribute__((address_space(1)))
#define LAS __attribute__((address_space(3)))
typedef unsigned short bf16;
typedef unsigned v4u __attribute__((ext_vector_type(4)));
typedef float f32x4 __attribute__((ext_vector_type(4)));
typedef short bf16x8 __attribute__((ext_vector_type(8)));
typedef GAS unsigned gu32;
typedef GAS unsigned long long gu64;
#define RLX_AGENT __ATOMIC_RELAXED, __HIP_MEMORY_SCOPE_AGENT
#define LDS_WAIT() asm volatile("s_waitcnt lgkmcnt(0)" ::: "memory")
#define VM_WAIT() asm volatile("s_waitcnt vmcnt(0)" ::: "memory")
__device__ __forceinline__ unsigned long long rt() { return __builtin_amdgcn_s_memrealtime(); }
__device__ __forceinline__ unsigned f2bf(float f) { unsigned u = __builtin_bit_cast(unsigned, f); return (u + 0x7fffu + ((u >> 16) & 1u)) >> 16; }
__device__ __forceinline__ unsigned pk2(float lo, float hi) { return f2bf(lo) | (f2bf(hi) << 16); }

#define XB_TMO      128
#define XB_XCNT(j)  (256  + 64 * (j))
#define XB_XSUB(j)  (1280 + 64 * (j))
#define XB_XGEN(j)  (2304 + 64 * (j))
#define XB_TOP      3328
#define XB_TOPGEN   3392
#define XCD_BAR_WORDS 3456
#define XB_SPIN_CAP (1u << 18)

__device__ __forceinline__ unsigned xb_ld(unsigned* p)              { return __hip_atomic_load(p, __ATOMIC_RELAXED, __HIP_MEMORY_SCOPE_AGENT); }
__device__ __forceinline__ unsigned xb_add(unsigned* p, unsigned v) { return __hip_atomic_fetch_add(p, v, __ATOMIC_RELAXED, __HIP_MEMORY_SCOPE_AGENT); }
__device__ __forceinline__ unsigned xb_xcc_id() { return (unsigned)__builtin_amdgcn_s_getreg((3 << 11) | 20) & 0xFu; }
#define XB_SPIN(cond, bar) do { unsigned _sp = 0; while (cond) { __builtin_amdgcn_s_sleep(1); \
    if ((++_sp & 255u) == 0u) { if (xb_ld(&(bar)[XB_TMO])) break; if (_sp > XB_SPIN_CAP) { atomicAdd(&(bar)[XB_TMO], 1u); break; } } } } while (0)

struct XcdBarrier {
    unsigned* bar; unsigned x; bool w0;
    volatile LAS unsigned* st;
};

__device__ __forceinline__ XcdBarrier xcd_barrier_post(unsigned* bar, volatile LAS unsigned* st, int wave_s) {
    XcdBarrier b; b.bar = bar; b.x = xb_xcc_id(); b.st = st; b.w0 = wave_s == 0;
    if (wave_s == 0 && MK_LANE() == 0) (void)xb_add(&bar[XB_XCNT(b.x)], 1u);
    return b;
}
__device__ __forceinline__ void xcd_barrier_complete(unsigned* bar, unsigned x, unsigned& nloc, unsigned& nx) {
    const unsigned G = gridDim.x * gridDim.y * gridDim.z;
    unsigned sum, cnt, mine, sp = 0u;
    for (;;) {
        sum = 0u; cnt = 0u; mine = 0u;
#pragma unroll
        for (unsigned j = 0; j < 16; ++j) { const unsigned c = xb_ld(&bar[XB_XCNT(j)]); sum += c; cnt += (c > 0u) ? 1u : 0u; mine = (j == x) ? c : mine; }
        if (sum == G) break;
        __builtin_amdgcn_s_sleep(1);
        if ((++sp & 255u) == 0u) { if (xb_ld(&bar[XB_TMO])) break; if (sp > XB_SPIN_CAP) { atomicAdd(&bar[XB_TMO], 1u); break; } }
    }
    nloc = mine > 0u ? mine : 1u; nx = cnt > 0u ? cnt : 1u;
}

__device__ __forceinline__ void xcd_barrier(const XcdBarrier& b) {
    asm volatile("s_waitcnt vmcnt(0)" ::: "memory");
    __syncthreads();
    if (b.w0 && MK_LANE() == 0) {
        unsigned* bar = b.bar;
        __builtin_amdgcn_s_waitcnt(0);
        unsigned nloc = b.st[0], nx = b.st[1];
        if (nloc == 0u) { xcd_barrier_complete(bar, b.x, nloc, nx); b.st[0] = nloc; b.st[1] = nx; }
        const unsigned old = xb_add(&bar[XB_XSUB(b.x)], 1u);
        const unsigned gen = old / nloc;
        if (old + 1u == (gen + 1u) * nloc) {
            __builtin_amdgcn_fence(__ATOMIC_RELEASE, "agent");
            asm volatile("s_waitcnt vmcnt(0)" ::: "memory");
            const unsigned og = xb_add(&bar[XB_TOP], 1u);
            const unsigned tg = og / nx;
            if (og + 1u == (tg + 1u) * nx) xb_add(&bar[XB_TOPGEN], 1u);
            else XB_SPIN(xb_ld(&bar[XB_TOPGEN]) == tg, bar);
            __builtin_amdgcn_fence(__ATOMIC_ACQUIRE, "agent");
            xb_add(&bar[XB_XGEN(b.x)], 1u);
            asm volatile("s_waitcnt vmcnt(0)" ::: "memory");
        } else {
            XB_SPIN(xb_ld(&bar[XB_XGEN(b.x)]) == gen, bar);
            __builtin_amdgcn_fence(__ATOMIC_ACQUIRE, "agent");
            asm volatile("s_waitcnt vmcnt(0)" ::: "memory");
        }
    }
    __syncthreads();
}
constexpr int NWAVES = 8;
constexpr int BATCH = 2, SEQ = 8192, D = 1024, M = BATCH * SEQ, FF = 2816, HD = 64, HYB = 3584, SBW = 3072;
constexpr size_t MiB = 1u << 20;
constexpr size_t WS_CTL = 0, CTL_ZERO_BYTES = 1 * MiB;
constexpr size_t WS_W = 1 * MiB;
constexpr size_t WS_XBA = 43 * MiB, WS_XBB = 75 * MiB;
constexpr size_t WS_BIG = 107 * MiB;
constexpr size_t WS_KV = 219 * MiB;
constexpr size_t WS_ST = 235 * MiB;
constexpr size_t WS_TAB = 243 * MiB;
constexpr size_t WS_SS = 246 * MiB;
constexpr size_t WS_LSE = 247 * MiB;
constexpr size_t WS_SSP = 248 * MiB;
constexpr size_t WO_F1IN = 0, WO_F1OUT = 5767168, WO_MIXIN = 8650752, WO_MIXOUT = 12320768, WO_F2IN = 13369344, WO_F2OUT = 19136512;
constexpr int CW_BAR = 4096;
constexpr int RING_OFF = 0, RING_BYTES = 131072, LDSCTL_OFF = RING_BYTES, MISC_OFF = LDSCTL_OFF + 320, LDS_BYTES = 147456;

__device__ __forceinline__ float wave_sum(float v) {
#pragma unroll
    for (int o = 1; o < 64; o <<= 1) v += __shfl_xor(v, o);
    return v;
}
__device__ __forceinline__ float bf2f(bf16 v) { return __uint_as_float(((unsigned)v) << 16); }

__device__ __forceinline__ void transpose_item(const float* W, const float* gain, int K, int N, bf16* WT, int dest_row0, int k0, int n0, LAS float* scr, int lane) {
    float wv[32];
#pragma unroll
    for (int i = 0; i < 32; ++i) wv[i] = ((const GAS float*)W)[(size_t)(k0 + 2 * i + (lane >> 5)) * N + n0 + (lane & 31)];
    float gk[32];
    if (gain) {
#pragma unroll
        for (int i = 0; i < 32; ++i) gk[i] = ((const GAS float*)gain)[k0 + 2 * i + (lane >> 5)];
    } else {
#pragma unroll
        for (int i = 0; i < 32; ++i) gk[i] = 1.0f;
    }
#pragma unroll
    for (int i = 0; i < 32; ++i) { const int kk = 2 * i + (lane >> 5); scr[kk * 33 + (lane & 31)] = wv[i] * gk[i]; }
    LDS_WAIT(); asm volatile("" ::: "memory");
    const int c = lane & 7;
#pragma unroll
    for (int j = 0; j < 4; ++j) { const int n = (lane >> 3) + 8 * j; const LAS float* s = scr + (8 * c) * 33 + n;
        v4u o; o.x = pk2(s[0 * 33], s[1 * 33]); o.y = pk2(s[2 * 33], s[3 * 33]); o.z = pk2(s[4 * 33], s[5 * 33]); o.w = pk2(s[6 * 33], s[7 * 33]);
        *(GAS v4u*)(WT + (size_t)(dest_row0 + n) * K + k0 + 8 * c) = o; }
    LDS_WAIT(); asm volatile("" ::: "memory");
}
struct Args { const float* in[14]; float* out; unsigned char* ws; int ph_lo, ph_hi, li, mask; };

__device__ __forceinline__ void convert_layer(const Args& a, int l, int sel, LAS float* scr, int gw, int NGW, int lane) {
    bf16* Wb = (bf16*)(a.ws + WS_W);
    const int mixN = l == 0 ? HYB : SBW;
    const int I_IN = (D / 64) * (2 * FF / 32), I_OUT = (FF / 64) * (D / 32), I_MI = (D / 64) * (mixN / 32), I_MO = (D / 64) * (D / 32);
    const int NITEMS = sel == 0 ? 2 * I_IN + 2 * I_OUT + I_MI + I_MO : (sel == 3 ? I_MI + I_MO : I_IN + I_OUT);
    for (int it = gw; it < NITEMS; it += NGW) {
        int r = it, mat;
        if (sel == 0) { if (r < I_IN) mat = 0; else if ((r -= I_IN) < I_IN) mat = 1; else if ((r -= I_IN) < I_OUT) mat = 2; else if ((r -= I_OUT) < I_OUT) mat = 3; else if ((r -= I_OUT) < I_MI) mat = 4; else { r -= I_MI; mat = 5; } }
        else if (sel == 3) { if (r < I_MI) mat = 4; else { r -= I_MI; mat = 5; } }
        else { if (r < I_IN) mat = sel == 1 ? 0 : 1; else { r -= I_IN; mat = sel == 1 ? 2 : 3; } }
        const float* W; const float* gain = nullptr; int K, N; bf16* WT; bool swi = false;
        if (mat == 0) { W = a.in[2] + (size_t)l * D * 2 * FF; gain = a.in[1] + l * D; K = D; N = 2 * FF; WT = Wb + WO_F1IN; swi = true; }
        else if (mat == 1) { W = a.in[6] + (size_t)l * D * 2 * FF; gain = a.in[5] + l * D; K = D; N = 2 * FF; WT = Wb + WO_F2IN; swi = true; }
        else if (mat == 2) { W = a.in[3] + (size_t)l * FF * D; K = FF; N = D; WT = Wb + WO_F1OUT; }
        else if (mat == 3) { W = a.in[7] + (size_t)l * FF * D; K = FF; N = D; WT = Wb + WO_F2OUT; }
        else if (mat == 4) { W = l == 0 ? a.in[8] : a.in[11]; gain = a.in[4] + l * D; K = D; N = mixN; WT = Wb + WO_MIXIN; }
        else { W = l == 0 ? a.in[10] : a.in[12]; K = D; N = D; WT = Wb + WO_MIXOUT; }
        const int nblk = N / 32, kb = r / nblk, nb = r % nblk, n0 = 32 * nb; int dest = n0;
        if (swi) { const int up = n0 >= FF ? 1 : 0, j0 = n0 - up * FF; dest = (j0 / 128) * 256 + up * 128 + (j0 % 128); }
        transpose_item(W, gain, K, N, WT, dest, 64 * kb, n0, scr, lane);
    }
}
namespace mix {
typedef short bfx8 __attribute__((ext_vector_type(8)));
typedef unsigned u32x2v __attribute__((ext_vector_type(2)));
typedef unsigned short u16;
#define MFMA16(a, b, c) __builtin_amdgcn_mfma_f32_16x16x32_bf16(a, b, c, 0, 0, 0)
constexpr int QP = 72;
constexpr int OFF_Q = 0, OFF_K = 18432, OFF_V = 55296, OFF_FLAG = 90112;
constexpr int VP1 = 140, VP2 = 268;
constexpr float LOG2E = 1.4426950408889634f, LN2 = 0.6931471805599453f;

__device__ __forceinline__ float bfe(const v4u& a, int e) { return __uint_as_float((e & 1) ? (a[e >> 1] & 0xffff0000u) : (a[e >> 1] << 16)); }
typedef float f32x2_t __attribute__((ext_vector_type(2))); typedef __bf16 bf16x2_t __attribute__((ext_vector_type(2)));
__device__ __forceinline__ unsigned pkbf(float lo, float hi) { const f32x2_t v = {lo, hi}; const bf16x2_t b = __builtin_convertvector(v, bf16x2_t); return __builtin_bit_cast(unsigned, b); }
__device__ __forceinline__ bfx8 pack8(const f32x4& p0, const f32x4& p1) { v4u w; w.x = pkbf(p0[0], p0[1]); w.y = pkbf(p0[2], p0[3]); w.z = pkbf(p1[0], p1[1]); w.w = pkbf(p1[2], p1[3]); return __builtin_bit_cast(bfx8, w); }

template <int MODE>
__device__ __forceinline__ void stage_rows(LAS bf16* dst, const bf16* src, size_t rowStride, int nrows, int pos0, int posStride, const float* ctab, const float* stab, int tid) {
    for (int it = tid; it < nrows * 4; it += 512) {
        const int row = it >> 2, c = it & 3; const bf16* p = src + (size_t)row * rowStride;
        v4u a = *(const GAS v4u*)(p + 8 * c), b = *(const GAS v4u*)(p + 32 + 8 * c);
        if (MODE == 1) {
            const int pos = pos0 + row * posStride; const GAS f32x4* ct = (const GAS f32x4*)(ctab + pos * 32 + 8 * c); const GAS f32x4* sn = (const GAS f32x4*)(stab + pos * 32 + 8 * c);
            const f32x4 c0 = ct[0], c1 = ct[1], s0 = sn[0], s1 = sn[1]; float y1[8], y2[8];
#pragma unroll
            for (int e = 0; e < 8; ++e) { const float cs = e < 4 ? c0[e & 3] : c1[e & 3], si = e < 4 ? s0[e & 3] : s1[e & 3]; const float x1 = bfe(a, e), x2 = bfe(b, e); y1[e] = x1 * cs - x2 * si; y2[e] = x2 * cs + x1 * si; }
            a.x = pkbf(y1[0], y1[1]); a.y = pkbf(y1[2], y1[3]); a.z = pkbf(y1[4], y1[5]); a.w = pkbf(y1[6], y1[7]);
            b.x = pkbf(y2[0], y2[1]); b.y = pkbf(y2[2], y2[3]); b.z = pkbf(y2[4], y2[5]); b.w = pkbf(y2[6], y2[7]);
        }
        if (MODE == 2) {
            v4u o; o.x = __shfl_xor(a.x, 1); o.y = __shfl_xor(a.y, 1); o.z = __shfl_xor(a.z, 1); o.w = __shfl_xor(a.w, 1);
            if (c < 2) {
                const int pos = pos0 + row * posStride; const GAS f32x4* ct = (const GAS f32x4*)(ctab + pos * 8); const GAS f32x4* sn = (const GAS f32x4*)(stab + pos * 8);
                const f32x4 c0 = ct[0], c1 = ct[1], s0 = sn[0], s1 = sn[1]; float y[8];
#pragma unroll
                for (int e = 0; e < 8; ++e) { const float cs = e < 4 ? c0[e & 3] : c1[e & 3], si = e < 4 ? s0[e & 3] : s1[e & 3]; const float xo = bfe(a, e), xp = bfe(o, e); y[e] = c == 0 ? (xo * cs - xp * si) : (xo * cs + xp * si); }
                a.x = pkbf(y[0], y[1]); a.y = pkbf(y[2], y[3]); a.z = pkbf(y[4], y[5]); a.w = pkbf(y[6], y[7]);
            }
        }
        *(LAS v4u*)(dst + row * QP + 8 * c) = a; *(LAS v4u*)(dst + row * QP + 32 + 8 * c) = b;
    }
}
__device__ __forceinline__ void stage_vt(LAS bf16* dst, int pitch, int key_off, const bf16* src, size_t rowStride, int tid) {
    for (int it = tid; it < 128 * 8; it += 512) {
        const int key = it & 127, c = it >> 7; const v4u a = *(const GAS v4u*)(src + (size_t)key * rowStride + 8 * c);
#pragma unroll
        for (int e = 0; e < 8; ++e) dst[(8 * c + e) * pitch + key_off + key] = (bf16)((e & 1) ? (a[e >> 1] >> 16) : (a[e >> 1] & 0xffffu));
    }
}
struct RR { v4u a, b; };
struct TT { f32x4 c0, c1, s0, s1; };
struct VV { v4u v0, v1; };
__device__ __forceinline__ void ld_rows(RR& r, const bf16* src, size_t rowStride, int tid) { const bf16* p = src + (size_t)(tid >> 2) * rowStride + 8 * (tid & 3); r.a = *(const GAS v4u*)p; r.b = *(const GAS v4u*)(p + 32); }
__device__ __forceinline__ void st_rows(LAS bf16* dst, const RR& r, int tid) { LAS bf16* q = dst + (tid >> 2) * QP + 8 * (tid & 3); *(LAS v4u*)q = r.a; *(LAS v4u*)(q + 32) = r.b; }
__device__ __forceinline__ void ld_tab(TT& t, const float* ctab, const float* stab, int idx) { const GAS f32x4* ct = (const GAS f32x4*)(ctab + idx); const GAS f32x4* sn = (const GAS f32x4*)(stab + idx); t.c0 = ct[0]; t.c1 = ct[1]; t.s0 = sn[0]; t.s1 = sn[1]; }
__device__ __forceinline__ void rot1(RR& r, const TT& t) {
    float y1[8], y2[8];
#pragma unroll
    for (int e = 0; e < 8; ++e) { const float cs = e < 4 ? t.c0[e & 3] : t.c1[e & 3], si = e < 4 ? t.s0[e & 3] : t.s1[e & 3]; const float x1 = bfe(r.a, e), x2 = bfe(r.b, e); y1[e] = x1 * cs - x2 * si; y2[e] = x2 * cs + x1 * si; }
    r.a.x = pkbf(y1[0], y1[1]); r.a.y = pkbf(y1[2], y1[3]); r.a.z = pkbf(y1[4], y1[5]); r.a.w = pkbf(y1[6], y1[7]);
    r.b.x = pkbf(y2[0], y2[1]); r.b.y = pkbf(y2[2], y2[3]); r.b.z = pkbf(y2[4], y2[5]); r.b.w = pkbf(y2[6], y2[7]);
}
__device__ __forceinline__ void rot2(RR& r, const TT& t, int c) {
    v4u o; o.x = __shfl_xor(r.a.x, 1); o.y = __shfl_xor(r.a.y, 1); o.z = __shfl_xor(r.a.z, 1); o.w = __shfl_xor(r.a.w, 1);
    if (c < 2) { float y[8];
#pragma unroll
        for (int e = 0; e < 8; ++e) { const float cs = e < 4 ? t.c0[e & 3] : t.c1[e & 3], si = e < 4 ? t.s0[e & 3] : t.s1[e & 3]; const float xo = bfe(r.a, e), xp = bfe(o, e); y[e] = c == 0 ? (xo * cs - xp * si) : (xo * cs + xp * si); }
        r.a.x = pkbf(y[0], y[1]); r.a.y = pkbf(y[2], y[3]); r.a.z = pkbf(y[4], y[5]); r.a.w = pkbf(y[6], y[7]); }
}
__device__ __forceinline__ void ld_vt(VV& v, const bf16* src, size_t rowStride, int tid) { const int kp = (tid >> 2) & 63, c = ((tid >> 8) << 2) | (tid & 3); const bf16* p = src + (size_t)(2 * kp) * rowStride + 8 * c; v.v0 = *(const GAS v4u*)p; v.v1 = *(const GAS v4u*)(p + rowStride); }
__device__ __forceinline__ void st_vt(LAS bf16* dst, int pitch, int key_off, const VV& v, int tid) { const int kp = (tid >> 2) & 63, c = ((tid >> 8) << 2) | (tid & 3);
#pragma unroll
    for (int e = 0; e < 8; ++e) { const unsigned a = v.v0[e >> 1], b2 = v.v1[e >> 1]; const unsigned wd = (e & 1) ? ((a >> 16) | (b2 & 0xffff0000u)) : ((a & 0xffffu) | (b2 << 16));
        *(LAS unsigned*)(dst + (8 * c + e) * pitch + key_off + 2 * kp) = wd; }
}
__device__ __forceinline__ void stage_kt_ret(LAS bf16* dst, const bf16* src, size_t rowStride, int pos0, const float* ctab, const float* stab, float log2g, int tid) {
    { const int it = tid; const int key = it & 127, c = it >> 7; const bf16* p = src + (size_t)key * rowStride;
        const v4u a = *(const GAS v4u*)(p + 8 * c), b = *(const GAS v4u*)(p + 32 + 8 * c);
        const int pos = pos0 + key; const GAS f32x4* ct = (const GAS f32x4*)(ctab + pos * 32 + 8 * c); const GAS f32x4* sn = (const GAS f32x4*)(stab + pos * 32 + 8 * c);
        const f32x4 c0 = ct[0], c1 = ct[1], s0 = sn[0], s1 = sn[1]; const float kd = 0.125f * exp2f((float)(127 - key) * log2g);
#pragma unroll
        for (int e = 0; e < 8; ++e) { const float cs = e < 4 ? c0[e & 3] : c1[e & 3], si = e < 4 ? s0[e & 3] : s1[e & 3]; const float x1 = bfe(a, e), x2 = bfe(b, e);
            dst[(8 * c + e) * 136 + key] = (bf16)f2bf((x1 * cs - x2 * si) * kd); dst[(32 + 8 * c + e) * 136 + key] = (bf16)f2bf((x2 * cs + x1 * si) * kd); }
    }
}
__device__ __forceinline__ f32x4 st_tile(const LAS bf16* Ks, int T, const bfx8 (&qf)[2], int c16, int g) {
    f32x4 acc = (f32x4){0.f, 0.f, 0.f, 0.f};
#pragma unroll
    for (int ks = 0; ks < 2; ++ks) { const bfx8 a = *(const LAS bfx8*)(Ks + (16 * T + c16) * QP + 32 * ks + 8 * g); acc = MFMA16(a, qf[ks], acc); }
    return acc;
}
__device__ __forceinline__ void st_tiles8(const LAS bf16* Ks, int T0, const bfx8 (&qf)[2], int c16, int g, f32x4 (&out)[8]) {
    bfx8 a[8][2];
#pragma unroll
    for (int T = 0; T < 8; ++T)
#pragma unroll
        for (int ks = 0; ks < 2; ++ks) a[T][ks] = *(const LAS bfx8*)(Ks + (16 * (T0 + T) + c16) * QP + 32 * ks + 8 * g);
#pragma unroll
    for (int T = 0; T < 8; ++T) { f32x4 acc = (f32x4){0.f, 0.f, 0.f, 0.f};
#pragma unroll
        for (int ks = 0; ks < 2; ++ks) acc = MFMA16(a[T][ks], qf[ks], acc);
        out[T] = acc; }
}
__device__ __forceinline__ void pv_pair(f32x4 (&o)[4], const LAS bf16* Vs, int vp, int t0, int t1, const f32x4& p0, const f32x4& p1, int c16, int g) {
    const bfx8 pb = pack8(p0, p1); u32x2v lo[4], hi[4];
#pragma unroll
    for (int dt = 0; dt < 4; ++dt) { lo[dt] = *(const LAS u32x2v*)(Vs + (16 * dt + c16) * vp + 16 * t0 + 4 * g); hi[dt] = *(const LAS u32x2v*)(Vs + (16 * dt + c16) * vp + 16 * t1 + 4 * g); }
#pragma unroll
    for (int dt = 0; dt < 4; ++dt) { v4u av; av.x = lo[dt].x; av.y = lo[dt].y; av.z = hi[dt].x; av.w = hi[dt].y; o[dt] = MFMA16(__builtin_bit_cast(bfx8, av), pb, o[dt]); }
}

__device__ __forceinline__ void ret_kv_unit(int u, const bf16* proj, const float* rc, const float* rs, float* kv, LAS unsigned char* lds, int tid) {
    const int n = u & 63, bh = u >> 6, h = bh & 7, b = bh >> 3; const int lane = tid & 63, w = __builtin_amdgcn_readfirstlane(tid >> 6), c16 = lane & 15, g = lane >> 4;
    const float log2g = log2f(1.0f - exp2f(-5.0f - (float)h));
    const bf16* rowp = proj + (size_t)(b * SEQ + n * 128) * HYB + h * 64;
    LAS bf16* Kt = (LAS bf16*)(lds + OFF_Q); LAS bf16* Vt = (LAS bf16*)(lds + OFF_V);
    { const int key = tid & 127, c = tid >> 7; const bf16* p = rowp + 512 + (size_t)key * HYB;
        const v4u a = *(const GAS v4u*)(p + 8 * c), b2 = *(const GAS v4u*)(p + 32 + 8 * c); TT t; ld_tab(t, rc, rs, (n * 128 + key) * 32 + 8 * c); VV vv; ld_vt(vv, rowp + 1024, HYB, tid);
        const float kd = 0.125f * __builtin_amdgcn_exp2f((float)(127 - key) * log2g);
#pragma unroll
        for (int e = 0; e < 8; ++e) { const float cs = e < 4 ? t.c0[e & 3] : t.c1[e & 3], si = e < 4 ? t.s0[e & 3] : t.s1[e & 3]; const float x1 = bfe(a, e), x2 = bfe(b2, e);
            Kt[(8 * c + e) * 136 + key] = (bf16)f2bf((x1 * cs - x2 * si) * kd); Kt[(32 + 8 * c + e) * 136 + key] = (bf16)f2bf((x2 * cs + x1 * si) * kd); }
        st_vt(Vt, 136, 0, vv, tid); }
    __syncthreads();
    const int dvt = w >> 1;
#pragma unroll
    for (int i = 0; i < 2; ++i) { const int dkt = 2 * (w & 1) + i; f32x4 acc = (f32x4){0.f, 0.f, 0.f, 0.f};
#pragma unroll
        for (int ks = 0; ks < 4; ++ks) { const bfx8 a = *(const LAS bfx8*)(Vt + (16 * dvt + c16) * 136 + 32 * ks + 8 * g), bb = *(const LAS bfx8*)(Kt + (16 * dkt + c16) * 136 + 32 * ks + 8 * g); acc = MFMA16(a, bb, acc); }
        float* o = kv + ((size_t)n * 16 + bh) * 4096;
#pragma unroll
        for (int r = 0; r < 4; ++r) o[(16 * dvt + 4 * g + r) * 64 + 16 * dkt + c16] = acc[r]; }
    __syncthreads();
}
__device__ __forceinline__ void ret_scan(int chain, const float* kv, bf16* St) {
    const int h = (chain >> 12) & 7; const float cd = exp2f(128.0f * log2f(1.0f - exp2f(-5.0f - (float)h)));
    float state = 0.f; const GAS float* kvp = (const GAS float*)kv + chain; GAS bf16* stp = (GAS bf16*)St + chain;
#pragma unroll
    for (int n0 = 0; n0 < 64; n0 += 32) {
        float v[32];
#pragma unroll
        for (int i = 0; i < 32; ++i) v[i] = kvp[(size_t)(n0 + i) * 65536];
#pragma unroll
        for (int i = 0; i < 32; ++i) { stp[(size_t)(n0 + i) * 65536] = (bf16)f2bf(state); state = state * cd + v[i]; }
    }
}
__device__ __forceinline__ void ret_out_unit(int u, const bf16* proj, const float* rc, const float* rs, const bf16* St, const float* gn, bf16* cat, LAS unsigned char* lds, int tid) {
    const int n = u & 63, bh = u >> 6, h = bh & 7, b = bh >> 3; const int lane = tid & 63, w = __builtin_amdgcn_readfirstlane(tid >> 6), c16 = lane & 15, g = lane >> 4;
    const float log2g = log2f(1.0f - exp2f(-5.0f - (float)h));
    const size_t row0 = (size_t)(b * SEQ + n * 128); const bf16* rowp = proj + row0 * HYB + h * 64;
    LAS bf16* Qs = (LAS bf16*)(lds + OFF_Q); LAS bf16* Ks = (LAS bf16*)(lds + OFF_K); LAS bf16* Vs = (LAS bf16*)(lds + OFF_V);
    { RR rq, rk, rst; TT t; VV vv;
        ld_rows(rq, rowp, HYB, tid); ld_rows(rk, rowp + 512, HYB, tid); ld_tab(t, rc, rs, (n * 128 + (tid >> 2)) * 32 + 8 * (tid & 3)); ld_vt(vv, rowp + 1024, HYB, tid);
        if (tid < 256) ld_rows(rst, St + ((size_t)n * 16 + bh) * 4096, 64, tid);
        rot1(rq, t); rot1(rk, t); st_rows(Qs, rq, tid); st_rows(Ks, rk, tid); st_vt(Vs, VP1, 0, vv, tid);
        if (tid < 256) st_rows(Ks + 128 * QP, rst, tid); }
    __syncthreads();
    bfx8 qf[2];
#pragma unroll
    for (int ks = 0; ks < 2; ++ks) qf[ks] = *(const LAS bfx8*)(Qs + (16 * w + c16) * QP + 32 * ks + 8 * g);
    const int qi = 16 * w + c16;
    f32x4 o[4], cr[4];
#pragma unroll
    for (int dt = 0; dt < 4; ++dt) { o[dt] = (f32x4){0.f, 0.f, 0.f, 0.f}; cr[dt] = (f32x4){0.f, 0.f, 0.f, 0.f}; }
#pragma unroll
    for (int tp = 0; tp < 4; ++tp) {
        f32x4 p[2];
#pragma unroll
        for (int i = 0; i < 2; ++i) { const int T = 2 * tp + i; const f32x4 s = st_tile(Ks, T, qf, c16, g);
#pragma unroll
            for (int r = 0; r < 4; ++r) { const int kj = 16 * T + 4 * g + r; const int dd = qi - kj; p[i][r] = dd >= 0 ? s[r] * 0.125f * __builtin_amdgcn_exp2f((float)dd * log2g) : 0.f; } }
        pv_pair(o, Vs, VP1, 2 * tp, 2 * tp + 1, p[0], p[1], c16, g);
    }
#pragma unroll
    for (int dt = 0; dt < 4; ++dt) cr[dt] = st_tile(Ks, 8 + dt, qf, c16, g);
    const float qd = exp2f((float)(qi + 1) * log2g);
    float sum = 0.f;
#pragma unroll
    for (int dt = 0; dt < 4; ++dt) { o[dt] = o[dt] + cr[dt] * qd; sum += (o[dt][0] + o[dt][1]) + (o[dt][2] + o[dt][3]); }
    sum += __shfl_xor(sum, 16); sum += __shfl_xor(sum, 32);
    const float mu = sum * (1.0f / 64.0f); float var = 0.f;
#pragma unroll
    for (int dt = 0; dt < 4; ++dt) { o[dt] = o[dt] - mu; var += (o[dt][0] * o[dt][0] + o[dt][1] * o[dt][1]) + (o[dt][2] * o[dt][2] + o[dt][3] * o[dt][3]); }
    var += __shfl_xor(var, 16); var += __shfl_xor(var, 32);
    const float rstd = rsqrtf(var * (1.0f / 64.0f) + 1e-5f);
    const size_t tok = row0 + qi;
    f32x4 ggv[4]; u32x2v rgv[4];
#pragma unroll
    for (int dt = 0; dt < 4; ++dt) { const int d0 = 16 * dt + 4 * g; ggv[dt] = *(const GAS f32x4*)(gn + h * 64 + d0); rgv[dt] = *(const GAS u32x2v*)(proj + tok * HYB + 1536 + h * 64 + d0); }
#pragma unroll
    for (int dt = 0; dt < 4; ++dt) { const int d0 = 16 * dt + 4 * g; const f32x4 gg = ggv[dt]; const u32x2v rgw = rgv[dt];
        float y[4];
#pragma unroll
        for (int r = 0; r < 4; ++r) { const float gate = __uint_as_float((r & 1) ? (rgw[r >> 1] & 0xffff0000u) : (rgw[r >> 1] << 16)); y[r] = o[dt][r] * rstd * gg[r] * (gate * __builtin_amdgcn_rcpf(1.0f + __expf(-gate))); }
        u32x2v wv; wv.x = pkbf(y[0], y[1]); wv.y = pkbf(y[2], y[3]); *(GAS u32x2v*)(cat + tok * D + h * 64 + d0) = wv; }
    __syncthreads();
}

__device__ __forceinline__ void dil_unit(int u, const bf16* proj, const float* dc, const float* ds, bf16* part, float* lsep, bf16* cat, LAS unsigned char* lds, int tid) {
    const int idx = u & 63, h = (u >> 6) & 7, b = (u >> 9) & 1, p = u >> 10; const int dil = p == 0 ? 1 : (p == 1 ? 4 : 16), nper = 64 / dil, r = idx / nper, nbi = idx % nper;
    const int lane = tid & 63, w = __builtin_amdgcn_readfirstlane(tid >> 6), c16 = lane & 15, g = lane >> 4;
    const bf16* bp = proj + (size_t)b * SEQ * HYB + h * 64; const int t0 = (128 * nbi) * dil + r;
    LAS bf16* Qs = (LAS bf16*)(lds + OFF_Q); LAS bf16* Ks = (LAS bf16*)(lds + OFF_K); LAS bf16* Vs = (LAS bf16*)(lds + OFF_V);
    const size_t rstr = (size_t)dil * HYB;
    { RR rq, rk, rkp; TT t, tp_; VV vv, vvp; const int tp = t0 - 128 * dil, srow = tid >> 2, sc = tid & 3;
        ld_rows(rq, bp + (size_t)t0 * HYB + 2048, rstr, tid); ld_rows(rk, bp + (size_t)t0 * HYB + 2560, rstr, tid); ld_tab(t, dc, ds, (t0 + srow * dil) * 8); ld_vt(vv, bp + (size_t)t0 * HYB + 3072, rstr, tid);
        if (nbi > 0) { ld_rows(rkp, bp + (size_t)tp * HYB + 2560, rstr, tid); ld_tab(tp_, dc, ds, (tp + srow * dil) * 8); ld_vt(vvp, bp + (size_t)tp * HYB + 3072, rstr, tid); }
        rot2(rq, t, sc); rot2(rk, t, sc); st_rows(Qs, rq, tid); st_rows(Ks + 128 * QP, rk, tid); st_vt(Vs, VP2, 128, vv, tid);
        if (nbi > 0) { rot2(rkp, tp_, sc); st_rows(Ks, rkp, tid); st_vt(Vs, VP2, 0, vvp, tid); } }
    __syncthreads();
    bfx8 qf[2];
#pragma unroll
    for (int ks = 0; ks < 2; ++ks) qf[ks] = *(const LAS bfx8*)(Qs + (16 * w + c16) * QP + 32 * ks + 8 * g);
    const int qi = 16 * w + c16; const int Tlo = nbi > 0 ? w : 8, Thi = 8 + w;
    f32x4 s[16]; float m = -INFINITY;
#pragma unroll
    for (int T = 0; T < 16; ++T) { s[T] = (f32x4){-INFINITY, -INFINITY, -INFINITY, -INFINITY};
        if (T >= Tlo && T <= Thi) { const f32x4 a = st_tile(Ks, T, qf, c16, g);
#pragma unroll
            for (int rr = 0; rr < 4; ++rr) { const int kj = 16 * (T & 7) + 4 * g + rr; const bool ok = T < 8 ? (kj >= qi) : (kj <= qi); s[T][rr] = ok ? a[rr] * 0.125f : -INFINITY; m = fmaxf(m, s[T][rr]); } } }
    m = fmaxf(m, __shfl_xor(m, 16)); m = fmaxf(m, __shfl_xor(m, 32));
    float l = 0.f;
#pragma unroll
    for (int T = 0; T < 16; ++T) {
        if (T >= Tlo && T <= Thi) {
#pragma unroll
            for (int rr = 0; rr < 4; ++rr) { const float e = __builtin_amdgcn_exp2f((s[T][rr] - m) * LOG2E); s[T][rr] = e; l += e; }
        } else s[T] = (f32x4){0.f, 0.f, 0.f, 0.f};
    }
    l += __shfl_xor(l, 16); l += __shfl_xor(l, 32);
    f32x4 o[4];
#pragma unroll
    for (int dt = 0; dt < 4; ++dt) o[dt] = (f32x4){0.f, 0.f, 0.f, 0.f};
#pragma unroll
    for (int tp = 0; tp < 8; ++tp) if (2 * tp + 1 >= Tlo && 2 * tp <= Thi) {
        const int ta = 2 * tp, tb = 2 * tp + 1;
        const int ra = ta >= Tlo ? ta : tb, rb = tb <= Thi ? tb : ta;
        pv_pair(o, Vs, VP2, ra, rb, s[ta], s[tb], c16, g);
    }
    const float rl = 1.0f / l, lse = m + __logf(l);
    const size_t tok = (size_t)b * SEQ + t0 + (size_t)qi * dil;
    if (p < 2) {
        if (g == 0) lsep[(size_t)p * M * 8 + tok * 8 + h] = lse;
#pragma unroll
        for (int dt = 0; dt < 4; ++dt) { u32x2v wv; wv.x = pkbf(o[dt][0] * rl, o[dt][1] * rl); wv.y = pkbf(o[dt][2] * rl, o[dt][3] * rl); *(GAS u32x2v*)(part + (size_t)p * M * 512 + tok * 512 + h * 64 + 16 * dt + 4 * g) = wv; }
    } else {
        const float l0 = ((const GAS float*)lsep)[tok * 8 + h], l1 = ((const GAS float*)lsep)[(size_t)M * 8 + tok * 8 + h];
        u32x2v x0v[4], x1v[4];
#pragma unroll
        for (int dt = 0; dt < 4; ++dt) { const int d0 = h * 64 + 16 * dt + 4 * g; x0v[dt] = *(const GAS u32x2v*)(part + tok * 512 + d0); x1v[dt] = *(const GAS u32x2v*)(part + (size_t)M * 512 + tok * 512 + d0); }
        const float mm = fmaxf(lse, fmaxf(l0, l1));
        const float w0 = __expf(l0 - mm), w1 = __expf(l1 - mm), w2 = __expf(lse - mm); const float inv = 1.0f / (w0 + w1 + w2); const float a0 = w0 * inv, a1 = w1 * inv, a2 = w2 * inv * rl;
#pragma unroll
        for (int dt = 0; dt < 4; ++dt) { const int d0 = h * 64 + 16 * dt + 4 * g; const u32x2v x0 = x0v[dt], x1 = x1v[dt]; float y[4];
#pragma unroll
            for (int rr = 0; rr < 4; ++rr) { const float v0 = __uint_as_float((rr & 1) ? (x0[rr >> 1] & 0xffff0000u) : (x0[rr >> 1] << 16)), v1 = __uint_as_float((rr & 1) ? (x1[rr >> 1] & 0xffff0000u) : (x1[rr >> 1] << 16)); y[rr] = a0 * v0 + a1 * v1 + a2 * o[dt][rr]; }
            u32x2v wv; wv.x = pkbf(y[0], y[1]); wv.y = pkbf(y[2], y[3]); *(GAS u32x2v*)(cat + tok * D + 512 + d0) = wv; }
    }
    __syncthreads();
}
}
namespace mix {
__device__ __forceinline__ void sb_unit(int u, const bf16* qkv, bf16* cat, LAS unsigned char* lds, int tid) {
    const int qb = 63 - (u & 63), h = (u >> 6) & 15, b = u >> 10; const int lane = tid & 63, w = __builtin_amdgcn_readfirstlane(tid >> 6), c16 = lane & 15, g = lane >> 4;
    const bf16* bp = qkv + (size_t)b * SEQ * SBW + h * 64;
    LAS bf16* Qs = (LAS bf16*)(lds + OFF_Q); LAS bf16* Ks = (LAS bf16*)(lds + OFF_K); LAS bf16* Vs = (LAS bf16*)(lds + OFF_V); volatile LAS int* flags = (volatile LAS int*)(lds + OFF_FLAG);
    const int qi = 16 * w + c16;
    v4u onesw, tri0w, tri1w;
    {
        unsigned t0e[8], t1e[8];
#pragma unroll
        for (int j = 0; j < 8; ++j) { t0e[j] = j < 4 ? ((4 * g + j > c16) ? 0x3F80u : 0u) : 0x3F80u; t1e[j] = j < 4 ? 0u : ((4 * g + (j - 4) > c16) ? 0x3F80u : 0u); }
        onesw = (v4u){0x3F803F80u, 0x3F803F80u, 0x3F803F80u, 0x3F803F80u};
        tri0w = (v4u){t0e[0] | (t0e[1] << 16), t0e[2] | (t0e[3] << 16), t0e[4] | (t0e[5] << 16), t0e[6] | (t0e[7] << 16)};
        tri1w = (v4u){t1e[0] | (t1e[1] << 16), t1e[2] | (t1e[3] << 16), t1e[4] | (t1e[5] << 16), t1e[6] | (t1e[7] << 16)};
    }
    const bfx8 ones = __builtin_bit_cast(bfx8, onesw), tri0 = __builtin_bit_cast(bfx8, tri0w), tri1 = __builtin_bit_cast(bfx8, tri1w);
    f32x4 o[4];
#pragma unroll
    for (int dt = 0; dt < 4; ++dt) o[dt] = (f32x4){0.f, 0.f, 0.f, 0.f};
    float carry = 0.f;
    bfx8 qf[2];
    const int krow = tid >> 2, kc = tid & 3, vkp = (tid >> 2) & 63, vc = ((tid >> 8) << 2) | (tid & 3);
    v4u ka, kb2, va0, va1;
#define SB_LOAD(blk) do { const bf16* kp_ = bp + (size_t)((blk) * 128 + krow) * SBW + 1024; ka = *(const GAS v4u*)(kp_ + 8 * kc); kb2 = *(const GAS v4u*)(kp_ + 32 + 8 * kc); \
        const bf16* vp_ = bp + (size_t)((blk) * 128 + 2 * vkp) * SBW + 2048 + 8 * vc; va0 = *(const GAS v4u*)vp_; va1 = *(const GAS v4u*)(vp_ + SBW); } while (0)
    SB_LOAD(qb);
    { RR rq; ld_rows(rq, bp + (size_t)(qb * 128) * SBW, SBW, tid); st_rows(Qs, rq, tid); }
    for (int kb = qb; kb >= 0; --kb) {
        *(LAS v4u*)(Ks + krow * QP + 8 * kc) = ka; *(LAS v4u*)(Ks + krow * QP + 32 + 8 * kc) = kb2;
#pragma unroll
        for (int e = 0; e < 8; ++e) { const unsigned a_ = va0[e >> 1], b_ = va1[e >> 1]; *(LAS unsigned*)(Vs + (8 * vc + e) * VP1 + 2 * vkp) = (e & 1) ? ((a_ >> 16) | (b_ & 0xffff0000u)) : ((a_ & 0xffffu) | (b_ << 16)); }
        __syncthreads();
        if (kb > 0) SB_LOAD(kb - 1);
        if (kb == qb) {
#pragma unroll
            for (int ks = 0; ks < 2; ++ks) qf[ks] = *(const LAS bfx8*)(Qs + (16 * w + c16) * QP + 32 * ks + 8 * g);
        }
        const bool diag = kb == qb;
        if (__any(carry >= -104.0f)) {
        f32x4 ls[8], lg[8];
        f32x4 zt[8]; st_tiles8(Ks, 0, qf, c16, g, zt);
#pragma unroll
        for (int T = 0; T < 8; ++T) { const f32x4 a = zt[T];
#pragma unroll
            for (int r = 0; r < 4; ++r) { const int kj = 16 * T + 4 * g + r; const bool ok = !diag || kj < qi; const float z = a[r] * 0.125f;
                const float sp = fmaxf(z, 0.f) + __log2f(1.0f + __builtin_amdgcn_exp2f(-fabsf(z) * LOG2E)) * LN2;
                ls[T][r] = ok ? -sp : 0.f; lg[T][r] = ok ? z - sp : -INFINITY; } }
        float tot[4]; f32x4 later[8];
#pragma unroll
        for (int s = 0; s < 4; ++s) {
            const bfx8 bh = pack8(ls[2 * s], ls[2 * s + 1]);
            f32x4 t = (f32x4){0.f, 0.f, 0.f, 0.f}; t = MFMA16(ones, bh, t); tot[s] = t[0];
            f32x4 a0 = (f32x4){0.f, 0.f, 0.f, 0.f}, a1 = (f32x4){0.f, 0.f, 0.f, 0.f};
            a0 = MFMA16(tri0, bh, a0); a1 = MFMA16(tri1, bh, a1);
            later[2 * s] = a0; later[2 * s + 1] = a1;
        }
        float suf = carry;
#pragma unroll
        for (int s = 3; s >= 0; --s) {
            f32x4 p0, p1;
#pragma unroll
            for (int r = 0; r < 4; ++r) { p0[r] = __builtin_amdgcn_exp2f((lg[2 * s][r] + later[2 * s][r] + suf) * LOG2E); p1[r] = __builtin_amdgcn_exp2f((lg[2 * s + 1][r] + later[2 * s + 1][r] + suf) * LOG2E); }
            pv_pair(o, Vs, VP1, 2 * s, 2 * s + 1, p0, p1, c16, g);
            suf += tot[s];
        }
        carry = suf;
        }
        const int alive = __any(carry >= -104.0f) ? 1 : 0;
        if (lane == 0) flags[w] = alive;
        __syncthreads();
        int any = 0;
#pragma unroll
        for (int i = 0; i < 8; ++i) any |= flags[i];
        if (!any) break;
    }
#undef SB_LOAD
    const size_t tok = (size_t)b * SEQ + qb * 128 + qi;
#pragma unroll
    for (int dt = 0; dt < 4; ++dt) { u32x2v wv; wv.x = pkbf(o[dt][0], o[dt][1]); wv.y = pkbf(o[dt][2], o[dt][3]); *(GAS u32x2v*)(cat + tok * D + h * 64 + 16 * dt + 4 * g) = wv; }
    __syncthreads();
}
}
__global__ void __launch_bounds__(NWAVES * 64, 2) mega(Args args) {
    extern __shared__ __attribute__((aligned(16))) unsigned char lds_raw[];
    LAS unsigned char* lds = (LAS unsigned char*)lds_raw;
    volatile LAS unsigned* MISC = (volatile LAS unsigned*)(lds + MISC_OFF);
    const int G = gridDim.x; const int bx = blockIdx.x;
    const int wave_s = __builtin_amdgcn_readfirstlane((int)threadIdx.x >> 6);
    for (int u = wave_s * 64 + MK_LANE(); u < (LDS_BYTES - LDSCTL_OFF) / 4; u += NWAVES * 64) ((LAS unsigned*)(lds + LDSCTL_OFF))[u] = 0u;
    __syncthreads();
    XcdBarrier bar = xcd_barrier_post((unsigned*)((gu32*)(args.ws + WS_CTL) + CW_BAR) + args.li * XCD_BAR_WORDS, MISC + 8, wave_s);

    for (int ph = args.ph_lo; ph < args.ph_hi; ++ph) {
        int tid = wave_s * 64 + MK_LANE(); asm volatile("" : "+v"(tid));
        unsigned char* ws = args.ws; asm volatile("" : "+s"(ws));
        const int lane = tid & 63, wave = __builtin_amdgcn_readfirstlane(tid >> 6);
        const int vcu = (G % 8 == 0) ? (bx % 8) * (G / 8) + bx / 8 : bx;
        const int gw = vcu * NWAVES + wave, NGW = G * NWAVES;
        bf16* Wb = (bf16*)(ws + WS_W); bf16* xbA = (bf16*)(ws + WS_XBA); bf16* xbB = (bf16*)(ws + WS_XBB); bf16* big = (bf16*)(ws + WS_BIG);
        float* SS = (float*)(ws + WS_SS); float* out = args.out;
        const int l = ph >= 11 ? 1 : 0, s = (ph >= 1 && ph <= 9) ? ph : (ph >= 11 && ph <= 19 ? ph - 10 : 0);
        if (l == 1 && (s == 5 || s == 6)) continue;
        if (ph == 0) {
            LAS float* scr = (LAS float*)(lds + RING_OFF + wave * 16384);
            float* rc = (float*)(ws + WS_TAB); float* rs = rc + SEQ * 32; float* dc = rs + SEQ * 32; float* ds = dc + SEQ * 8;
            for (int idx = gw * 64 + lane; idx < SEQ * 32; idx += NGW * 64) {
                { const int pos = idx / 32, i = idx % 32; const float inv = 1.0f / powf(10000.0f, (float)i / 32.0f); const float ang = (float)pos * inv; rc[idx] = cosf(ang); rs[idx] = sinf(ang); }
                if (idx < SEQ * 8) { const int pos = idx / 8, i = idx % 8; const float inv = 1.0f / powf(500000.0f, (float)i / 8.0f); const float ang = (float)pos * inv; dc[idx] = cosf(ang); ds[idx] = sinf(ang); }
            }
            for (int m0 = gw; m0 < M; m0 += 2 * NGW) {
                f32x4 v[2][4];
#pragma unroll
                for (int r = 0; r < 2; ++r) { const int m = m0 + r * NGW < M ? m0 + r * NGW : m0; const GAS f32x4* xr = (const GAS f32x4*)(args.in[0] + (size_t)m * D) + lane;
#pragma unroll
                    for (int j = 0; j < 4; ++j) v[r][j] = xr[64 * j]; }
#pragma unroll
                for (int r = 0; r < 2; ++r) { const int m = m0 + r * NGW; if (m < M) { float sq = 0.f;
#pragma unroll
                    for (int j = 0; j < 4; ++j) sq += (v[r][j].x * v[r][j].x + v[r][j].y * v[r][j].y) + (v[r][j].z * v[r][j].z + v[r][j].w * v[r][j].w);
                    sq = wave_sum(sq); if (lane == 0) SS[m] = sq;
                    GAS unsigned long long* o8 = (GAS unsigned long long*)(xbA + (size_t)m * D) + lane;
#pragma unroll
                    for (int j = 0; j < 4; ++j) o8[64 * j] = (unsigned long long)pk2(v[r][j].x, v[r][j].y) | ((unsigned long long)pk2(v[r][j].z, v[r][j].w) << 32); } }
            }
            convert_layer(args, 0, 0, scr, gw, NGW, lane);
        } else if (ph == 10) {
            LAS float* scr = (LAS float*)(lds + RING_OFF + wave * 16384);
            if ((1408 % G) == 0) convert_layer(args, 1, 0, scr, gw, NGW, lane);
            else convert_layer(args, 1, 3, scr, gw, NGW, lane);
        } else if (ph == 20) {
            const float* ssf = (const float*)(ws + WS_SSP) + (size_t)5 * 16 * M; const float* g = args.in[13];
            f32x4 gv[4];
#pragma unroll
            for (int j = 0; j < 4; ++j) gv[j] = ((const GAS f32x4*)g + lane)[64 * j];
            for (int m0 = gw; m0 < M; m0 += 4 * NGW) {
                float part[4]; unsigned long long wv[4][4];
#pragma unroll
                for (int r = 0; r < 4; ++r) { const int m = m0 + r * NGW; part[r] = (lane < 16 && m < M) ? ((const GAS float*)ssf)[(size_t)lane * M + m] : 0.f;
                    const GAS unsigned long long* xi = (const GAS unsigned long long*)(xbA + (size_t)(m < M ? m : 0) * D) + lane;
#pragma unroll
                    for (int j = 0; j < 4; ++j) wv[r][j] = xi[64 * j]; }
#pragma unroll
                for (int r = 0; r < 4; ++r) { const int m = m0 + r * NGW; const float rs = rsqrtf(wave_sum(part[r]) * (1.0f / 1024.0f) + 1e-6f);
                    if (m < M) { GAS f32x4* xr = (GAS f32x4*)(out + (size_t)m * D) + lane;
#pragma unroll
                        for (int j = 0; j < 4; ++j) { const unsigned lo = (unsigned)wv[r][j], hi = (unsigned)(wv[r][j] >> 32);
                            f32x4 v = (f32x4){__uint_as_float(lo << 16), __uint_as_float(lo & 0xffff0000u), __uint_as_float(hi << 16), __uint_as_float(hi & 0xffff0000u)}; v = v * rs * gv[j]; xr[64 * j] = v; } } }
            }
        } else if (s == 1 || s == 8) {
            pg8::Gemm g{s == 1 ? xbA : xbB, Wb + (s == 1 ? WO_F1IN : WO_F2IN), M, 2 * FF, D};
            pg8::StaticOrder S; S.init(M, 2 * FF, G, bx);
            const int kss = 3 * l + (s == 1 ? 0 : 2);
            pg8::EpiSwiGLU E{big, FF, kss == 0 ? (const float*)SS : (const float*)(ws + WS_SSP) + (size_t)(kss - 1) * 16 * M, kss == 0 ? 1 : 16};
            pg8::gemm_phase<pg8::EpiSwiGLU, pg8::StaticOrder, PG8_ALIGN, PG8_SP2>(lds + RING_OFF, g, S, E, wave_s);
            {
                const int nwg = (M / 256) * (2 * FF / 256), rem = nwg % G;
                if (rem != 0 && bx >= rem && ((l == 0 && s == 8) || (l == 1 && s == 1))) {
                    LAS float* scr = (LAS float*)(lds + RING_OFF + wave * 16384);
                    convert_layer(args, 1, l == 0 ? 1 : 2, scr, (bx - rem) * NWAVES + wave, (G - rem) * NWAVES, lane);
                }
            }
        } else if (s == 3) {
            const int N = l == 0 ? HYB : SBW;
            pg8::Gemm g{xbB, Wb + WO_MIXIN, M, N, D};
            pg8::StaticOrder S; S.init(M, N, G, bx);
            pg8::EpiScaleBf16 E{big, N, (const float*)(ws + WS_SSP) + (size_t)(3 * l) * 16 * M, 16};
            pg8::gemm_phase<pg8::EpiScaleBf16, pg8::StaticOrder, PG8_ALIGN, PG8_SP2>(lds + RING_OFF, g, S, E, wave_s);
        } else if (s == 2 || s == 7 || s == 9) {
            const bf16* A = s == 7 ? xbA : big; const int K = s == 7 ? D : FF;
            const bf16* Bt = Wb + (s == 2 ? WO_F1OUT : s == 7 ? WO_MIXOUT : WO_F2OUT);
            const float* base32 = (l == 0 && s == 2) ? args.in[0] : nullptr; const bf16* baseb = s == 2 ? xbA : xbB;
            bf16* xbo = s == 9 ? xbA : xbB; float* ssn = (float*)(ws + WS_SSP) + (size_t)(3 * l + (s == 2 ? 0 : s == 7 ? 1 : 2)) * 16 * M;
            pg8::Gemm g{A, Bt, M, D, K};
            pg8::StaticOrder S; S.init(M, D, G, bx);
            pg8::EpiResid E{base32, baseb, xbo, ssn, s == 7 ? 1.0f : 0.5f};
            pg8::gemm_phase<pg8::EpiResid, pg8::StaticOrder, PG8_ALIGN, PG8_SP2>(lds + RING_OFF, g, S, E, wave_s);
        } else if (l == 0) {
            const float* rc = (const float*)(ws + WS_TAB); const float* rs = rc + SEQ * 32; const float* dc = rs + SEQ * 32; const float* ds = dc + SEQ * 8;
            float* kv = (float*)(ws + WS_KV); bf16* St = (bf16*)(ws + WS_ST); bf16* part = (bf16*)out;     float* lsep = (float*)(ws + WS_LSE);
            if (s == 4) { for (int u = bx; u < 1024; u += G) mix::ret_kv_unit(u, big, rc, rs, kv, lds, tid); }
            else if (s == 5) {
                for (int chain = bx * 512 + tid; chain < 65536; chain += G * 512) mix::ret_scan(chain, kv, St);
                for (int u = bx; u < 2048; u += G) mix::dil_unit(u, big, dc, ds, part, lsep, xbA, lds, tid);
            } else {
                for (int v = bx; v < 2048; v += G) { if (v < 1024) mix::ret_out_unit(v, big, rc, rs, St, args.in[9], xbA, lds, tid); else mix::dil_unit(v + 1024, big, dc, ds, part, lsep, xbA, lds, tid); }
            }
        } else {
            for (int u = bx; u < 2048; u += G) mix::sb_unit(u, big, xbA, lds, tid);
        }
        if (ph + 1 < args.ph_hi) { if (args.li != 0) cooperative_groups::this_grid().sync(); else xcd_barrier(bar); }
    }
}
extern "C" void kernel_launch(void* const* d_in, const int* in_sizes, int n_in, void* d_out, int out_size, void* d_ws, size_t ws_size, hipStream_t stream) {
    static int grid = 0;
    if (grid == 0) {
        int dev = 0, cus = 0, per_cu = 0;
        hipGetDevice(&dev); hipDeviceGetAttribute(&cus, hipDeviceAttributeMultiprocessorCount, dev);
        if (hipFuncSetAttribute((const void*)mega, hipFuncAttributeMaxDynamicSharedMemorySize, LDS_BYTES) != hipSuccess) { fprintf(stderr, "kernel_launch: hipFuncSetAttribute failed\n"); grid = -1; return; }
        if (hipOccupancyMaxActiveBlocksPerMultiprocessor(&per_cu, (const void*)mega, NWAVES * 64, LDS_BYTES) != hipSuccess || per_cu < 1) per_cu = 1;
        (void)hipGetLastError();
        grid = (cus > 0 ? cus : 256) * 1;
    }
    if (grid < 0) return;
    hipMemsetAsync((char*)d_ws + WS_CTL, 0, CTL_ZERO_BYTES, stream);
    Args a{};
    for (int i = 0; i < 14; ++i) a.in[i] = (const float*)d_in[i];
    a.out = (float*)d_out; a.ws = (unsigned char*)d_ws; a.ph_lo = 0; a.ph_hi = 21; a.li = 0; a.mask = 0;
    void* kargs[] = {&a};
    hipError_t e = hipLaunchCooperativeKernel((const void*)mega, dim3(grid), dim3(NWAVES * 64), kargs, LDS_BYTES, stream);
    if (e != hipSuccess) fprintf(stderr, "kernel_launch: cooperative launch failed: %s (grid %d)\n", hipGetErrorString(e), grid);
}
```
